# Optimizing an MI355X kernel written in HIP

```python
import numpy as np
import jax
import jax.numpy as jnp
from jax import lax

D_MODEL = 2048
BATCH = 8
SEQ = 2048
DEPTH = 2

CTX_LEN = 256
GRID_W = 64
MIX_WIDTH = D_MODEL
GROUP_WIDTH = MIX_WIDTH // 4
HEAD_DIM = 128
LRU_WIDTH = GROUP_WIDTH
LRU_BLOCKS = 4
LRU_BLOCK_W = LRU_WIDTH // LRU_BLOCKS
CONV_W = 4
CONV_PAD_LEFT = 2
RGLRU_C = 8.0
GLA_HEADS = 4
GLA_DV = GROUP_WIDTH // GLA_HEADS
GLA_DK = GLA_DV // 2
GLA_GATE_RANK = 16
GLA_TAU = 16.0
GLA_CHUNK = 64
ATT_HEADS = GROUP_WIDTH // HEAD_DIM
ATT_KV_HEADS = 2
ATT_GROUP = ATT_HEADS // ATT_KV_HEADS
Q_BLOCK = 128
ROPE_THETA = 10000.0
WIN_HEADS = GROUP_WIDTH // HEAD_DIM
WIN_KV_HEADS = 2
WIN_GROUP = WIN_HEADS // WIN_KV_HEADS
WINDOW = 128
N_EXPERTS = 64
N_EXPERT_GROUPS = 8
TOPK_GROUPS = 4
TOP_K = 8
EXPERT_HIDDEN = 512
SHARED_HIDDEN = 512
ROUTED_SCALE = 2.5
MOE_BLOCK = 128

RMS_EPS = 1e-6
NEG_INF = -1e30
IN_SPLITS = (LRU_WIDTH, LRU_WIDTH,
             GLA_HEADS * GLA_DK, GLA_HEADS * GLA_DK, GLA_HEADS * GLA_DV, GLA_HEADS * GLA_DV,
             GLA_GATE_RANK, GLA_GATE_RANK,
             ATT_HEADS * HEAD_DIM, ATT_KV_HEADS * HEAD_DIM, ATT_KV_HEADS * HEAD_DIM,
             WIN_HEADS * HEAD_DIM, WIN_KV_HEADS * HEAD_DIM, WIN_KV_HEADS * HEAD_DIM)
IN_COLS = sum(IN_SPLITS)
F32 = jnp.float32

kernel_name = 'hybrid_prefix_dit_block'


def rms_norm(x, g):
    xf = x.astype(F32)
    y = xf * lax.rsqrt(jnp.mean(xf * xf, axis=-1, keepdims=True) + RMS_EPS)
    return (y * g.astype(F32)).astype(x.dtype)


def modulate(x, shift, scale):
    return x * (1.0 + scale) + shift


def heads(t, n):
    return t.reshape(*t.shape[:-1], n, t.shape[-1] // n)


def swiglu(h, w_gate, w_up, w_down):
    return (jax.nn.silu(h @ w_gate) * (h @ w_up)) @ w_down


def axial_rope_tables(n_tok):
    rows = n_tok // GRID_W
    n_freq = HEAD_DIM // 4
    inv_freq = ROPE_THETA ** (-jnp.arange(n_freq, dtype=F32) / n_freq)
    row = jnp.repeat(jnp.arange(rows, dtype=F32), GRID_W)
    col = jnp.tile(jnp.arange(GRID_W, dtype=F32), rows)
    ang = jnp.stack([row, col], axis=-1)[:, :, None] * inv_freq
    return jnp.cos(ang), jnp.sin(ang)


def apply_axial_rope(x, cos, sin):
    b, n, h, d = x.shape
    xr = x.astype(F32).reshape(b, n, h, 2, 2, d // 4)
    x1, x2 = xr[..., 0, :], xr[..., 1, :]
    cs, sn = cos[None, :, None], sin[None, :, None]
    out = jnp.stack([x1 * cs - x2 * sn, x1 * sn + x2 * cs], axis=-2)
    return out.reshape(b, n, h, d).astype(x.dtype)


def centred_depthwise_conv(x, w, b):
    y = lax.conv_general_dilated(
        x, w[:, None, :].astype(x.dtype), window_strides=(1,),
        padding=[(CONV_PAD_LEFT, CONV_W - 1 - CONV_PAD_LEFT)],
        dimension_numbers=('NWC', 'WIO', 'NWC'), feature_group_count=x.shape[-1])
    return y + b.astype(x.dtype)


def linear_scan(a, b, h0):
    def combine(left, right):
        return left[0] * right[0], right[0] * left[1] + right[1]
    a_cum, b_cum = lax.associative_scan(combine, (a, b), axis=1)
    return a_cum * h0[:, None] + b_cum


def rglru_mixer(x_lat, g_lat, x_ctx, g_ctx, conv_w, conv_b, w_r, b_r, w_i, b_i, lam, need_ctx):
    n_ctx = x_ctx.shape[1]
    u = jnp.concatenate([centred_depthwise_conv(x_ctx, conv_w, conv_b),
                         centred_depthwise_conv(x_lat, conv_w, conv_b)], axis=1).astype(F32)
    u_blk = heads(u, LRU_BLOCKS)
    h_ctx_sum, h_lat_sum = 0.0, 0.0
    for d in range(2):
        r = jax.nn.sigmoid(jnp.einsum('bshi,hij->bshj', u_blk, w_r[d].astype(F32)).reshape(u.shape) + b_r[d])
        i = jax.nn.sigmoid(jnp.einsum('bshi,hij->bshj', u_blk, w_i[d].astype(F32)).reshape(u.shape) + b_i[d])
        log_a = -RGLRU_C * r * jax.nn.softplus(-lam[d].astype(F32))
        a = jnp.exp(log_a)
        bx = jnp.sqrt(-jnp.expm1(2.0 * log_a)) * (i * u)
        a_c, a_l, b_c, b_l = a[:, :n_ctx], a[:, n_ctx:], bx[:, :n_ctx], bx[:, n_ctx:]
        if d == 1:
            a_c, a_l, b_c, b_l = (jnp.flip(t, 1) for t in (a_c, a_l, b_c, b_l))
        h_c = linear_scan(a_c, b_c, jnp.zeros_like(b_c[:, 0]))
        h_l = linear_scan(a_l, b_l, h_c[:, -1])
        if d == 1:
            h_c, h_l = jnp.flip(h_c, 1), jnp.flip(h_l, 1)
        h_ctx_sum = h_ctx_sum + h_c
        h_lat_sum = h_lat_sum + h_l
    y_lat = (h_lat_sum * jax.nn.gelu(g_lat.astype(F32))).astype(x_lat.dtype)
    y_ctx = (h_ctx_sum * jax.nn.gelu(g_ctx.astype(F32))).astype(x_ctx.dtype) if need_ctx else None
    return y_lat, y_ctx


def gla_chunk_scan(q, k, v, log_a, s0):
    bsz, s, h, dk = q.shape
    dv = v.shape[-1]
    n_chunks = s // GLA_CHUNK

    def chunks(t):
        return jnp.swapaxes(t.reshape(bsz, n_chunks, GLA_CHUNK, *t.shape[2:]), 0, 1)

    lower = jnp.tril(jnp.ones((GLA_CHUNK, GLA_CHUNK), bool))[None, :, :, None, None]

    def step(state, inp):
        qc, kc, vc, ac = inp
        cum = jnp.cumsum(ac, axis=1)
        last = cum[:, -1]
        diff = cum[:, :, None] - cum[:, None, :]
        decay = jnp.exp(jnp.where(lower, diff, -jnp.inf))
        scores = jnp.einsum('btshd,bshd->bhts', qc[:, :, None] * decay, kc)
        o = (jnp.einsum('bhts,bshv->bthv', scores, vc)
             + jnp.einsum('bthd,bhdv->bthv', qc * jnp.exp(cum), state))
        state = (jnp.exp(last)[..., None] * state
                 + jnp.einsum('bshd,bshv->bhdv', kc * jnp.exp(last[:, None] - cum), vc))
        return state, o

    state, o = lax.scan(step, s0, (chunks(q), chunks(k), chunks(v), chunks(log_a)))
    return jnp.swapaxes(o, 0, 1).reshape(bsz, s, h, dv), state


def gla_mixer(p_lat, p_ctx, w2, b2, norm_g, need_ctx):
    def prep(p):
        q, k, v, g, z_f, z_b = (t.astype(F32) for t in p)
        log_a = [heads(jax.nn.log_sigmoid(z @ w2[d].astype(F32) + b2[d]) / GLA_TAU, GLA_HEADS)
                 for d, z in enumerate((z_f, z_b))]
        return heads(q, GLA_HEADS) * GLA_DK ** -0.5, heads(k, GLA_HEADS), heads(v, GLA_HEADS), g, log_a

    q_l, k_l, v_l, g_l, la_l = prep(p_lat)
    q_c, k_c, v_c, g_c, la_c = prep(p_ctx)
    s0 = jnp.zeros((q_l.shape[0], GLA_HEADS, GLA_DK, GLA_DV), F32)
    o_lat, o_ctx = 0.0, 0.0
    for d in range(2):
        seq_c = (q_c, k_c, v_c, la_c[d])
        seq_l = (q_l, k_l, v_l, la_l[d])
        if d == 1:
            seq_c = tuple(jnp.flip(t, 1) for t in seq_c)
            seq_l = tuple(jnp.flip(t, 1) for t in seq_l)
        oc, s_ctx = gla_chunk_scan(*seq_c, s0)
        ol, _ = gla_chunk_scan(*seq_l, s_ctx)
        if d == 1:
            oc, ol = jnp.flip(oc, 1), jnp.flip(ol, 1)
        o_lat = o_lat + ol
        o_ctx = o_ctx + oc

    def finish(o, g):
        return (rms_norm(o, norm_g) * jax.nn.silu(heads(g, GLA_HEADS))).reshape(g.shape)

    y_lat = finish(o_lat, g_l).astype(p_lat[0].dtype)
    y_ctx = finish(o_ctx, g_c).astype(p_ctx[0].dtype) if need_ctx else None
    return y_lat, y_ctx


def gqa_attend(q, k, v, mask=None, sink=None):
    s = jnp.einsum('...qkgd,...skd->...kgqs', q, k).astype(F32) * (q.shape[-1] ** -0.5)
    if mask is not None:
        s = jnp.where(mask, s, NEG_INF)
    if sink is not None:
        sink_col = jnp.broadcast_to(sink.astype(F32).reshape(k.shape[-2], -1)[:, :, None, None],
                                    s.shape[:-1] + (1,))
        p = jax.nn.softmax(jnp.concatenate([s, sink_col], axis=-1), axis=-1)[..., :-1]
    else:
        p = jax.nn.softmax(s, axis=-1)
    return jnp.einsum('...kgqs,...skd->...qkgd', p.astype(v.dtype), v)


def global_attention(p_lat, p_ctx, qk_g, cos, sin, need_ctx):
    q_l, k_l, v_l = p_lat
    q_c, k_c, v_c = p_ctx
    bsz, n = q_l.shape[:2]
    n_blocks = n // Q_BLOCK
    q_l = apply_axial_rope(rms_norm(heads(q_l, ATT_HEADS), qk_g[0]), cos, sin)
    k_l = apply_axial_rope(rms_norm(heads(k_l, ATT_KV_HEADS), qk_g[1]), cos, sin)
    k_c = rms_norm(heads(k_c, ATT_KV_HEADS), qk_g[1])
    v_c = heads(v_c, ATT_KV_HEADS)
    k_all = jnp.concatenate([k_c, k_l], axis=1)
    v_all = jnp.concatenate([v_c, heads(v_l, ATT_KV_HEADS)], axis=1)
    q_blocks = jnp.moveaxis(q_l.reshape(bsz, n_blocks, Q_BLOCK, ATT_KV_HEADS, ATT_GROUP, HEAD_DIM), 1, 0)
    o_blocks = lax.map(lambda qb: gqa_attend(qb, k_all, v_all), q_blocks)
    y_lat = jnp.moveaxis(o_blocks, 0, 1).reshape(bsz, n, ATT_HEADS * HEAD_DIM)
    y_ctx = None
    if need_ctx:
        q_c = rms_norm(heads(q_c, ATT_HEADS), qk_g[0])
        q_c = q_c.reshape(*q_c.shape[:2], ATT_KV_HEADS, ATT_GROUP, HEAD_DIM)
        y_ctx = gqa_attend(q_c, k_c, v_c).reshape(bsz, -1, ATT_HEADS * HEAD_DIM)
    return y_lat, y_ctx


def window_attention(p_lat, p_ctx, sink, cos, sin, need_ctx):
    q_l, k_l, v_l = p_lat
    q_c, k_c, v_c = p_ctx
    bsz, n = q_l.shape[:2]
    n_ctx = q_c.shape[1]
    n_blocks = n // WINDOW
    q_l = apply_axial_rope(heads(q_l, WIN_HEADS), cos, sin)
    k_l = apply_axial_rope(heads(k_l, WIN_KV_HEADS), cos, sin)
    v_l = heads(v_l, WIN_KV_HEADS)
    k_c = heads(k_c, WIN_KV_HEADS)
    v_c = heads(v_c, WIN_KV_HEADS)

    def band(t):
        tp = jnp.pad(t, ((0, 0), (WINDOW, WINDOW), (0, 0), (0, 0)))
        tp = tp.reshape(bsz, n_blocks + 2, WINDOW, *t.shape[2:])
        return jnp.concatenate([tp[:, :-2], tp[:, 1:-1], tp[:, 2:]], axis=2)

    def with_ctx(t_band, t_ctx):
        return jnp.concatenate([t_band, jnp.broadcast_to(t_ctx[:, None], (bsz, n_blocks) + t_ctx.shape[1:])], axis=2)

    k_all = with_ctx(band(k_l), k_c)
    v_all = with_ctx(band(v_l), v_c)
    q_pos = jnp.arange(n_blocks)[:, None] * WINDOW + jnp.arange(WINDOW)
    k_pos = (jnp.arange(n_blocks)[:, None] - 1) * WINDOW + jnp.arange(3 * WINDOW)
    kp = k_pos[:, None, :]
    in_band = (jnp.abs(q_pos[:, :, None] - kp) <= WINDOW) & (kp >= 0) & (kp < n)
    mask = jnp.concatenate([in_band, jnp.ones((n_blocks, WINDOW, n_ctx), bool)], axis=-1)[:, None, None]
    q_blocks = q_l.reshape(bsz, n_blocks, WINDOW, WIN_KV_HEADS, WIN_GROUP, HEAD_DIM)
    y_lat = gqa_attend(q_blocks, k_all, v_all, mask, sink).reshape(bsz, n, WIN_HEADS * HEAD_DIM)
    y_ctx = None
    if need_ctx:
        q_c = heads(q_c, WIN_HEADS).reshape(bsz, n_ctx, WIN_KV_HEADS, WIN_GROUP, HEAD_DIM)
        y_ctx = gqa_attend(q_c, k_c, v_c, sink=sink).reshape(bsz, n_ctx, WIN_HEADS * HEAD_DIM)
    return y_lat, y_ctx


def moe_ffn(h, router_w, router_bias, w_gate, w_up, w_down, s_gate, s_up, s_down):
    t, d = h.shape
    scores = jax.nn.sigmoid(h.astype(F32) @ router_w.astype(F32))
    biased = scores + router_bias.astype(F32)
    group_score = lax.top_k(biased.reshape(t, N_EXPERT_GROUPS, -1), 2)[0].sum(-1)
    _, top_groups = lax.top_k(group_score, TOPK_GROUPS)
    group_ok = jnp.any(top_groups[:, :, None] == jnp.arange(N_EXPERT_GROUPS), axis=1)
    eligible = jnp.repeat(group_ok, N_EXPERTS // N_EXPERT_GROUPS, axis=1)
    _, top_e = lax.top_k(jnp.where(eligible, biased, -jnp.inf), TOP_K)
    gate = jnp.take_along_axis(scores, top_e, axis=1)
    gate = gate / jnp.sum(gate, axis=-1, keepdims=True) * ROUTED_SCALE
    n_assign = t * TOP_K
    flat_e = top_e.reshape(-1)
    flat_tok = jnp.repeat(jnp.arange(t, dtype=jnp.int32), TOP_K)
    order = jnp.argsort(flat_e)
    e_sorted = flat_e[order]
    counts = jnp.bincount(flat_e, length=N_EXPERTS)
    padded = (counts + MOE_BLOCK - 1) // MOE_BLOCK * MOE_BLOCK
    pad_end = jnp.cumsum(padded)
    pad_start = pad_end - padded
    start = jnp.cumsum(counts) - counts
    dest = pad_start[e_sorted] + jnp.arange(n_assign, dtype=jnp.int32) - start[e_sorted]
    n_blocks = -(-(n_assign + N_EXPERTS * (MOE_BLOCK - 1)) // MOE_BLOCK)
    n_rows = n_blocks * MOE_BLOCK
    row_tok = jnp.full((n_rows,), t, dtype=jnp.int32).at[dest].set(flat_tok[order])
    row_w = jnp.zeros((n_rows,), F32).at[dest].set(gate.reshape(-1)[order])
    block_e = jnp.minimum(jnp.searchsorted(pad_end, jnp.arange(n_blocks, dtype=jnp.int32) * MOE_BLOCK, side='right'),
                          N_EXPERTS - 1)
    h_pad = jnp.concatenate([h, jnp.zeros((1, d), h.dtype)], axis=0)

    def expert_block(acc, inp):
        tok_b, w_b, e = inp
        y = swiglu(h_pad[tok_b], w_gate[e], w_up[e], w_down[e]).astype(F32) * w_b[:, None]
        return acc.at[tok_b].add(y), None

    acc, _ = lax.scan(expert_block, jnp.zeros((t + 1, d), F32),
                      (row_tok.reshape(n_blocks, MOE_BLOCK), row_w.reshape(n_blocks, MOE_BLOCK), block_e))
    return (acc[:t] + swiglu(h, s_gate, s_up, s_down).astype(F32)).astype(h.dtype)


def setup_inputs(seed: int = 0) -> dict:
    key = jax.random.key(seed)
    ks = iter(jax.random.split(key, 32))

    def nrm(shape, scale):
        return jax.random.normal(next(ks), shape, F32) * scale

    x = nrm((BATCH, SEQ, D_MODEL), 1.0)
    c = nrm((BATCH, D_MODEL), 1.0)
    ctx = nrm((BATCH, CTX_LEN, D_MODEL), 1.0)
    c_ctx = nrm((D_MODEL,), 1.0)
    mod_w = nrm((DEPTH, D_MODEL, 6 * D_MODEL), 0.5 * D_MODEL ** -0.5)
    mod_b = nrm((DEPTH, 6 * D_MODEL), 0.01)
    norm_g = 1.0 + nrm((DEPTH, 4, D_MODEL), 0.02)
    w_in = nrm((DEPTH, D_MODEL, IN_COLS), D_MODEL ** -0.5)
    w_out = nrm((DEPTH, MIX_WIDTH, D_MODEL), MIX_WIDTH ** -0.5)
    conv_w = nrm((DEPTH, CONV_W, LRU_WIDTH), CONV_W ** -0.5)
    conv_b = nrm((DEPTH, LRU_WIDTH), 0.01)
    lru_wr = nrm((DEPTH, 2, LRU_BLOCKS, LRU_BLOCK_W, LRU_BLOCK_W), LRU_BLOCK_W ** -0.5)
    lru_br = nrm((DEPTH, 2, LRU_WIDTH), 0.01)
    lru_wi = nrm((DEPTH, 2, LRU_BLOCKS, LRU_BLOCK_W, LRU_BLOCK_W), LRU_BLOCK_W ** -0.5)
    lru_bi = nrm((DEPTH, 2, LRU_WIDTH), 0.01)
    a_pow_c = jax.random.uniform(next(ks), (DEPTH, 2, LRU_WIDTH), F32, 0.9, 0.999)
    p = a_pow_c ** (1.0 / RGLRU_C)
    lru_lambda = jnp.log(p) - jnp.log1p(-p)
    gla_w2 = nrm((DEPTH, 2, GLA_GATE_RANK, GLA_HEADS * GLA_DK), GLA_GATE_RANK ** -0.5)
    gla_b2 = nrm((DEPTH, 2, GLA_HEADS * GLA_DK), 0.1)
    gla_norm_g = 1.0 + nrm((DEPTH, GLA_DV), 0.02)
    qk_norm_g = 1.0 + nrm((DEPTH, 2, HEAD_DIM), 0.02)
    win_sink = nrm((DEPTH, WIN_HEADS), 0.5)
    router_w = nrm((DEPTH, D_MODEL, N_EXPERTS), D_MODEL ** -0.5)
    router_bias = nrm((DEPTH, N_EXPERTS), 0.01)
    exp_w_gate = nrm((DEPTH, N_EXPERTS, D_MODEL, EXPERT_HIDDEN), D_MODEL ** -0.5)
    exp_w_up = nrm((DEPTH, N_EXPERTS, D_MODEL, EXPERT_HIDDEN), D_MODEL ** -0.5)
    exp_w_down = nrm((DEPTH, N_EXPERTS, EXPERT_HIDDEN, D_MODEL), EXPERT_HIDDEN ** -0.5)
    sh_w_gate = nrm((DEPTH, D_MODEL, SHARED_HIDDEN), D_MODEL ** -0.5)
    sh_w_up = nrm((DEPTH, D_MODEL, SHARED_HIDDEN), D_MODEL ** -0.5)
    sh_w_down = nrm((DEPTH, SHARED_HIDDEN, D_MODEL), SHARED_HIDDEN ** -0.5)
    return {'x': x, 'c': c, 'ctx': ctx, 'c_ctx': c_ctx, 'mod_w': mod_w, 'mod_b': mod_b,
            'norm_g': norm_g, 'w_in': w_in, 'w_out': w_out, 'conv_w': conv_w, 'conv_b': conv_b,
            'lru_wr': lru_wr, 'lru_br': lru_br, 'lru_wi': lru_wi, 'lru_bi': lru_bi,
            'lru_lambda': lru_lambda, 'gla_w2': gla_w2, 'gla_b2': gla_b2, 'gla_norm_g': gla_norm_g,
            'qk_norm_g': qk_norm_g, 'win_sink': win_sink, 'router_w': router_w,
            'router_bias': router_bias, 'exp_w_gate': exp_w_gate, 'exp_w_up': exp_w_up,
            'exp_w_down': exp_w_down, 'sh_w_gate': sh_w_gate, 'sh_w_up': sh_w_up,
            'sh_w_down': sh_w_down}


def reference(x, c, ctx, c_ctx, mod_w, mod_b, norm_g, w_in, w_out, conv_w, conv_b,
              lru_wr, lru_br, lru_wi, lru_bi, lru_lambda, gla_w2, gla_b2, gla_norm_g,
              qk_norm_g, win_sink, router_w, router_bias, exp_w_gate, exp_w_up, exp_w_down,
              sh_w_gate, sh_w_up, sh_w_down):
    bsz, n_lat, d = x.shape
    rope_cos, rope_sin = axial_rope_tables(n_lat)
    split_at = [int(v) for v in np.cumsum(IN_SPLITS)[:-1]]
    for layer in range(DEPTH):
        need_ctx = layer < DEPTH - 1
        m_lat = jnp.split((jax.nn.silu(c) @ mod_w[layer] + mod_b[layer])[:, None, :], 6, axis=-1)
        m_ctx = jnp.split(jax.nn.silu(c_ctx) @ mod_w[layer] + mod_b[layer], 6, axis=-1)
        g = norm_g[layer]
        h_lat = modulate(rms_norm(x, g[0]), m_lat[0], m_lat[1])
        h_ctx = modulate(rms_norm(ctx, g[0]), m_ctx[0], m_ctx[1])
        p_lat = jnp.split(h_lat @ w_in[layer], split_at, axis=-1)
        p_ctx = jnp.split(h_ctx @ w_in[layer], split_at, axis=-1)
        outs = [
            rglru_mixer(p_lat[0], p_lat[1], p_ctx[0], p_ctx[1], conv_w[layer], conv_b[layer],
                        lru_wr[layer], lru_br[layer], lru_wi[layer], lru_bi[layer], lru_lambda[layer], need_ctx),
            gla_mixer(p_lat[2:8], p_ctx[2:8], gla_w2[layer], gla_b2[layer], gla_norm_g[layer], need_ctx),
            global_attention(p_lat[8:11], p_ctx[8:11], qk_norm_g[layer], rope_cos, rope_sin, need_ctx),
            window_attention(p_lat[11:14], p_ctx[11:14], win_sink[layer], rope_cos, rope_sin, need_ctx),
        ]
        y_lat = jnp.concatenate([o[0] for o in outs], axis=-1) @ w_out[layer]
        x = x + m_lat[2] * rms_norm(y_lat, g[1])
        ffn_in = [modulate(rms_norm(x, g[2]), m_lat[3], m_lat[4]).reshape(-1, d)]
        if need_ctx:
            y_ctx = jnp.concatenate([o[1] for o in outs], axis=-1) @ w_out[layer]
            ctx = ctx + m_ctx[2] * rms_norm(y_ctx, g[1])
            ffn_in.append(modulate(rms_norm(ctx, g[2]), m_ctx[3], m_ctx[4]).reshape(-1, d))
        f = moe_ffn(jnp.concatenate(ffn_in, axis=0), router_w[layer], router_bias[layer],
                    exp_w_gate[layer], exp_w_up[layer], exp_w_down[layer],
                    sh_w_gate[layer], sh_w_up[layer], sh_w_down[layer])
        x = x + m_lat[5] * rms_norm(f[:bsz * n_lat].reshape(x.shape), g[3])
        if need_ctx:
            ctx = ctx + m_ctx[5] * rms_norm(f[bsz * n_lat:].reshape(ctx.shape), g[3])
    return x
```

```cpp
#include <hip/hip_runtime.h>
#include <cstdio>
#include <cstdint>

#define LAS __attribute__((address_space(3)))
#define GAS __attribute__((address_space(1)))
typedef unsigned short bf16_t;
typedef short bf16x8 __attribute__((ext_vector_type(8)));
typedef short s16x4 __attribute__((ext_vector_type(4)));
typedef float f32x4 __attribute__((ext_vector_type(4)));
typedef float f32x2 __attribute__((ext_vector_type(2)));
typedef float f32x16 __attribute__((ext_vector_type(16)));
typedef unsigned u32x4 __attribute__((ext_vector_type(4)));
typedef unsigned u32x2 __attribute__((ext_vector_type(2)));
#define DI __device__ __forceinline__

constexpr int DM = 2048, NB = 8, SEQ = 2048, CTXL = 256, NLAYER = 2;
constexpr int RL = NB * SEQ;
constexpr int RC = NB * CTXL;
constexpr int RT = RL + RC;
constexpr int INC = 4640;
constexpr int PC = 4864;
constexpr int C_AX = 0, C_AG = 512, C_BQ = 1024, C_BK = 1280, C_BV = 1536, C_BG = 2048, C_CQ = 2560, C_CK = 3072, C_CV = 3328, C_DQ = 3584, C_DK = 4096, C_DV = 4352, C_ZF = 4608, C_ZB = 4624;
constexpr int NEXP = 64, EH = 512, TOPK = 8;
#ifndef MOE_FP8_L0
#define MOE_FP8_L0 1
#endif
#ifndef MOE_FP8_L1
#define MOE_FP8_L1 1
#endif
constexpr bool MOE_FP8[2] = {MOE_FP8_L0 != 0, MOE_FP8_L1 != 0};
#ifndef MOE2_FP8_L0
#define MOE2_FP8_L0 1
#endif
#ifndef MOE2_FP8_L1
#define MOE2_FP8_L1 1
#endif
constexpr bool MOE2_FP8[2] = {MOE2_FP8_L0 != 0, MOE2_FP8_L1 != 0};
#ifndef IN1_FP8
#define IN1_FP8 1
#endif
#ifndef IN0_FP8
#define IN0_FP8 1
#endif
constexpr bool IN_FP8[2] = {IN0_FP8 != 0, IN1_FP8 != 0};
constexpr float SW_IN = 64.f;
#ifndef SP2_FP8
#define SP2_FP8 true
#endif
#ifndef SP2_BF16
#define SP2_BF16 true
#endif
constexpr float SW_GU = 64.f, SW_D = 32.f, S_ACT = 4.f, S_MO = 16.f;
constexpr int KT = SEQ + CTXL;
constexpr float RMS_EPS = 1e-6f;
constexpr int NCHUNK = KT / 64;

constexpr size_t MiB = 1u << 20;
constexpr size_t WS_CTL = 0;
constexpr size_t WS_MOD = 1 * MiB;
constexpr size_t WS_META = 2 * MiB;
constexpr size_t WS_GLAD = 10 * MiB;
constexpr size_t WS_SP = 10 * MiB + 768 * 1024;
constexpr size_t WS_ROWID = 9 * MiB;
constexpr size_t WS_RWS = 8 * MiB;
constexpr size_t WS_LRUW = 11 * MiB;
constexpr size_t WS_WIN = 12 * MiB;
constexpr size_t WS_WOUT = 50 * MiB;
constexpr size_t WS_WGU = 66 * MiB;
constexpr size_t WS_WD = 586 * MiB;
constexpr size_t WS_XC = 846 * MiB;
constexpr size_t WS_H = 862 * MiB;
constexpr size_t WS_Y = 934 * MiB;
constexpr size_t WS_ARENA = 1006 * MiB;
constexpr size_t AR_P = 0;
constexpr size_t AR_QC = 171 * MiB, AR_KC = 189 * MiB, AR_VC = 198 * MiB, AR_QD = 207 * MiB, AR_KD = 225 * MiB, AR_VD = 234 * MiB;
constexpr size_t AR_LA = 243 * MiB, AR_LB = 315 * MiB, AR_LH = 387 * MiB;
constexpr size_t AR_GS = 459 * MiB;
constexpr size_t AR_GOI = 531 * MiB;
constexpr size_t AR_GQE = 567 * MiB;
constexpr size_t AR_XLB = 672 * MiB;
constexpr size_t AR_GSB = AR_LB;
constexpr size_t AR_YO = 600 * MiB;
constexpr int SLOT_MAX = 163840 + RT;
constexpr size_t AR_ACT = 0;
constexpr size_t AR_MO = 178 * MiB;
constexpr size_t WS_END = WS_ARENA + 890 * MiB;
static_assert(AR_YO + 72 * MiB <= 890 * MiB, "arena");

constexpr int CW_TMO = 0;
constexpr int CW_BAR = 4096;
constexpr int CW_QUEUE = 8192;
constexpr size_t MT_BLKCNT = 0;
constexpr size_t MT_TOKE = 64 * 1024;
constexpr size_t MT_TOKR = MT_TOKE + 589824;
constexpr size_t MT_TOKG = MT_TOKR + 589824;
constexpr size_t MT_TOKS = MT_TOKG + 589824;
constexpr size_t MT_ROWOFF = MT_TOKS + 589824;
constexpr size_t MT_ROWW = MT_ROWOFF + 729088;
static_assert(MT_ROWW + 729088 <= 8 * MiB, "meta");

constexpr int RING_BYTES = 131072;
constexpr int TBL_OFF = RING_BYTES;
constexpr int MISC_OFF = RING_BYTES + 4096;
constexpr int LDS_BYTES = 147456;

#define MFMA16(a, b, c) __builtin_amdgcn_mfma_f32_16x16x32_bf16((a), (b), (c), 0, 0, 0)
typedef __bf16 bf16x2v __attribute__((ext_vector_type(2)));
DI unsigned cvt_pk_bf16(float lo, float hi) { f32x2 v = {lo, hi}; bf16x2v b = __builtin_convertvector(v, bf16x2v); return __builtin_bit_cast(unsigned, b); }
DI unsigned f2bf(float f) { return cvt_pk_bf16(f, 0.0f) & 0xffffu; }
DI unsigned pk2(float lo, float hi) { return cvt_pk_bf16(lo, hi); }
DI float bf2f(unsigned short b) { return __builtin_bit_cast(float, ((unsigned)b) << 16); }
DI float bflo(unsigned w) { return __builtin_bit_cast(float, w << 16); }
DI float bfhi(unsigned w) { return __builtin_bit_cast(float, w & 0xffff0000u); }
DI float rdlane(float x, int l) { return __builtin_bit_cast(float, __builtin_amdgcn_readlane(__builtin_bit_cast(int, x), l)); }
#define DPP_ADD(v_, ctrl_) (v_) += __builtin_bit_cast(float, __builtin_amdgcn_update_dpp(0, __builtin_bit_cast(int, (v_)), (ctrl_), 0xf, 0xf, true))
DI float wave_sum(float v) {
    DPP_ADD(v, 0xB1);
    DPP_ADD(v, 0x4E);
    DPP_ADD(v, 0x141);
    DPP_ADD(v, 0x140);
    return (rdlane(v, 0) + rdlane(v, 16)) + (rdlane(v, 32) + rdlane(v, 48));
}
DI float sigmoidf_(float x) { return 1.0f / (1.0f + __expf(-x)); }
DI float siluf_(float x) { return x / (1.0f + __expf(-x)); }
DI float siluf_fast(float x) { return x * __builtin_amdgcn_rcpf(1.0f + __expf(-x)); }
#define LDS_WAIT() asm volatile("s_waitcnt lgkmcnt(0)" ::: "memory")
#define VM_WAIT() asm volatile("s_waitcnt vmcnt(0)" ::: "memory")

#define XB_TMO      128
#define XB_XCNT(j)  (256  + 64 * (j))
#define XB_XSUB(j)  (1280 + 64 * (j))
#define XB_XGEN(j)  (2304 + 64 * (j))
#define XB_TOP      3328
#define XB_TOPGEN   3392
#define XCD_BAR_WORDS 3456
#define XB_SPIN_CAP (1u << 18)
__device__ __forceinline__ unsigned xb_ld(unsigned* p)              { return __hip_atomic_load(p, __ATOMIC_RELAXED, __HIP_MEMORY_SCOPE_AGENT); }
__device__ __forceinline__ unsigned xb_add(unsigned* p, unsigned v) { return __hip_atomic_fetch_add(p, v, __ATOMIC_RELAXED, __HIP_MEMORY_SCOPE_AGENT); }
__device__ __forceinline__ unsigned xb_xcc_id() { return (unsigned)__builtin_amdgcn_s_getreg((3 << 11) | 20) & 0xFu; }
#define XB_SPIN(cond, bar) do { unsigned _sp = 0; while (cond) { __builtin_amdgcn_s_sleep(1); \
    if ((++_sp & 255u) == 0u) { if (xb_ld(&(bar)[XB_TMO])) break; if (_sp > XB_SPIN_CAP) { atomicAdd(&(bar)[XB_TMO], 1u); break; } } } } while (0)
struct XcdBarrier { unsigned* bar; unsigned x; volatile LAS unsigned* st; };
__device__ __forceinline__ XcdBarrier xcd_barrier_post(unsigned* bar, volatile LAS unsigned* st) {
    XcdBarrier b; b.bar = bar; b.x = xb_xcc_id(); b.st = st;
    if (threadIdx.x == 0) (void)xb_add(&bar[XB_XCNT(b.x)], 1u);
    return b;
}
__device__ __forceinline__ void xcd_barrier_complete(unsigned* bar, unsigned x, unsigned& nloc, unsigned& nx) {
    const unsigned G = gridDim.x * gridDim.y * gridDim.z;
    unsigned sum, cnt, mine, sp = 0u;
    for (;;) {
        sum = 0u; cnt = 0u; mine = 0u;
#pragma unroll
        for (unsigned j = 0; j < 16; ++j) { const unsigned c = xb_ld(&bar[XB_XCNT(j)]); sum += c; cnt += (c > 0u) ? 1u : 0u; mine = (j == x) ? c : mine; }
        if (sum == G) break;
        __builtin_amdgcn_s_sleep(1);
        if ((++sp & 255u) == 0u) { if (xb_ld(&bar[XB_TMO])) break; if (sp > XB_SPIN_CAP) { atomicAdd(&bar[XB_TMO], 1u); break; } }
    }
    nloc = mine > 0u ? mine : 1u; nx = cnt > 0u ? cnt : 1u;
}
__device__ __forceinline__ void xcd_barrier(const XcdBarrier& b, int tid_) {
    asm volatile("s_waitcnt vmcnt(0)" ::: "memory");
    __syncthreads();
    if (tid_ == 0) {
        unsigned* bar = b.bar;
        __builtin_amdgcn_s_waitcnt(0);
        unsigned nloc = b.st[0], nx = b.st[1];
        if (nloc == 0u) { xcd_barrier_complete(bar, b.x, nloc, nx); b.st[0] = nloc; b.st[1] = nx; }
        const unsigned old = xb_add(&bar[XB_XSUB(b.x)], 1u);
        const unsigned gen = old / nloc;
        if (old + 1u == (gen + 1u) * nloc) {
            __builtin_amdgcn_fence(__ATOMIC_RELEASE, "agent");
            asm volatile("s_waitcnt vmcnt(0)" ::: "memory");
            const unsigned og = xb_add(&bar[XB_TOP], 1u);
            const unsigned tg = og / nx;
            if (og + 1u == (tg + 1u) * nx) xb_add(&bar[XB_TOPGEN], 1u);
            else XB_SPIN(xb_ld(&bar[XB_TOPGEN]) == tg, bar);
            __builtin_amdgcn_fence(__ATOMIC_ACQUIRE, "agent");
            xb_add(&bar[XB_XGEN(b.x)], 1u);
            asm volatile("s_waitcnt vmcnt(0)" ::: "memory");
        } else {
            XB_SPIN(xb_ld(&bar[XB_XGEN(b.x)]) == gen, bar);
            __builtin_amdgcn_fence(__ATOMIC_ACQUIRE, "agent");
            asm volatile("s_waitcnt vmcnt(0)" ::: "memory");
        }
    }
    __syncthreads();
}

namespace pg8 {
typedef int v8i __attribute__((ext_vector_type(8)));
typedef int v4i __attribute__((ext_vector_type(4)));
DI v8i cat8(bf16x8 lo, bf16x8 hi) { const v4i a = __builtin_bit_cast(v4i, lo), b = __builtin_bit_cast(v4i, hi); return __builtin_shufflevector(a, b, 0, 1, 2, 3, 4, 5, 6, 7); }
constexpr int BM = 256, BK = 64, HALF = 128, HTB = HALF * BK * 2, STAGE_BYTES = 8 * HTB, NXCD = 8, WGM = 8;
DI int lds_byte(int r, int c) { const int st = (r >> 4) * 2 + (c >> 5), rr = r & 15, cc = c & 31, ob = rr * 64 + cc * 2; return st * 1024 + (ob ^ (((ob >> 9) & 1) << 5)); }
DI void stage_rc(int b, int& R, int& C) { const int st = b / 1024, sb = b % 1024, swz = sb ^ (((sb >> 9) & 1) << 5); R = (st >> 1) * 16 + swz / 64; C = (st & 1) * 32 + (swz % 64) / 2; }
DI int perm32(int rho) { const int n = rho >> 4, i = rho & 15; return 8 * (i >> 2) + 4 * n + (i & 3); }

struct Unit { int pm, pn, pb, e; };

struct TileOrder {
    int nM, nN, nwg, G, c;
    DI void init(int nM_, int nN_, int G_, int c_) { nM = nM_; nN = nN_; nwg = nM * nN; G = G_; c = c_; }
    DI bool tile(int i, int& pm, int& pn) const {
        const long L = (long)i * G + c; if (L >= nwg) return false;
        int wgid = (int)L; { const int q = nwg / NXCD, r = nwg % NXCD, xcd = wgid % NXCD, off = wgid / NXCD; wgid = (xcd < r ? xcd * (q + 1) : r * (q + 1) + (xcd - r) * q) + off; }
        const int nig = WGM * nN, gid = wgid / nig, fm = gid * WGM, gsz = (nM - fm) < WGM ? (nM - fm) : WGM;
        pm = fm + ((wgid % nig) % gsz); pn = (wgid % nig) / gsz; return true;
    }
};
struct DenseSched {
    TileOrder T;
    DI bool next(int i, Unit& u) const { if (!T.tile(i, u.pm, u.pn)) return false; u.pb = u.pn; u.e = 0; return true; }
};
struct MoeSched {
    TileOrder T; const LAS unsigned short* tile_e;
    DI bool next(int i, Unit& u) const { if (!T.tile(i, u.pm, u.pn)) return false; u.e = (int)__builtin_amdgcn_readfirstlane((int)tile_e[u.pm]); u.pb = u.e * T.nN + u.pn; return true; }
};

struct EpiBf16 {
    static constexpr bool PERM = true;
    bf16_t* O; int ldc; float scale;
    DI void operator()(const f32x4 (&acc)[2][2][4][2], const Unit& u, int wr, int wc, int fr, int fq) const {
        const int row0 = u.pm * BM + wr * 64 + fr; const int col0 = u.pn * BM + wc * 32 + 8 * fq;
#pragma unroll
        for (int ai = 0; ai < 2; ++ai)
#pragma unroll
            for (int m = 0; m < 4; ++m) { const int row = row0 + ai * HALF + m * 16; bf16_t* rowp = O + (size_t)row * ldc + col0; const float rs = scale;
#pragma unroll
                for (int bj = 0; bj < 2; ++bj) { const f32x4 v0 = acc[ai][bj][m][0] * rs, v1 = acc[ai][bj][m][1] * rs;
                    u32x4 w; w.x = cvt_pk_bf16(v0[0], v0[1]); w.y = cvt_pk_bf16(v0[2], v0[3]); w.z = cvt_pk_bf16(v1[0], v1[1]); w.w = cvt_pk_bf16(v1[2], v1[3]);
                    *(u32x4*)(rowp + bj * HALF) = w; } }
    }
};
DI unsigned pk4_fp8(float a, float b, float c, float d) {
    a = fminf(fmaxf(a, -448.f), 448.f); b = fminf(fmaxf(b, -448.f), 448.f); c = fminf(fmaxf(c, -448.f), 448.f); d = fminf(fmaxf(d, -448.f), 448.f);
    int w = 0; w = __builtin_amdgcn_cvt_pk_fp8_f32(a, b, w, false); w = __builtin_amdgcn_cvt_pk_fp8_f32(c, d, w, true); return (unsigned)w; }
struct EpiFp8 {
    static constexpr bool PERM = true;
    unsigned char* O; int ldc; float scale;
    DI void operator()(const f32x4 (&acc)[2][2][4][2], const Unit& u, int wr, int wc, int fr, int fq) const {
        const int odd = fq & 1; const int row0 = u.pm * BM + wr * 64 + fr + 16 * odd; const int col0 = u.pn * BM + wc * 32 + 8 * (fq - odd);
#pragma unroll
        for (int ai = 0; ai < 2; ++ai)
#pragma unroll
            for (int bj = 0; bj < 2; ++bj)
#pragma unroll
                for (int mp = 0; mp < 4; mp += 2) {
                    const f32x4 a0 = acc[ai][bj][mp][0] * scale, a1 = acc[ai][bj][mp][1] * scale, b0 = acc[ai][bj][mp + 1][0] * scale, b1 = acc[ai][bj][mp + 1][1] * scale;
                    const unsigned ax = pk4_fp8(a0[0], a0[1], a0[2], a0[3]), ay = pk4_fp8(a1[0], a1[1], a1[2], a1[3]), bx = pk4_fp8(b0[0], b0[1], b0[2], b0[3]), by = pk4_fp8(b1[0], b1[1], b1[2], b1[3]);
                    const auto rx = __builtin_amdgcn_permlane16_swap(ax, bx, false, false); const auto ry = __builtin_amdgcn_permlane16_swap(ay, by, false, false);
                    *(u32x4*)(O + (size_t)(row0 + ai * HALF + mp * 16) * ldc + col0 + bj * HALF) = (u32x4){rx[0], ry[0], rx[1], ry[1]}; }
    }
};
template <bool F8OUT> struct EpiSwiGlu {
    static constexpr bool PERM = false;
    void* ACT; float iscale, oscale;
    DI void operator()(const f32x4 (&acc)[2][2][4][2], const Unit& u, int wr, int wc, int fr, int fq) const {
        const int row0 = u.pm * BM + wr * 64 + fr;
        if constexpr (F8OUT) {
#pragma unroll
            for (int ai = 0; ai < 2; ++ai)
#pragma unroll
                for (int bj = 0; bj < 2; ++bj) { unsigned d[4];
#pragma unroll
                    for (int m = 0; m < 4; ++m) { const f32x4 g = acc[ai][bj][m][0] * iscale, up = acc[ai][bj][m][1] * iscale;
                        d[m] = pk4_fp8(siluf_fast(g[0]) * up[0] * oscale, siluf_fast(g[1]) * up[1] * oscale, siluf_fast(g[2]) * up[2] * oscale, siluf_fast(g[3]) * up[3] * oscale); }
                    const auto s1 = __builtin_amdgcn_permlane16_swap(d[0], d[1], false, false); const auto s2 = __builtin_amdgcn_permlane16_swap(d[2], d[3], false, false);
                    const auto t0 = __builtin_amdgcn_permlane32_swap(s1[0], s2[0], false, false); const auto t1 = __builtin_amdgcn_permlane32_swap(s1[1], s2[1], false, false);
                    *(u32x4*)((unsigned char*)ACT + (size_t)(row0 + ai * HALF + fq * 16) * EH + 16 * (8 * u.pn + 4 * bj + wc)) = (u32x4){t0[0], t1[0], t0[1], t1[1]}; }
            return;
        }
#pragma unroll
        for (int ai = 0; ai < 2; ++ai)
#pragma unroll
            for (int m = 0; m < 4; ++m) { const size_t rowi = (size_t)(row0 + ai * HALF + m * 16) * EH;
#pragma unroll
                for (int bj = 0; bj < 2; ++bj) { const int hid = 16 * (8 * u.pn + 4 * bj + wc) + 4 * fq; const f32x4 g = acc[ai][bj][m][0] * iscale, up = acc[ai][bj][m][1] * iscale;
                    float a0 = siluf_fast(g[0]) * up[0], a1 = siluf_fast(g[1]) * up[1], a2 = siluf_fast(g[2]) * up[2], a3 = siluf_fast(g[3]) * up[3];
                    if constexpr (F8OUT) { *(unsigned*)((unsigned char*)ACT + rowi + hid) = pk4_fp8(a0 * oscale, a1 * oscale, a2 * oscale, a3 * oscale); }
                    else { u32x2 w; w.x = cvt_pk_bf16(a0, a1); w.y = cvt_pk_bf16(a2, a3); *(u32x2*)((bf16_t*)ACT + rowi + hid) = w; } } }
    }
};

template <int K, int EB, int GMODE, bool SP2, class Epi, class Sched>
DI void gemm_phase(int tid_in, LAS unsigned char* lds, const bf16_t* A, const bf16_t* Bt, const LAS unsigned short* lrows, const Sched& S, const Epi& E) {
    constexpr bool GATHER = GMODE != 0;
    int tid = tid_in; asm volatile("" : "+v"(tid));
    const int wid = __builtin_amdgcn_readfirstlane(tid >> 6), lane = tid & 63, wr = wid >> 2, wc = wid & 3, fr = lane & 15, fq = lane >> 4;
    constexpr int KB = K * EB;
    constexpr int nt = KB / 128;
    unsigned voffA[2], voffB[2];
#pragma unroll
    for (int i = 0; i < 2; ++i) { int R, C; stage_rc(tid * 16 + i * 8192, R, C); const int Rb = Epi::PERM ? ((R & ~31) + perm32(R & 31)) : R;
        voffA[i] = (unsigned)(R * KB + C * 2); voffB[i] = (unsigned)(Rb * KB + C * 2); }
    constexpr size_t kstep = (size_t)(BK * 2);
    constexpr size_t hstep = (size_t)HALF * KB;
    constexpr size_t tstep = 2 * hstep;
    const unsigned ldsw = (unsigned)wid * 1024u;
    const int aoff = lds_byte(wr * 64 + fr, fq * 8), boff = lds_byte(wc * 32 + fr, fq * 8);
#define PG8_SA(b, h) (((b) * 2 + (h)) * HTB)
#define PG8_SB(b, h) ((4 + (b) * 2 + (h)) * HTB)
#define PG8_STAGE(bufoff, gbase, voff) do { _Pragma("unroll") for (int _i = 0; _i < 2; ++_i) \
        __builtin_amdgcn_global_load_lds((const unsigned*)((const char*)(gbase) + (voff)[_i]), (LAS unsigned*)(lds + (bufoff) + ldsw + _i * 8192), 16, 0, 0); } while (0)
#define PG8_STAGE_A(bufoff, ab, ao, h, koff) do { if constexpr (GATHER) { PG8_STAGE(bufoff, (const char*)A + (koff), (ao)[h]); } else { PG8_STAGE(bufoff, (ab) + (h) * hstep + (koff), voffA); } } while (0)
#define PG8_LDA(dst, b, h) do { _Pragma("unroll") for (int m = 0; m < 4; ++m) { if constexpr (EB == 2) { _Pragma("unroll") for (int k = 0; k < 2; ++k) dst[m][k] = *(const LAS bf16x8*)(lds + PG8_SA(b, h) + aoff + m * 2048 + k * 1024); } \
        else { dst##8[m] = cat8(*(const LAS bf16x8*)(lds + PG8_SA(b, h) + aoff + m * 2048), *(const LAS bf16x8*)(lds + PG8_SA(b, h) + aoff + m * 2048 + 1024)); } } } while (0)
#define PG8_LDB(dst, b, h) do { _Pragma("unroll") for (int n = 0; n < 2; ++n) { if constexpr (EB == 2) { _Pragma("unroll") for (int k = 0; k < 2; ++k) dst[n][k] = *(const LAS bf16x8*)(lds + PG8_SB(b, h) + boff + n * 2048 + k * 1024); } \
        else { dst##8[n] = cat8(*(const LAS bf16x8*)(lds + PG8_SB(b, h) + boff + n * 2048), *(const LAS bf16x8*)(lds + PG8_SB(b, h) + boff + n * 2048 + 1024)); } } } while (0)
#define PG8_MMA(ai, bj, At, Bt_) do { __builtin_amdgcn_s_setprio(1); _Pragma("unroll") for (int m = 0; m < 4; ++m) _Pragma("unroll") for (int n = 0; n < 2; ++n) { \
        if constexpr (EB == 2) { _Pragma("unroll") for (int k = 0; k < 2; ++k) acc[ai][bj][m][n] = __builtin_amdgcn_mfma_f32_16x16x32_bf16(Bt_[n][k], At[m][k], acc[ai][bj][m][n], 0, 0, 0); } \
        else { acc[ai][bj][m][n] = __builtin_amdgcn_mfma_scale_f32_16x16x128_f8f6f4(Bt_##8[n], At##8[m], acc[ai][bj][m][n], 0, 0, 0, 0, 0, 0); } } \
        __builtin_amdgcn_s_setprio(0); } while (0)
#define PG8_WAIT_V(n) asm volatile("s_waitcnt vmcnt(" #n ")" ::: "memory")
#define PG8_WAIT_L(n) asm volatile("s_waitcnt lgkmcnt(" #n ")" ::: "memory")
#define PG8_BAR __builtin_amdgcn_s_barrier()
#define PG8_SCHED __builtin_amdgcn_sched_barrier(0)
    Unit cur, nxt; int ui = 0;
    if (!S.next(0, cur)) return;
    f32x4 acc[2][2][4][2];
#pragma unroll
    for (int a = 0; a < 2; ++a)
#pragma unroll
        for (int b = 0; b < 2; ++b)
#pragma unroll
            for (int m = 0; m < 4; ++m)
#pragma unroll
                for (int n = 0; n < 2; ++n) acc[a][b][m][n] = (f32x4){0.f, 0.f, 0.f, 0.f};
    bf16x8 At[4][2], B0[2][2], B1[2][2];
    v8i At8[4], B08[2], B18[2];
    unsigned gA[2][2], gN[2][2];
    if constexpr (GATHER) {
#pragma unroll
        for (int i = 0; i < 2; ++i) { int R, C; stage_rc(tid * 16 + i * 8192, R, C);
#pragma unroll
            for (int h = 0; h < 2; ++h) gA[h][i] = (GMODE == 1 ? (unsigned)lrows[h * HALF + R] : (unsigned)(cur.pm * BM + h * HALF + R)) * (unsigned)KB + (unsigned)C * 2u; }
        asm volatile("" : "+v"(gA[0][0]), "+v"(gA[0][1]), "+v"(gA[1][0]), "+v"(gA[1][1]));
    } else {
#pragma unroll
        for (int h = 0; h < 2; ++h)
#pragma unroll
            for (int i = 0; i < 2; ++i) { gA[h][i] = 0u; gN[h][i] = 0u; }
    }
    const char* cA = (const char*)A + (size_t)cur.pm * tstep; const char* cB = (const char*)Bt + (size_t)cur.pb * tstep;
    if constexpr (SP2) {
        PG8_STAGE(PG8_SB(0, 0), cB, voffB); PG8_STAGE(PG8_SB(0, 1), cB + hstep, voffB); PG8_STAGE_A(PG8_SA(0, 0), cA, gA, 0, 0); PG8_STAGE_A(PG8_SA(0, 1), cA, gA, 1, 0);
        if (wr == 1) PG8_BAR;
        PG8_WAIT_V(2); PG8_BAR;
        PG8_STAGE(PG8_SB(1, 0), cB + kstep, voffB); PG8_STAGE_A(PG8_SA(1, 0), cA, gA, 0, kstep); PG8_STAGE(PG8_SB(1, 1), cB + hstep + kstep, voffB);
        PG8_WAIT_V(6); PG8_BAR;
    } else {
    PG8_STAGE(PG8_SB(0, 0), cB, voffB); PG8_STAGE_A(PG8_SA(0, 0), cA, gA, 0, 0); PG8_STAGE(PG8_SB(0, 1), cB + hstep, voffB); PG8_STAGE_A(PG8_SA(0, 1), cA, gA, 1, 0);
    if (wr == 1) PG8_BAR;
    PG8_WAIT_V(4); PG8_BAR;
    PG8_STAGE(PG8_SB(1, 0), cB + kstep, voffB); PG8_STAGE_A(PG8_SA(1, 0), cA, gA, 0, kstep); PG8_STAGE(PG8_SB(1, 1), cB + hstep + kstep, voffB);
    PG8_WAIT_V(6); PG8_BAR;
    }
    for (;;) {
        const bool has_next = S.next(ui + 1, nxt);
        const char* nA = has_next ? (const char*)A + (size_t)nxt.pm * tstep : cA; const char* nB = has_next ? (const char*)Bt + (size_t)nxt.pb * tstep : cB;
        if constexpr (GATHER) {
            const int npm = has_next ? nxt.pm : cur.pm; int tz = tid; asm volatile("" : "+v"(tz));
#pragma unroll
            for (int i = 0; i < 2; ++i) { int R, C; stage_rc(tz * 16 + i * 8192, R, C);
#pragma unroll
                for (int h = 0; h < 2; ++h) gN[h][i] = (GMODE == 1 ? (unsigned)lrows[(has_next ? ui + 1 : ui) * BM + h * HALF + R] : (unsigned)(npm * BM + h * HALF + R)) * (unsigned)KB + (unsigned)C * 2u; }
            asm volatile("" : "+v"(gN[0][0]), "+v"(gN[0][1]), "+v"(gN[1][0]), "+v"(gN[1][1]));
        }
        int ntv = nt; asm volatile("" : "+s"(ntv));
        for (int t = 0; t < ntv; t += 2) {
            const bool last = (t == ntv - 2);
            const size_t k1 = (size_t)(t + 1) * kstep;
            const char* a2 = last ? nA : cA; const char* b2 = last ? nB : cB + (size_t)(t + 2) * kstep;
            const size_t ka2 = last ? 0 : (size_t)(t + 2) * kstep;
            const char* b3 = b2 + kstep; const size_t ka3 = ka2 + kstep;
            if constexpr (SP2) {
            PG8_LDB(B0, 0, 0); PG8_LDB(B1, 0, 1); PG8_SCHED; PG8_LDA(At, 0, 0); PG8_STAGE_A(PG8_SA(1, 1), cA, gA, 1, k1);
            if constexpr (GATHER) { if (last) { gA[0][0] = gN[0][0]; gA[0][1] = gN[0][1]; gA[1][0] = gN[1][0]; gA[1][1] = gN[1][1]; } }
            PG8_WAIT_V(8); PG8_WAIT_L(0); PG8_BAR; PG8_MMA(0, 0, At, B0); PG8_MMA(0, 1, At, B1); PG8_BAR; PG8_SCHED;
            PG8_LDA(At, 0, 1); PG8_STAGE(PG8_SB(0, 0), b2, voffB); PG8_STAGE(PG8_SB(0, 1), b2 + hstep, voffB); PG8_STAGE_A(PG8_SA(0, 0), a2, gA, 0, ka2);
            PG8_WAIT_V(8); PG8_WAIT_L(0); PG8_BAR; PG8_MMA(1, 0, At, B0); PG8_MMA(1, 1, At, B1); PG8_BAR; PG8_SCHED;
            PG8_LDB(B0, 1, 0); PG8_LDB(B1, 1, 1); PG8_SCHED; PG8_LDA(At, 1, 0); PG8_STAGE_A(PG8_SA(0, 1), a2, gA, 1, ka2);
            PG8_WAIT_V(8); PG8_WAIT_L(0); PG8_BAR; PG8_MMA(0, 0, At, B0); PG8_MMA(0, 1, At, B1); PG8_BAR; PG8_SCHED;
            PG8_LDA(At, 1, 1); PG8_STAGE(PG8_SB(1, 0), b3, voffB); PG8_STAGE(PG8_SB(1, 1), b3 + hstep, voffB); PG8_STAGE_A(PG8_SA(1, 0), a2, gA, 0, ka3);
            PG8_WAIT_V(8); PG8_WAIT_L(0); PG8_BAR; PG8_MMA(1, 0, At, B0); PG8_MMA(1, 1, At, B1); PG8_BAR; PG8_SCHED;
            } else {
            PG8_LDB(B0, 0, 0); PG8_SCHED; PG8_LDA(At, 0, 0); PG8_STAGE_A(PG8_SA(1, 1), cA, gA, 1, k1);
            if constexpr (GATHER) { if (last) { gA[0][0] = gN[0][0]; gA[0][1] = gN[0][1]; gA[1][0] = gN[1][0]; gA[1][1] = gN[1][1]; } }
            PG8_WAIT_L(8); PG8_BAR; PG8_WAIT_L(0); PG8_MMA(0, 0, At, B0); PG8_BAR; PG8_SCHED;
            PG8_LDB(B1, 0, 1); PG8_STAGE(PG8_SB(0, 0), b2, voffB);
            PG8_BAR; PG8_WAIT_L(0); PG8_MMA(0, 1, At, B1); PG8_BAR;
            PG8_LDA(At, 0, 1); PG8_STAGE_A(PG8_SA(0, 0), a2, gA, 0, ka2);
            PG8_BAR; PG8_WAIT_L(0); PG8_MMA(1, 0, At, B0); PG8_BAR; PG8_SCHED;
            PG8_STAGE(PG8_SB(0, 1), b2 + hstep, voffB);
            PG8_WAIT_V(6); PG8_BAR; PG8_MMA(1, 1, At, B1); PG8_BAR;
            PG8_LDB(B0, 1, 0); PG8_SCHED; PG8_LDA(At, 1, 0); PG8_STAGE_A(PG8_SA(0, 1), a2, gA, 1, ka2);
            PG8_WAIT_L(8); PG8_BAR; PG8_WAIT_L(0); PG8_MMA(0, 0, At, B0); PG8_BAR; PG8_SCHED;
            PG8_LDB(B1, 1, 1); PG8_STAGE(PG8_SB(1, 0), b3, voffB);
            PG8_BAR; PG8_WAIT_L(0); PG8_MMA(0, 1, At, B1); PG8_BAR;
            PG8_LDA(At, 1, 1); PG8_STAGE_A(PG8_SA(1, 0), a2, gA, 0, ka3);
            PG8_BAR; PG8_WAIT_L(0); PG8_MMA(1, 0, At, B0); PG8_BAR; PG8_SCHED;
            PG8_STAGE(PG8_SB(1, 1), b3 + hstep, voffB);
            PG8_WAIT_V(6); PG8_BAR; PG8_MMA(1, 1, At, B1); PG8_BAR;
            }
        }
        E(acc, cur, wr, wc, fr, fq);
        if (!has_next) break;
#pragma unroll
        for (int a = 0; a < 2; ++a)
#pragma unroll
            for (int b = 0; b < 2; ++b)
#pragma unroll
                for (int m = 0; m < 4; ++m)
#pragma unroll
                    for (int n = 0; n < 2; ++n) acc[a][b][m][n] = (f32x4){0.f, 0.f, 0.f, 0.f};
        cur = nxt; cA = nA; cB = nB; ++ui;
    }
    PG8_WAIT_V(0);
    if (wr == 0) PG8_BAR;
    PG8_BAR;
#undef PG8_SA
#undef PG8_SB
#undef PG8_STAGE
#undef PG8_STAGE_A
#undef PG8_LDA
#undef PG8_LDB
#undef PG8_MMA
#undef PG8_WAIT_V
#undef PG8_WAIT_L
#undef PG8_BAR
#undef PG8_SCHED
}
}

namespace att {
constexpr int D = 128, NW = 8, QBLK = 32, KVBLK = 64;
constexpr float SCALE = 0.088388347648318440f;
constexpr float THR = 8.f;
constexpr int LDQ = D, LDK = D, LDO = DM;
constexpr size_t SHM_V = KVBLK * D * 2, SHM_K = KVBLK * D * 2, SHM_ATTN = 2 * SHM_V + 2 * SHM_K + NW * 64 * 4;
#define KSWZ(row, colB) ((row) * 256 + ((colB) ^ (((row) & 7) << 4)))
#define SBAR() __builtin_amdgcn_sched_barrier(0)
DI int crow(int r, int hi) { return (r & 3) + 8 * (r >> 2) + 4 * hi; }
DI unsigned cvtpk(float lo, float hi) { return cvt_pk_bf16(lo, hi); }

DI void wmask(f32x16& p0, f32x16& p1, int qp, int kb, int hi) {
#pragma unroll
    for (int r = 0; r < 16; ++r) { const int k0 = kb + crow(r, hi) - qp; const int k1 = k0 + 32;
        p0[r] = (k0 >= -128 && k0 <= 128) ? p0[r] : -1e30f; p1[r] = (k1 >= -128 && k1 <= 128) ? p1[r] : -1e30f; }
}
DI void partialSM(f32x16& p0, f32x16& p1, float& m_reg, float& mn, float& alpha) {
    constexpr float C = SCALE * 1.4426950408889634f;
    float pmax = p0[0];
#pragma unroll
    for (int r = 1; r < 16; ++r) pmax = fmaxf(pmax, p0[r]);
#pragma unroll
    for (int r = 0; r < 16; ++r) pmax = fmaxf(pmax, p1[r]);
    { auto rr = __builtin_amdgcn_permlane32_swap(__float_as_uint(pmax), __float_as_uint(pmax), false, false);
      pmax = fmaxf(__uint_as_float(rr[0]), __uint_as_float(rr[1])); }
    if (__builtin_expect(__all(pmax - m_reg <= THR / SCALE), 1)) { mn = m_reg; alpha = 1.f; }
    else { mn = fmaxf(m_reg, pmax); alpha = __builtin_amdgcn_exp2f((m_reg - mn) * C); m_reg = mn; }
    float mnC = -mn * C;
#pragma unroll
    for (int r = 0; r < 16; ++r) p0[r] = fmaf(p0[r], C, mnC);
#pragma unroll
    for (int r = 0; r < 16; ++r) p1[r] = fmaf(p1[r], C, mnC);
#pragma unroll
    for (int r = 0; r < 16; ++r) p0[r] = __builtin_amdgcn_exp2f(p0[r]);
}
DI void finishSM(f32x16& p0, f32x16& p1, float alpha, float& l_reg, bf16x8& pa0, bf16x8& pa1, bf16x8& pa2, bf16x8& pa3) {
#pragma unroll
    for (int r = 0; r < 16; ++r) p1[r] = __builtin_amdgcn_exp2f(p1[r]);
    float ps = 0;
#pragma unroll
    for (int r = 0; r < 16; ++r) ps += p0[r];
#pragma unroll
    for (int r = 0; r < 16; ++r) ps += p1[r];
    { auto rr = __builtin_amdgcn_permlane32_swap(__float_as_uint(ps), __float_as_uint(ps), false, false);
      ps = __uint_as_float(rr[0]) + __uint_as_float(rr[1]); }
    l_reg = l_reg * alpha + ps;
#define PK4(P, BASE, OUT) do { unsigned a0 = cvtpk(P[BASE + 0], P[BASE + 1]), a1 = cvtpk(P[BASE + 2], P[BASE + 3]);   \
    unsigned b0 = cvtpk(P[BASE + 4], P[BASE + 5]), b1 = cvtpk(P[BASE + 6], P[BASE + 7]);                              \
    auto r0 = __builtin_amdgcn_permlane32_swap(a0, b0, false, false); auto r1 = __builtin_amdgcn_permlane32_swap(a1, b1, false, false); \
    u32x4 w = {r0[0], r1[0], r0[1], r1[1]}; OUT = *reinterpret_cast<bf16x8*>(&w); } while (0)
    PK4(p0, 0, pa0); PK4(p0, 8, pa1); PK4(p1, 0, pa2); PK4(p1, 8, pa3);
#undef PK4
}
DI void qkt(f32x16& p0, f32x16& p1, const char* Ks, const bf16x8* qr, int r32, int hi) {
    p0 = f32x16{}; p1 = f32x16{};
#pragma unroll
    for (int d0 = 0; d0 < 8; ++d0) { int cb = (d0 * 16 + hi * 8) * 2;
        bf16x8 b0 = *reinterpret_cast<const bf16x8*>(Ks + KSWZ(r32, cb));
        bf16x8 b1 = *reinterpret_cast<const bf16x8*>(Ks + KSWZ(32 + r32, cb));
        p0 = __builtin_amdgcn_mfma_f32_32x32x16_bf16(b0, qr[d0], p0, 0, 0, 0);
        p1 = __builtin_amdgcn_mfma_f32_32x32x16_bf16(b1, qr[d0], p1, 0, 0, 0); }
}
DI int v_st(int k, int c) { const int kk = (k & ~0xC) | ((k & 4) << 1) | ((k & 8) >> 1); return ((kk >> 3) * 4 + (c >> 5)) * 512 + ((kk & 7) * 32 + (c & 31)) * 2; }
DI int v_rd_base(int lane) { return ((lane & 3) << 3) | (((lane >> 2) & 3) << 6) | (((lane >> 4) & 1) << 5) | (((lane >> 5) & 1) << 8); }
constexpr int v_rd_off(int d0, int ks, int half) { return d0 * 512 + ks * 4096 + half * 2048; }
template <int OFF> DI s16x4 tr_read(int vb) { s16x4 r; asm volatile("ds_read_b64_tr_b16 %0, %1 offset:%2" : "=&v"(r) : "v"(vb), "i"(OFF) : "memory"); return r; }
template <int D0> DI void pv_one(f32x16& od, int vb, bf16x8 pa0, bf16x8 pa1, bf16x8 pa2, bf16x8 pa3) {
    const s16x4 l0 = tr_read<v_rd_off(D0, 0, 0)>(vb), h0 = tr_read<v_rd_off(D0, 0, 1)>(vb), l1 = tr_read<v_rd_off(D0, 1, 0)>(vb), h1 = tr_read<v_rd_off(D0, 1, 1)>(vb);
    const s16x4 l2 = tr_read<v_rd_off(D0, 2, 0)>(vb), h2 = tr_read<v_rd_off(D0, 2, 1)>(vb), l3 = tr_read<v_rd_off(D0, 3, 0)>(vb), h3 = tr_read<v_rd_off(D0, 3, 1)>(vb);
    asm volatile("s_waitcnt lgkmcnt(0)" ::: "memory"); SBAR();
#define PK(L, H) (bf16x8){L[0], L[1], L[2], L[3], H[0], H[1], H[2], H[3]}
    od = __builtin_amdgcn_mfma_f32_32x32x16_bf16(pa0, PK(l0, h0), od, 0, 0, 0);
    od = __builtin_amdgcn_mfma_f32_32x32x16_bf16(pa1, PK(l1, h1), od, 0, 0, 0);
    od = __builtin_amdgcn_mfma_f32_32x32x16_bf16(pa2, PK(l2, h2), od, 0, 0, 0);
    od = __builtin_amdgcn_mfma_f32_32x32x16_bf16(pa3, PK(l3, h3), od, 0, 0, 0);
#undef PK
}
DI void pv_d0(f32x16* o, int vb, bf16x8 pa0, bf16x8 pa1, bf16x8 pa2, bf16x8 pa3) {
    pv_one<0>(o[0], vb, pa0, pa1, pa2, pa3); pv_one<1>(o[1], vb, pa0, pa1, pa2, pa3); pv_one<2>(o[2], vb, pa0, pa1, pa2, pa3); pv_one<3>(o[3], vb, pa0, pa1, pa2, pa3);
}

DI void attn_body(const bf16_t* __restrict__ Qb, const bf16_t* __restrict__ Kh, const bf16_t* __restrict__ Vh, bf16_t* __restrict__ Ob, int NT, int skip, int q0, float sinkv, bool WIN, bool SINK, char* lds, int tid_in) {
    int tid = tid_in; asm volatile("" : "+v"(tid));
    const int wid = tid >> 6, lane = tid & 63, r32 = lane & 31, hi = lane >> 5;
    char* V_lds = lds; char* K_lds = lds + 2 * SHM_V;
    float* ws = (float*)(lds + 2 * SHM_V + 2 * SHM_K) + wid * 64; float* li_l = ws; float* al_l = ws + 32;
    float m_reg = -1e30f, l_reg = 0; f32x16 o[4] = {}; bf16x8 qr[8];
    const bf16_t* Qw = Qb + (long)(wid * QBLK + r32) * LDQ + hi * 8;
#pragma unroll
    for (int d0 = 0; d0 < 8; ++d0) qr[d0] = *reinterpret_cast<const bf16x8*>(Qw + d0 * 16);
    const int sr = tid >> 4, sc = (tid & 15) * 8, vst0 = v_st(sr, sc), vst1 = v_st(32 + sr, sc);
    const int vb0 = (int)(uintptr_t)V_lds + v_rd_base(lane);
    const int qp = q0 + wid * QBLK + r32;
    struct { bf16x8 vs0, vs1, ks0, ks1; } sr_[2];
#define KOFF(j) (64 * (j) + ((j) >= 4 ? skip : 0))
#define SLOAD(i, jt) do { const int k0_ = KOFF(jt); sr_[i].vs0 = *reinterpret_cast<const bf16x8*>(&Vh[(long)(k0_ + sr) * LDK + sc]); sr_[i].vs1 = *reinterpret_cast<const bf16x8*>(&Vh[(long)(k0_ + 32 + sr) * LDK + sc]); \
    sr_[i].ks0 = *reinterpret_cast<const bf16x8*>(&Kh[(long)(k0_ + sr) * LDK + sc]); sr_[i].ks1 = *reinterpret_cast<const bf16x8*>(&Kh[(long)(k0_ + 32 + sr) * LDK + sc]); } while (0)
#define SWRITE(b, i) do { *(bf16x8*)(V_lds + (b) * SHM_V + vst0) = sr_[i].vs0;          \
    *(bf16x8*)(V_lds + (b) * SHM_V + vst1) = sr_[i].vs1; int kc = sc * 2;               \
    *(bf16x8*)(K_lds + (b) * SHM_K + KSWZ(sr, kc)) = sr_[i].ks0;                       \
    *(bf16x8*)(K_lds + (b) * SHM_K + KSWZ(32 + sr, kc)) = sr_[i].ks1; } while (0)
#define SWAIT() asm volatile("s_waitcnt vmcnt(4)" ::: "memory")
#define RESC(a) do { if (__any((a) < 1.f)) { if (hi == 0) al_l[r32] = (a); asm volatile("s_waitcnt lgkmcnt(0)" ::: "memory"); \
    _Pragma("unroll") for (int d = 0; d < 4; ++d) _Pragma("unroll") for (int r = 0; r < 16; ++r) o[d][r] *= al_l[crow(r, hi)]; } } while (0)
#define WMASK(PA, PB, jt) do { if (WIN && (jt) >= 4) wmask(PA, PB, qp, skip + 64 * ((jt) - 4), hi); } while (0)
    f32x16 pA0, pA1, pB0, pB1; float mnA, mnB, alA, alB; bf16x8 pa0, pa1, pa2, pa3;
    constexpr int SE = 0, SO = 1;
    SLOAD(SE, 0); asm volatile("s_waitcnt vmcnt(0)" ::: "memory"); SWRITE(0, SE); __syncthreads();
    qkt(pA0, pA1, K_lds, qr, r32, hi); partialSM(pA0, pA1, m_reg, mnA, alA);
    SLOAD(SO, 1); if (2 < NT) SLOAD(SE, 2);
    SWAIT(); SWRITE(1, SO); __syncthreads();
    for (int j = 1; j + 1 < NT; j += 2) {
        SBAR(); qkt(pB0, pB1, K_lds + SHM_K, qr, r32, hi); WMASK(pB0, pB1, j);
        finishSM(pA0, pA1, alA, l_reg, pa0, pa1, pa2, pa3); SBAR();
        SLOAD(SO, j + 2); SBAR();
        pv_d0(o, vb0, pa0, pa1, pa2, pa3); partialSM(pB0, pB1, m_reg, mnB, alB);
        __syncthreads(); SWAIT(); SWRITE(0, SE);
        RESC(alB); __syncthreads();
        SBAR(); qkt(pA0, pA1, K_lds, qr, r32, hi); WMASK(pA0, pA1, j + 1);
        finishSM(pB0, pB1, alB, l_reg, pa0, pa1, pa2, pa3); SBAR();
        if (j + 3 < NT) SLOAD(SE, j + 3); SBAR();
        pv_d0(o, vb0 + (int)SHM_V, pa0, pa1, pa2, pa3); partialSM(pA0, pA1, m_reg, mnA, alA);
        __syncthreads(); SWAIT(); SWRITE(1, SO);
        RESC(alA); __syncthreads();
    }
    SBAR(); qkt(pB0, pB1, K_lds + SHM_K, qr, r32, hi); WMASK(pB0, pB1, NT - 1);
    finishSM(pA0, pA1, alA, l_reg, pa0, pa1, pa2, pa3); SBAR();
    pv_d0(o, vb0, pa0, pa1, pa2, pa3); partialSM(pB0, pB1, m_reg, mnB, alB);
    __syncthreads(); RESC(alB);
    finishSM(pB0, pB1, alB, l_reg, pa0, pa1, pa2, pa3); SBAR();
    pv_d0(o, vb0 + (int)SHM_V, pa0, pa1, pa2, pa3);
    if (SINK) l_reg += __builtin_amdgcn_exp2f(sinkv * 1.4426950408889634f - m_reg * (SCALE * 1.4426950408889634f));
    if (hi == 0) li_l[r32] = l_reg; asm volatile("s_waitcnt lgkmcnt(0)" ::: "memory");
    float rli[16];
#pragma unroll
    for (int r = 0; r < 16; ++r) rli[r] = __builtin_amdgcn_rcpf(li_l[crow(r, hi)]);
    bf16_t* Ow = Ob + (long)(wid * QBLK) * LDO;
#pragma unroll
    for (int r = 0; r < 16; ++r) { int orow = crow(r, hi);
#pragma unroll
        for (int d0 = 0; d0 < 4; ++d0) Ow[(long)orow * LDO + d0 * 32 + r32] = (bf16_t)f2bf(o[d0][r] * rli[r]); }
    __syncthreads();
#undef KOFF
#undef SLOAD
#undef SWRITE
#undef SWAIT
#undef RESC
#undef WMASK
}
}

constexpr int NWAVES = 8, NTHR = 512;
struct Args { const float* in[29]; float* out; unsigned char* ws; int ph_lo, ph_hi; };
struct Frame {
    LAS unsigned char* lds; unsigned char* ws; unsigned* ctl;
    int tid, lane, wave, bid;
    static constexpr int G = 256;
};
constexpr int PTR_OFF = RING_BYTES + 4096 + 512;
constexpr int LROWS_OFF = PTR_OFF + 256;
static_assert(LROWS_OFF + 12 * 256 * 2 <= LDS_BYTES, "lds");
DI const float* in_ptr(const Frame& F, int i) { const unsigned long long v = ((const LAS unsigned long long*)(F.lds + PTR_OFF))[i];
    const unsigned lo = __builtin_amdgcn_readfirstlane((unsigned)v), hi = __builtin_amdgcn_readfirstlane((unsigned)(v >> 32)); return (const float*)(const GAS float*)(((unsigned long long)hi << 32) | lo); }
#define AIN(k) in_ptr(F, (k))
DI int modrow(int row) { return row < RL ? (row >> 11) : NB; }
DI const float* mod_vec(const Frame& F, int layer, int mr, int chunk) { return (const float*)(F.ws + WS_MOD) + ((size_t)(layer * 9 + mr) * 6 + chunk) * DM; }

DI bf16x8 tr_read_pair(unsigned a_lo, unsigned a_hi) { s16x4 lo, hi;
    asm volatile("ds_read_b64_tr_b16 %0, %2\n\tds_read_b64_tr_b16 %1, %3\n\ts_waitcnt lgkmcnt(0)" : "=&v"(lo), "=&v"(hi) : "v"(a_lo), "v"(a_hi) : "memory");
    return (bf16x8){lo[0], lo[1], lo[2], lo[3], hi[0], hi[1], hi[2], hi[3]}; }
DI bf16x8 cat4(s16x4 l, s16x4 h) { return (bf16x8){l[0], l[1], l[2], l[3], h[0], h[1], h[2], h[3]}; }
DI int rowmap(int kind, int n) {
    if (kind == 1) return n < 2560 ? n : (n < 2592 ? n + 2048 : n - 32);
    if (kind == 2) return ((n >> 4) << 5) + (n & 15);
    if (kind == 3) return ((n >> 4) << 5) + 16 + (n & 15);
    return n;
}
DI void transpose_item(const float* W, int K, int N, bf16_t* WT, int kind, LAS float* scr, int item, int lane) {
    const int nblk = N / 32, kb = item / nblk, nb = item % nblk, k0 = 64 * kb, n0 = 32 * nb;
#pragma unroll 8
    for (int i = 0; i < 32; ++i) { const int kk = 2 * i + (lane >> 5); scr[kk * 33 + (lane & 31)] = W[(size_t)(k0 + kk) * N + n0 + (lane & 31)]; }
    LDS_WAIT(); asm volatile("" ::: "memory");
    const int c = lane & 7;
#pragma unroll
    for (int j = 0; j < 4; ++j) { const int n = (lane >> 3) + 8 * j; const LAS float* s = scr + (8 * c) * 33 + n;
        u32x4 o; o.x = pk2(s[0 * 33], s[1 * 33]); o.y = pk2(s[2 * 33], s[3 * 33]); o.z = pk2(s[4 * 33], s[5 * 33]); o.w = pk2(s[6 * 33], s[7 * 33]);
        *(u32x4*)(WT + (size_t)rowmap(kind, n0 + n) * K + k0 + 8 * c) = o; }
    LDS_WAIT(); asm volatile("" ::: "memory");
}
DI bool conv_group(int& it, const float* src, size_t ss, int cnt, int K, int N, bf16_t* dst, size_t ds, int kind, LAS float* scr, int lane) {
    const int per = (K / 64) * (N / 32), tot = per * cnt;
    if (it >= tot) { it -= tot; return false; }
    const int m = it / per, r = it % per;
    transpose_item(src + (size_t)m * ss, K, N, dst + (size_t)m * ds, kind, scr, r, lane);
    return true;
}
struct ConvTile { const float* W; bf16_t* WT; int K, N, kind, k0, n0, f8; float scale; };
DI bool conv_tile_decode(const Frame& F, int t, ConvTile& c) {
    constexpr int PER_LAYER = 256 + 65 * 64 * 3 + 32 * 19;
    if (t >= 2 * PER_LAYER) return false;
    const int l = t / PER_LAYER; int r = t % PER_LAYER;
    bf16_t* WOUT = (bf16_t*)(F.ws + WS_WOUT); bf16_t* WGU = (bf16_t*)(F.ws + WS_WGU); bf16_t* WD = (bf16_t*)(F.ws + WS_WD);
    if (r < 256) { c.W = AIN(8) + (size_t)l * DM * DM; c.WT = WOUT + (size_t)l * DM * DM; c.K = DM; c.N = DM; c.kind = 0; c.k0 = (r >> 3) * 64; c.n0 = (r & 7) * 256; c.f8 = 0; c.scale = 1.f; return true; }
    r -= 256;
    if (r < 2 * 65 * 64) { const int up = r >= 65 * 64; if (up) r -= 65 * 64; const int e = r >> 6, q = r & 63;
        c.W = e < 64 ? AIN(up ? 24 : 23) + ((size_t)l * 64 + e) * DM * EH : AIN(up ? 27 : 26) + (size_t)l * DM * EH;
        c.f8 = MOE_FP8[l] ? 1 : 0; c.scale = SW_GU;
        c.WT = c.f8 ? (bf16_t*)((unsigned char*)(WGU + (size_t)l * 65 * 1024 * DM) + (size_t)e * 1024 * DM) : WGU + ((size_t)l * 65 + e) * 1024 * DM; c.K = DM; c.N = EH; c.kind = up ? 3 : 2; c.k0 = (q >> 1) * 64; c.n0 = (q & 1) * 256; return true; }
    r -= 2 * 65 * 64;
    if (r >= 65 * 64) { r -= 65 * 64;
        c.W = AIN(7) + (size_t)l * DM * INC; c.WT = (bf16_t*)(F.ws + WS_WIN) + (size_t)l * PC * DM; c.K = DM; c.N = INC; c.kind = 1; c.k0 = (r / 19) * 64; c.n0 = (r % 19) * 256; c.f8 = IN_FP8[l] ? 1 : 0; c.scale = SW_IN; return true; }
    { const int e = r >> 6, q = r & 63;
      c.W = e < 64 ? AIN(25) + ((size_t)l * 64 + e) * EH * DM : AIN(28) + (size_t)l * EH * DM;
      c.f8 = MOE2_FP8[l] ? 1 : 0; c.scale = SW_D;
      c.WT = c.f8 ? (bf16_t*)((unsigned char*)(WD + (size_t)l * 65 * DM * EH) + (size_t)e * DM * EH) : WD + ((size_t)l * 65 + e) * DM * EH; c.K = EH; c.N = DM; c.kind = 0; c.k0 = (q >> 3) * 64; c.n0 = (q & 7) * 256; return true; }
}
DI void conv_tile_load(const ConvTile& c, int tid, f32x4 (&r)[8]) {
#pragma unroll
    for (int i = 0; i < 8; ++i) r[i] = (c.n0 + 4 * (tid & 63) < c.N) ? *(const f32x4*)(c.W + (size_t)(c.k0 + (tid >> 6) + 8 * i) * c.N + c.n0 + 4 * (tid & 63)) : (f32x4){0.f, 0.f, 0.f, 0.f};
}
DI void p0_convert_fast(const Frame& F) {
    LAS unsigned char* img = F.lds;
    const int g = F.lane >> 4, q = (F.lane & 15) >> 2, p = F.lane & 3;
    ConvTile cur, nxt; f32x4 rc[8], rn[8];
    int t = F.bid; bool have = conv_tile_decode(F, t, cur);
    if (have) conv_tile_load(cur, F.tid, rc);
    while (have) {
        const bool hn = conv_tile_decode(F, t + F.G, nxt);
        if (hn) conv_tile_load(nxt, F.tid, rn);
#pragma unroll
        for (int i = 0; i < 8; ++i) { u32x2 w; w.x = pk2(rc[i].x, rc[i].y); w.y = pk2(rc[i].z, rc[i].w); *(LAS u32x2*)(img + ((F.tid >> 6) + 8 * i) * 528 + (F.tid & 63) * 8) = w; }
        __syncthreads();
        if (cur.f8) {
#pragma unroll
            for (int i = 0; i < 2; ++i) { const int nb = F.wave * 2 + i;
                const unsigned a0 = (unsigned)(uintptr_t)img + (unsigned)(16 * g + q) * 528u + (unsigned)(16 * nb + 4 * p) * 2u;
                const bf16x8 t01 = tr_read_pair(a0, a0 + 4u * 528u), t23 = tr_read_pair(a0 + 8u * 528u, a0 + 12u * 528u);
                const float sc = cur.scale; u32x4 w;
#define F8W(T_, O_) pg8::pk4_fp8(bf2f((unsigned short)T_[O_]) * sc, bf2f((unsigned short)T_[O_ + 1]) * sc, bf2f((unsigned short)T_[O_ + 2]) * sc, bf2f((unsigned short)T_[O_ + 3]) * sc)
                w.x = F8W(t01, 0); w.y = F8W(t01, 4); w.z = F8W(t23, 0); w.w = F8W(t23, 4);
#undef F8W
                const int n = cur.n0 + 16 * nb + (F.lane & 15);
                if (n < cur.N) *(u32x4*)((unsigned char*)cur.WT + (size_t)rowmap(cur.kind, n) * cur.K + cur.k0 + 16 * g) = w; }
        } else {
#pragma unroll
        for (int i = 0; i < 4; ++i) { const int combo = F.wave * 4 + i, nb = combo >> 1, kh = combo & 1;
            const unsigned a0 = (unsigned)(uintptr_t)img + (unsigned)(32 * kh + 8 * g + q) * 528u + (unsigned)(16 * nb + 4 * p) * 2u;
            const bf16x8 lohi = tr_read_pair(a0, a0 + 4u * 528u);
            const int n = cur.n0 + 16 * nb + (F.lane & 15);
            if (n < cur.N) *(bf16x8*)(cur.WT + (size_t)rowmap(cur.kind, n) * cur.K + cur.k0 + 32 * kh + 8 * g) = lohi; }
        }
        __syncthreads();
        cur = nxt; have = hn; t += F.G;
#pragma unroll
        for (int i = 0; i < 8; ++i) rc[i] = rn[i];
    }
}
DI void p0_convert(const Frame& F, const Args& a) {
    LAS float* scr = (LAS float*)(F.lds + F.wave * 16384);
    const int gw = F.bid * NWAVES + F.wave, NGW = F.G * NWAVES;
    bf16_t* WIN = (bf16_t*)(F.ws + WS_WIN); bf16_t* LRUW = (bf16_t*)(F.ws + WS_LRUW);
    constexpr int PER_LAYER = 2 * 8 * 8 + 224;
    for (int it0 = gw; it0 < 2 * PER_LAYER; it0 += NGW) {
        const int l = it0 / PER_LAYER; int it = it0 % PER_LAYER;
        { const int per = 8; if (it < 8 * per) { const int m = it / per, r = it % per, d = m >> 2, h = m & 3;
            transpose_item(AIN(11) + ((size_t)(l * 2 + d) * 4 + h) * 16384, 128, 128, LRUW + ((size_t)((l * 2 + d) * 2 + 0) * 4 + h) * 16384, 0, scr, r, F.lane); continue; } it -= 8 * per;
          if (it < 8 * per) { const int m = it / per, r = it % per, d = m >> 2, h = m & 3;
            transpose_item(AIN(13) + ((size_t)(l * 2 + d) * 4 + h) * 16384, 128, 128, LRUW + ((size_t)((l * 2 + d) * 2 + 1) * 4 + h) * 16384, 0, scr, r, F.lane); continue; } it -= 8 * per; }
        { u32x4 z = {0u, 0u, 0u, 0u}; const int rb = IN_FP8[l] ? DM : DM * 2;
          u32x4* p = (u32x4*)((unsigned char*)(WIN + (size_t)l * PC * DM) + (size_t)(INC + it) * rb) + F.lane;
          for (int j = 0; j < rb / 1024; ++j) p[64 * j] = z; }
    }
    __syncthreads();
}
DI void p0_mod(const Frame& F, const Args& a) {
    LAS float* st = (LAS float*)F.lds;
    LAS float* part = (LAS float*)(F.lds + 73728);
    if (F.bid == 200) { float* SP = (float*)(F.ws + WS_SP); for (int i = F.tid; i < 2048; i += NTHR) SP[i] = log1pf(expf(-AIN(15)[i])); }
    if (F.bid >= 208 && F.bid < 224) { bf16_t* RWS = (bf16_t*)(F.ws + WS_RWS); const float* rw = AIN(21);
        for (int i = (F.bid - 208) * NTHR + F.tid; i < 2 * DM * NEXP; i += 16 * NTHR) { const int l = i / (DM * NEXP), r = i % (DM * NEXP), k = r >> 6, e = r & 63; const float w = rw[i];
            const unsigned hi = f2bf(w); const float lo = w - bf2f((unsigned short)hi);
            const size_t fi = (size_t)l * NEXP * DM + (((((size_t)(k >> 8) * 8 + ((k >> 5) & 7)) * 4 + (e >> 4)) * 64 + (((k >> 3) & 3) * 16 + (e & 15))) * 8 + (k & 7));
            RWS[fi] = (bf16_t)hi; RWS[(size_t)2 * NEXP * DM + fi] = (bf16_t)f2bf(lo); } }
    if (F.bid == 224) { unsigned* rid = (unsigned*)(F.ws + WS_ROWID); for (int i = F.tid; i < RT; i += NTHR) rid[i] = (unsigned)i * (unsigned)DM; }
    if (F.bid >= 192) return;
    for (int i = F.tid; i < 9 * DM; i += NTHR) { const int r = i / DM, k = i % DM; const float c = r < 8 ? AIN(1)[r * DM + k] : AIN(3)[k]; st[k * 9 + r] = siluf_(c); }
    __syncthreads();
    const int l = F.bid / 96, cg = F.bid % 96;
    const float* W = AIN(4) + (size_t)l * DM * 12288 + cg * 128 + 2 * F.lane;
    float acc[9][2];
#pragma unroll
    for (int r = 0; r < 9; ++r) { acc[r][0] = 0.f; acc[r][1] = 0.f; }
    const int kb = F.wave * 256;
#pragma unroll 4
    for (int k = kb; k < kb + 256; ++k) { const f32x2 w = *(const f32x2*)(W + (size_t)k * 12288);
#pragma unroll
        for (int r = 0; r < 9; ++r) { const float s = st[k * 9 + r]; acc[r][0] += s * w.x; acc[r][1] += s * w.y; } }
#pragma unroll
    for (int r = 0; r < 9; ++r) { part[(F.wave * 9 + r) * 128 + 2 * F.lane] = acc[r][0]; part[(F.wave * 9 + r) * 128 + 2 * F.lane + 1] = acc[r][1]; }
    __syncthreads();
    float* MOD = (float*)(F.ws + WS_MOD);
    for (int i = F.tid; i < 9 * 128; i += NTHR) { const int r = i >> 7, c = i & 127; float s = AIN(5)[l * 12288 + cg * 128 + c];
#pragma unroll
        for (int w = 0; w < 8; ++w) s += part[(w * 9 + r) * 128 + c];
        MOD[(size_t)(l * 9 + r) * 12288 + cg * 128 + c] = s; }
    asm volatile("s_waitcnt vmcnt(0)" ::: "memory");
    __syncthreads();
    if (l == 0 && cg < 32 && F.tid == 0) { __builtin_amdgcn_fence(__ATOMIC_RELEASE, "agent"); asm volatile("s_waitcnt vmcnt(0)" ::: "memory"); (void)xb_add(F.ctl + CW_QUEUE + 64 * 8, 1u); }
}

DI float row_sumsq(const f32x4 (&v)[8]) { float s = 0.f;
#pragma unroll
    for (int j = 0; j < 8; ++j) s += (v[j].x * v[j].x + v[j].y * v[j].y) + (v[j].z * v[j].z + v[j].w * v[j].w);
    return wave_sum(s); }
DI void norm_mod_store(const f32x4 (&v)[8], float rstd, const float* g, const float* shift, const float* scale, bf16_t* hrow, int lane) {
#pragma unroll
    for (int j = 0; j < 8; ++j) { const int c = 256 * j + 4 * lane; const f32x4 gg = *(const f32x4*)(g + c), sh = *(const f32x4*)(shift + c), sc = *(const f32x4*)(scale + c);
        const f32x4 h = v[j] * rstd * gg * (sc + 1.0f) + sh;
        if (IN_FP8[0]) *(unsigned*)((unsigned char*)hrow + c) = pg8::pk4_fp8(h.x, h.y, h.z, h.w);
        else { u32x2 w; w.x = pk2(h.x, h.y); w.y = pk2(h.z, h.w); *(u32x2*)(hrow + c) = w; } }
}
DI void pre_rows(const Frame& F, const Args& a, int layer, const float* xl, const float* xc, int nrows) {
    const int gw = F.bid * NWAVES + F.wave, NGW = F.G * NWAVES; bf16_t* H = (bf16_t*)(F.ws + WS_H);
    const float* g0 = AIN(6) + (size_t)(layer * 4 + 0) * DM;
    f32x4 nv[8];
    if (gw < nrows) { const float* xr = gw < RL ? xl + (size_t)gw * DM : xc + (size_t)(gw - RL) * DM;
#pragma unroll
        for (int j = 0; j < 8; ++j) nv[j] = *(const f32x4*)(xr + 256 * j + 4 * F.lane); }
#pragma unroll 1
    for (int row = gw; row < nrows; row += NGW) {
        f32x4 v[8];
#pragma unroll
        for (int j = 0; j < 8; ++j) v[j] = nv[j];
        { const int nr = row + NGW; if (nr < nrows) { const float* xr = nr < RL ? xl + (size_t)nr * DM : xc + (size_t)(nr - RL) * DM;
#pragma unroll
            for (int j = 0; j < 8; ++j) nv[j] = *(const f32x4*)(xr + 256 * j + 4 * F.lane); } }
        const float rstd = rsqrtf(row_sumsq(v) * (1.0f / DM) + RMS_EPS); const int mr = modrow(row);
        norm_mod_store(v, rstd, g0, mod_vec(F, layer, mr, 0), mod_vec(F, layer, mr, 1), IN_FP8[0] ? (bf16_t*)((unsigned char*)H + (size_t)row * DM) : H + (size_t)row * DM, F.lane);
    }
}

template <bool F8, bool XIB> DI void postmix_phase(const Frame& F, const Args& a, int layer, const void* xl_src_, const void* xc_src_, bf16_t* xl_dst, bf16_t* xc_dst, int nrows) {
    LAS unsigned char* AH = F.lds;
    LAS unsigned char* AL = F.lds + 8 * 4112;
    LAS float* part = (LAS float*)(F.lds + 66048);
    LAS unsigned* hist = (LAS unsigned*)(F.lds + 66048 + 16384);
    const bf16_t* YO = (const bf16_t*)(F.ws + WS_ARENA + AR_YO); bf16_t* H = (bf16_t*)(F.ws + WS_H);
    int* TOKE = (int*)(F.ws + WS_META + MT_TOKE); int* TOKR = (int*)(F.ws + WS_META + MT_TOKR); float* TOKG = (float*)(F.ws + WS_META + MT_TOKG);
    const float* g1 = AIN(6) + (size_t)(layer * 4 + 1) * DM; const float* g2 = AIN(6) + (size_t)(layer * 4 + 2) * DM;
    const bf16_t* RWH = (const bf16_t*)(F.ws + WS_RWS) + (size_t)layer * NEXP * DM; const bf16_t* RWL = RWH + (size_t)2 * NEXP * DM; const float rbias = AIN(22)[layer * NEXP + F.lane];
    const int rpb = nrows / F.G;
    LAS float* VA1 = (LAS float*)(F.lds + 83968); LAS float* VA2 = VA1 + DM; LAS float* VB2 = VA2 + DM;
    if (F.tid < 64) hist[F.tid] = 0u;
    int cur_mr = -1;
    u32x2 yc[8], yn[8]; f32x4 xc[8], xn[8];
#define PM_LOAD(Y_, X_, it_) do { const int row_ = F.bid * rpb + (it_) * 8 + F.wave; \
        if constexpr (XIB) { const bf16_t* xs_ = row_ < RL ? (const bf16_t*)xl_src_ + (size_t)row_ * DM : (const bf16_t*)xc_src_ + (size_t)(row_ - RL) * DM; \
            _Pragma("unroll") for (int j = 0; j < 8; ++j) { Y_[j] = *(const u32x2*)(YO + (size_t)row_ * DM + 256 * j + 4 * F.lane); const u32x2 t_ = *(const u32x2*)(xs_ + 256 * j + 4 * F.lane); const unsigned tx_ = t_.x, ty_ = t_.y; X_[j].x = __builtin_bit_cast(float, tx_); X_[j].y = __builtin_bit_cast(float, ty_); } }        \
        else { const float* xs_ = row_ < RL ? (const float*)xl_src_ + (size_t)row_ * DM : (const float*)xc_src_ + (size_t)(row_ - RL) * DM; \
            _Pragma("unroll") for (int j = 0; j < 8; ++j) { Y_[j] = *(const u32x2*)(YO + (size_t)row_ * DM + 256 * j + 4 * F.lane); X_[j] = *(const f32x4*)(xs_ + 256 * j + 4 * F.lane); } } } while (0)
    PM_LOAD(yc, xc, 0);
    __syncthreads();
    for (int it = 0; it < rpb / 8; ++it) {
        const int row = F.bid * rpb + it * 8 + F.wave; const int mr = modrow(F.bid * rpb + it * 8);
        bf16_t* xd = row < RL ? xl_dst + (size_t)row * DM : xc_dst + (size_t)(row - RL) * DM;
        if (mr != cur_mr) { cur_mr = mr;
            const float* m2 = mod_vec(F, layer, mr, 2); const float* m3 = mod_vec(F, layer, mr, 3); const float* m4 = mod_vec(F, layer, mr, 4); const int c = 4 * F.tid;
            const f32x4 a1 = *(const f32x4*)(m2 + c) * *(const f32x4*)(g1 + c), a2 = *(const f32x4*)(g2 + c) * (*(const f32x4*)(m4 + c) + 1.0f), b2 = *(const f32x4*)(m3 + c);
            *(LAS f32x4*)(VA1 + c) = a1; *(LAS f32x4*)(VA2 + c) = a2; *(LAS f32x4*)(VB2 + c) = b2;
            __syncthreads(); }
        f32x4 v[8];
        { f32x4 y[8];
#pragma unroll
          for (int j = 0; j < 8; ++j) y[j] = (f32x4){bflo(yc[j].x), bfhi(yc[j].x), bflo(yc[j].y), bfhi(yc[j].y)};
          const float rstd = rsqrtf(row_sumsq(y) * (1.0f / DM) + RMS_EPS);
#pragma unroll
          for (int j = 0; j < 8; ++j) { const int c = 256 * j + 4 * F.lane; f32x4 xv = xc[j];
              if constexpr (XIB) { const float r0 = xc[j].x, r1 = xc[j].y; const unsigned w0 = __builtin_bit_cast(unsigned, r0), w1 = __builtin_bit_cast(unsigned, r1); xv = (f32x4){bflo(w0), bfhi(w0), bflo(w1), bfhi(w1)}; }
              v[j] = xv + *(const LAS f32x4*)(VA1 + c) * (y[j] * rstd); *(u32x2*)(xd + c) = (u32x2){pk2(v[j].x, v[j].y), pk2(v[j].z, v[j].w)}; } }
        { const float rstd = rsqrtf(row_sumsq(v) * (1.0f / DM) + RMS_EPS);
#pragma unroll
          for (int j = 0; j < 8; ++j) { const int c = 256 * j + 4 * F.lane;
              const f32x4 h = v[j] * rstd * *(const LAS f32x4*)(VA2 + c) + *(const LAS f32x4*)(VB2 + c);
              if constexpr (F8) { *(unsigned*)((unsigned char*)H + (size_t)row * DM + c) = pg8::pk4_fp8(h.x, h.y, h.z, h.w); } else { u32x2 w; w.x = pk2(h.x, h.y); w.y = pk2(h.z, h.w); *(u32x2*)(H + (size_t)row * DM + c) = w; }
              { const unsigned h0 = f2bf(h.x), h1 = f2bf(h.y), h2 = f2bf(h.z), h3 = f2bf(h.w); u32x2 wh, wl; wh.x = h0 | (h1 << 16); wh.y = h2 | (h3 << 16);
                wl.x = pk2(h.x - bf2f((unsigned short)h0), h.y - bf2f((unsigned short)h1)); wl.y = pk2(h.z - bf2f((unsigned short)h2), h.w - bf2f((unsigned short)h3));
                *(LAS u32x2*)(AH + F.wave * 4112 + c * 2) = wh; *(LAS u32x2*)(AL + F.wave * 4112 + c * 2) = wl; } } }
        if (it + 1 < rpb / 8) PM_LOAD(yn, xn, it + 1);
        __syncthreads();
        { const int fr = F.lane & 15, fq = F.lane >> 4; f32x4 acc[4];
#pragma unroll
          for (int et = 0; et < 4; ++et) acc[et] = (f32x4){0.f, 0.f, 0.f, 0.f};
          const bf16_t* wph = RWH + ((size_t)F.wave * 8 * 4 * 64 + F.lane) * 8; const bf16_t* wpl = RWL + ((size_t)F.wave * 8 * 4 * 64 + F.lane) * 8;
          bf16x8 wh[3][4], wl[3][4];
#define RT_LD(buf, s_) do { _Pragma("unroll") for (int et = 0; et < 4; ++et) { wh[buf][et] = *(const bf16x8*)(wph + ((s_) * 4 + et) * 512); wl[buf][et] = *(const bf16x8*)(wpl + ((s_) * 4 + et) * 512); } } while (0)
#define RT_MM(buf, s_) do { const bf16x8 bh = *(const LAS bf16x8*)(AH + (fr & 7) * 4112 + (F.wave * 256 + 32 * (s_) + fq * 8) * 2), bl = *(const LAS bf16x8*)(AL + (fr & 7) * 4112 + (F.wave * 256 + 32 * (s_) + fq * 8) * 2); \
              _Pragma("unroll") for (int et = 0; et < 4; ++et) { acc[et] = MFMA16(wh[buf][et], bh, acc[et]); acc[et] = MFMA16(wh[buf][et], bl, acc[et]); acc[et] = MFMA16(wl[buf][et], bh, acc[et]); } } while (0)
          RT_LD(0, 0); RT_LD(1, 1);
#pragma unroll 1
          for (int s2 = 0; s2 < 6; s2 += 3) { RT_LD(2, s2 + 2); RT_MM(0, s2); RT_LD(0, s2 + 3); RT_MM(1, s2 + 1); RT_LD(1, s2 + 4); RT_MM(2, s2 + 2); }
          RT_MM(0, 6); RT_MM(1, 7);
#undef RT_LD
#undef RT_MM
          if (fr < 8) {
#pragma unroll
              for (int et = 0; et < 4; ++et) *(LAS f32x4*)(part + (F.wave * 8 + fr) * 64 + et * 16 + 4 * fq) = acc[et]; } }
        __syncthreads();
        { int ln = F.lane; asm volatile("" : "+v"(ln));
          float logit = 0.f;
#pragma unroll
          for (int w = 0; w < 8; ++w) logit += part[(w * 8 + F.wave) * 64 + ln];
          const float s = 1.0f / (1.0f + expf(-logit)); const float bsd = s + rbias; const float NINF = -__builtin_inff();
          float m1 = bsd; m1 = fmaxf(m1, __shfl_xor(m1, 1)); m1 = fmaxf(m1, __shfl_xor(m1, 2)); m1 = fmaxf(m1, __shfl_xor(m1, 4));
          const unsigned long long bal = __ballot(bsd == m1); const int g = ln >> 3; const unsigned gm = (unsigned)(bal >> (8 * g)) & 0xffu; const int first = __ffs(gm) - 1;
          float b2 = ((ln & 7) == first) ? NINF : bsd; b2 = fmaxf(b2, __shfl_xor(b2, 1)); b2 = fmaxf(b2, __shfl_xor(b2, 2)); b2 = fmaxf(b2, __shfl_xor(b2, 4));
          const float gs = m1 + b2; int grank = 0;
#pragma unroll
          for (int gg = 0; gg < 8; ++gg) { const float og = rdlane(gs, gg * 8); grank += ((og > gs) || (og == gs && gg < g)) ? 1 : 0; }
          const bool elig = grank < 4; const float mk = elig ? bsd : NINF; int erank = 0;
#pragma unroll
          for (int ee = 0; ee < 64; ++ee) { const float ov = rdlane(mk, ee); erank += ((ov > mk) || (ov == mk && ee < ln)) ? 1 : 0; }
          const bool sel = elig && erank < 8; const float ssum = wave_sum(sel ? s : 0.f); const float gate = s / ssum * 2.5f;
          const unsigned long long sb = __ballot(sel); const int kidx = __popcll(sb & ((1ull << ln) - 1ull));
          if (sel) { const unsigned rk = __hip_atomic_fetch_add(hist + ln, 1u, __ATOMIC_RELAXED, __HIP_MEMORY_SCOPE_WORKGROUP);
              TOKE[row * 8 + kidx] = ln; TOKR[row * 8 + kidx] = (int)rk; TOKG[row * 8 + kidx] = gate; } }
        __syncthreads();
#pragma unroll
        for (int j = 0; j < 8; ++j) { yc[j] = yn[j]; xc[j] = xn[j]; }
    }
#undef PM_LOAD
    if (F.tid < 64) ((unsigned*)(F.ws + WS_META + MT_BLKCNT))[F.bid * 64 + F.tid] = hist[F.tid];
    __syncthreads();
}

DI void moe_tables(const Frame& F, int ntok) {
    LAS unsigned char* T = F.lds + TBL_OFF;
    LAS unsigned short* tile_e = (LAS unsigned short*)T; LAS unsigned* pstart = (LAS unsigned*)(T + 2048); LAS unsigned* cnt = (LAS unsigned*)(T + 2304); LAS unsigned* base = (LAS unsigned*)(T + 2560); LAS unsigned* misc = (LAS unsigned*)(T + 2816);
    LAS unsigned* tmp = (LAS unsigned*)F.lds;
    const unsigned* BC = (const unsigned*)(F.ws + WS_META + MT_BLKCNT);
    { const int e = F.tid & 63, p = F.tid >> 6; unsigned tot = 0, below = 0;
      for (int b = p * 32; b < p * 32 + 32; ++b) { const unsigned c = (b < F.G) ? BC[b * 64 + e] : 0u; tot += c; below += (b < F.bid) ? c : 0u; }
      tmp[p * 64 + e] = tot; tmp[512 + p * 64 + e] = below; }
    __syncthreads();
    if (F.tid < 64) { unsigned tot = 0, below = 0;
#pragma unroll
        for (int p = 0; p < 8; ++p) { tot += tmp[p * 64 + F.tid]; below += tmp[512 + p * 64 + F.tid]; }
        cnt[F.tid] = tot; base[F.tid] = below; }
    __syncthreads();
    if (F.tid < 64) { unsigned s = 0, tot = 0;
#pragma unroll 16
        for (int e = 0; e < 64; ++e) { const unsigned pc = (cnt[e] + 255u) & ~255u; s += (e < F.tid) ? pc : 0u; tot += pc; }
        pstart[F.tid] = s; if (F.tid == 0) misc[0] = tot >> 8; }
    __syncthreads();
    const int nrt = (int)misc[0], nst = ntok / 256;
    for (int t = F.tid; t < nrt + nst; t += NTHR) { int e = 64; if (t < nrt) { const unsigned s = (unsigned)t << 8; e = 0;
#pragma unroll 1
            for (int q = 32; q >= 1; q >>= 1) if (e + q < 64 && pstart[e + q] <= s) e += q;
            while (e < 63 && pstart[e + 1] <= s) ++e; }
        tile_e[t] = (unsigned short)e; }
    __syncthreads();
}
DI void slots_phase(const Frame& F, int layer, int ntok, unsigned rowbytes) {
    moe_tables(F, ntok);
    LAS unsigned char* T = F.lds + TBL_OFF;
    LAS unsigned* pstart = (LAS unsigned*)(T + 2048); LAS unsigned* cnt = (LAS unsigned*)(T + 2304); LAS unsigned* base = (LAS unsigned*)(T + 2560); LAS unsigned* misc = (LAS unsigned*)(T + 2816);
    const int* TOKE = (const int*)(F.ws + WS_META + MT_TOKE); const int* TOKR = (const int*)(F.ws + WS_META + MT_TOKR); const float* TOKG = (const float*)(F.ws + WS_META + MT_TOKG);
    int* TOKS = (int*)(F.ws + WS_META + MT_TOKS); unsigned* ROWOFF = (unsigned*)(F.ws + WS_META + MT_ROWOFF);
    const int rpb = ntok / F.G; const unsigned sslot0 = misc[0] << 8;
    for (int i = F.tid; i < rpb * 8; i += NTHR) { const int row = F.bid * rpb + (i >> 3), k = i & 7; const int e = TOKE[row * 8 + k];
        const unsigned slot = pstart[e] + base[e] + (unsigned)TOKR[row * 8 + k];
        TOKS[row * 8 + k] = (int)slot; ROWOFF[slot] = (unsigned)row * rowbytes; }
    for (int i = F.tid; i < rpb; i += NTHR) { const int row = F.bid * rpb + i; ROWOFF[sslot0 + row] = (unsigned)row * rowbytes; }
    if (F.bid < 64) { const unsigned e = F.bid, c = cnt[e], pe = (c + 255u) & ~255u;
        for (unsigned i = c + F.tid; i < pe; i += NTHR) { ROWOFF[pstart[e] + i] = 0u; } }
    (void)layer;
}

__device__ __attribute__((noinline)) void combine_phase_ol(unsigned char* ws_, int tid_, int wave_, int bid_, int layer, float* xout, int nrows, int next_pre_) {
    extern __shared__ __attribute__((aligned(16))) unsigned char lds_raw2[];
    Frame F; F.lds = (LAS unsigned char*)lds_raw2; F.ws = ws_; F.ctl = (unsigned*)(ws_ + WS_CTL); F.tid = tid_; F.lane = tid_ & 63; F.wave = wave_; F.bid = bid_; const bool next_pre = next_pre_ != 0;
    const unsigned char* MO = (const unsigned char*)(F.ws + WS_ARENA + AR_MO); const int* TOKS = (const int*)(F.ws + WS_META + MT_TOKS); const float* TOKG = (const float*)(F.ws + WS_META + MT_TOKG);
    const unsigned sslot0 = ((LAS unsigned*)(F.lds + TBL_OFF + 2816))[0] << 8;
    const float* g3 = AIN(6) + (size_t)(layer * 4 + 3) * DM; const float* g0n = AIN(6) + (size_t)((layer + 1 < NLAYER ? layer + 1 : layer) * 4 + 0) * DM; const int rpb = nrows / F.G;
    LAS float* VA3 = (LAS float*)F.lds; LAS float* VA0 = VA3 + DM; LAS float* VB0 = VA0 + DM;
    int cur_mr = -1;
    int sv = TOKS[(F.bid * rpb + F.wave) * 8 + (F.lane & 7)]; float gv = TOKG[(F.bid * rpb + F.wave) * 8 + (F.lane & 7)];
    __syncthreads();
    for (int i = 0; i < rpb / 8; ++i) { const int row = F.bid * rpb + i * 8 + F.wave; const int mr_ = modrow(F.bid * rpb + i * 8);
        if (mr_ != cur_mr) { cur_mr = mr_; __syncthreads(); int c = 4 * F.tid; asm volatile("" : "+v"(c));
            *(LAS f32x4*)(VA3 + c) = *(const f32x4*)(mod_vec(F, layer, mr_, 5) + c) * *(const f32x4*)(g3 + c);
            if (next_pre) { *(LAS f32x4*)(VA0 + c) = *(const f32x4*)(g0n + c) * (*(const f32x4*)(mod_vec(F, layer + 1, mr_, 1) + c) + 1.0f); *(LAS f32x4*)(VB0 + c) = *(const f32x4*)(mod_vec(F, layer + 1, mr_, 0) + c); }
            __syncthreads(); }
        unsigned slot[9]; float gk[9];
#pragma unroll
        for (int k = 0; k < 8; ++k) { slot[k] = (unsigned)__builtin_amdgcn_readlane(sv, k); gk[k] = rdlane(gv, k) * (1.0f / S_MO); }
        slot[8] = sslot0 + (unsigned)row; gk[8] = 1.0f / S_MO;
        if (i + 1 < rpb / 8) { sv = TOKS[(row + 8) * 8 + (F.lane & 7)]; gv = TOKG[(row + 8) * 8 + (F.lane & 7)]; }
        bf16_t* xr = row < RL ? (bf16_t*)(F.ws + WS_ARENA + AR_XLB) + (size_t)row * DM : (bf16_t*)(F.ws + WS_XC) + (size_t)(row - RL) * DM;
        float f[4][8];
#pragma unroll
        for (int j = 0; j < 4; ++j)
#pragma unroll
            for (int e = 0; e < 8; ++e) f[j][e] = 0.f;
#pragma unroll
        for (int k3 = 0; k3 < 9; k3 += 3) { u32x2 w[3][4];
#pragma unroll
            for (int q = 0; q < 3; ++q)
#pragma unroll
                for (int j = 0; j < 4; ++j) w[q][j] = *(const u32x2*)(MO + (size_t)slot[k3 + q] * DM + 512 * j + 8 * F.lane);
#pragma unroll
            for (int q = 0; q < 3; ++q)
#pragma unroll
                for (int j = 0; j < 4; ++j) { const f32x2 p0 = __builtin_amdgcn_cvt_pk_f32_fp8((int)w[q][j].x, false), p1 = __builtin_amdgcn_cvt_pk_f32_fp8((int)w[q][j].x, true), p2 = __builtin_amdgcn_cvt_pk_f32_fp8((int)w[q][j].y, false), p3 = __builtin_amdgcn_cvt_pk_f32_fp8((int)w[q][j].y, true);
                    const float g = gk[k3 + q]; f[j][0] += p0.x * g; f[j][1] += p0.y * g; f[j][2] += p1.x * g; f[j][3] += p1.y * g; f[j][4] += p2.x * g; f[j][5] += p2.y * g; f[j][6] += p3.x * g; f[j][7] += p3.y * g; } }
        float ss = 0.f;
#pragma unroll
        for (int j = 0; j < 4; ++j)
#pragma unroll
            for (int e = 0; e < 8; ++e) ss += f[j][e] * f[j][e];
        const float rstd = rsqrtf(wave_sum(ss) * (1.0f / DM) + RMS_EPS);
        float ss2 = 0.f;
#pragma unroll
        for (int j = 0; j < 4; ++j) { const int c8 = 512 * j + 8 * F.lane; const u32x4 xw = *(const u32x4*)(xr + c8);
            const float xv[8] = {bflo(xw.x), bfhi(xw.x), bflo(xw.y), bfhi(xw.y), bflo(xw.z), bfhi(xw.z), bflo(xw.w), bfhi(xw.w)};
#pragma unroll
            for (int h2 = 0; h2 < 2; ++h2) { const f32x4 a3 = *(const LAS f32x4*)(VA3 + c8 + 4 * h2);
#pragma unroll
                for (int e = 0; e < 4; ++e) { const float o = xv[4 * h2 + e] + a3[e] * (f[j][4 * h2 + e] * rstd); f[j][4 * h2 + e] = o; ss2 += o * o; } }
            if (next_pre) *(u32x4*)(xr + c8) = (u32x4){pk2(f[j][0], f[j][1]), pk2(f[j][2], f[j][3]), pk2(f[j][4], f[j][5]), pk2(f[j][6], f[j][7])};
            else { float* xo = xout + (size_t)row * DM + c8; *(f32x4*)xo = (f32x4){f[j][0], f[j][1], f[j][2], f[j][3]}; *(f32x4*)(xo + 4) = (f32x4){f[j][4], f[j][5], f[j][6], f[j][7]}; } }
        if (next_pre) { const float r2 = rsqrtf(wave_sum(ss2) * (1.0f / DM) + RMS_EPS); bf16_t* hrow = (bf16_t*)(F.ws + WS_H) + (size_t)row * DM;
#pragma unroll
            for (int j = 0; j < 4; ++j) { const int c = 512 * j + 8 * F.lane; float h[8];
#pragma unroll
                for (int h2 = 0; h2 < 2; ++h2) { const f32x4 a0 = *(const LAS f32x4*)(VA0 + c + 4 * h2), b0 = *(const LAS f32x4*)(VB0 + c + 4 * h2);
#pragma unroll
                    for (int e = 0; e < 4; ++e) h[4 * h2 + e] = f[j][4 * h2 + e] * r2 * a0[e] + b0[e]; }
                if (IN_FP8[1]) { u32x2 w8; w8.x = pg8::pk4_fp8(h[0], h[1], h[2], h[3]); w8.y = pg8::pk4_fp8(h[4], h[5], h[6], h[7]); *(u32x2*)((unsigned char*)(F.ws + WS_H) + (size_t)row * DM + c) = w8; }
                else { u32x4 wq; wq.x = pk2(h[0], h[1]); wq.y = pk2(h[2], h[3]); wq.z = pk2(h[4], h[5]); wq.w = pk2(h[6], h[7]); *(u32x4*)(hrow + c) = wq; } } }
    }
    __syncthreads();
}

DI void qkv_prep_rows(const Frame& F, const Args& a, int layer) {
    const int gw = F.bid * NWAVES + F.wave, NGW = F.G * NWAVES;
    const bf16_t* P = (const bf16_t*)(F.ws + WS_ARENA + AR_P);
    bf16_t* QC = (bf16_t*)(F.ws + WS_ARENA + AR_QC); bf16_t* KC = (bf16_t*)(F.ws + WS_ARENA + AR_KC); bf16_t* VC = (bf16_t*)(F.ws + WS_ARENA + AR_VC);
    bf16_t* QD = (bf16_t*)(F.ws + WS_ARENA + AR_QD); bf16_t* KD = (bf16_t*)(F.ws + WS_ARENA + AR_KD); bf16_t* VD = (bf16_t*)(F.ws + WS_ARENA + AR_VD);
    const int hh = F.lane >> 4, lp = F.lane & 15, ax = lp >> 3, second = (lp >> 2) & 1, d0 = 8 * lp;
    float invf[8], gq[8], gk[8];
#pragma unroll
    for (int j = 0; j < 8; ++j) { invf[j] = exp2f(-(float)((lp & 3) * 8 + j) * (13.287712379549449f / 32.0f)); gq[j] = AIN(19)[(layer * 2 + 0) * 128 + d0 + j]; gk[j] = AIN(19)[(layer * 2 + 1) * 128 + d0 + j]; }
    u32x4 nq_c, nk_c, nq_d, nk_d;
    { const bf16_t* Pr = P + (size_t)gw * PC; nq_c = *(const u32x4*)(Pr + C_CQ + 8 * F.lane); nk_c = *(const u32x4*)(Pr + C_CK + 8 * F.lane); nq_d = *(const u32x4*)(Pr + C_DQ + 8 * F.lane); nk_d = *(const u32x4*)(Pr + C_DK + 8 * F.lane); }
#pragma unroll 1
    for (int row = gw; row < RT; row += NGW) {
        const bool lat = row < RL; int b, t, kidx;
        if (lat) { b = row >> 11; t = row & 2047; kidx = CTXL + t; } else { const int rr = row - RL; b = rr >> 8; t = rr & 255; kidx = t; }
        const u32x4 wq_c = nq_c, wk_c = nk_c, wq_d = nq_d, wk_d = nk_d;
        if (row + NGW < RT) { const bf16_t* Pr = P + (size_t)(row + NGW) * PC; nq_c = *(const u32x4*)(Pr + C_CQ + 8 * F.lane); nk_c = *(const u32x4*)(Pr + C_CK + 8 * F.lane); nq_d = *(const u32x4*)(Pr + C_DQ + 8 * F.lane); nk_d = *(const u32x4*)(Pr + C_DK + 8 * F.lane); }
        float cs[8], sn[8];
        { const float pos = (float)(ax == 0 ? (t >> 6) : (t & 63));
#pragma unroll
          for (int j = 0; j < 8; ++j) { const float ang = pos * invf[j]; cs[j] = lat ? __cosf(ang) : 1.0f; sn[j] = lat ? __sinf(ang) : 0.0f; } }
#define QK_ONE(W_, NORM_, G_, OUT_) do { float x[8] = {bflo(W_.x), bfhi(W_.x), bflo(W_.y), bfhi(W_.y), bflo(W_.z), bfhi(W_.z), bflo(W_.w), bfhi(W_.w)}; \
        if (NORM_) { float ss = 0.f; _Pragma("unroll") for (int j = 0; j < 8; ++j) ss += x[j] * x[j]; DPP_ADD(ss, 0xB1); DPP_ADD(ss, 0x4E); DPP_ADD(ss, 0x141); DPP_ADD(ss, 0x140); \
            const float rs = rsqrtf(ss * (1.0f / 128.0f) + RMS_EPS); _Pragma("unroll") for (int j = 0; j < 8; ++j) x[j] = x[j] * rs * G_[j]; } \
        float o[8]; _Pragma("unroll") for (int j = 0; j < 8; ++j) { const float p = __shfl_xor(x[j], 4); o[j] = second ? (p * sn[j] + x[j] * cs[j]) : (x[j] * cs[j] - p * sn[j]); } \
        OUT_.x = pk2(o[0], o[1]); OUT_.y = pk2(o[2], o[3]); OUT_.z = pk2(o[4], o[5]); OUT_.w = pk2(o[6], o[7]); } while (0)
        u32x4 oq_c, ok_c, oq_d, ok_d;
        QK_ONE(wq_c, true, gq, oq_c); QK_ONE(wk_c, true, gk, ok_c); QK_ONE(wq_d, false, gq, oq_d); QK_ONE(wk_d, false, gk, ok_d);
#undef QK_ONE
        *(u32x4*)(QC + ((size_t)(b * 4 + hh) * KT + kidx) * 128 + d0) = oq_c; *(u32x4*)(QD + ((size_t)(b * 4 + hh) * KT + kidx) * 128 + d0) = oq_d;
        if (hh < 2) { *(u32x4*)(KC + ((size_t)(b * 2 + hh) * KT + kidx) * 128 + d0) = ok_c; *(u32x4*)(KD + ((size_t)(b * 2 + hh) * KT + kidx) * 128 + d0) = ok_d; }
        else { *(u32x4*)(VC + ((size_t)(b * 2 + hh - 2) * KT + kidx) * 128 + d0) = wk_c; *(u32x4*)(VD + ((size_t)(b * 2 + hh - 2) * KT + kidx) * 128 + d0) = wk_d; }
    }
}


DI float expm1_neg(float x) {
    const float p = x * (1.0f + x * (0.5f + x * (0.16666667f + x * (0.041666668f + x * (0.0083333338f + x * 0.0013888889f)))));
    return x > -0.25f ? p : __expf(x) - 1.0f;
}
DI void lru_gate_weights(const Frame& F, int layer, int hd) {
    const int h = hd >> 1, d = hd & 1; LAS unsigned char* wl = F.lds + 34816; const bf16_t* LRUW = (const bf16_t*)(F.ws + WS_LRUW);
#pragma unroll
    for (int i = 0; i < 8; ++i) { const int idx = F.tid + i * NTHR; const int g = idx >> 11, rem = idx & 2047, o = rem >> 4, ch = rem & 15;
        *(LAS u32x4*)(wl + g * 34816 + o * 272 + ch * 16) = *(const u32x4*)(LRUW + ((size_t)((layer * 2 + d) * 2 + g) * 4 + h) * 16384 + o * 128 + ch * 8); }
    if (F.tid < 128) { LAS float* vb = (LAS float*)(F.lds + 34816 + 2 * 34816); const int cc = (layer * 2 + d) * 512 + h * 128 + F.tid;
        vb[F.tid] = AIN(12)[cc]; vb[128 + F.tid] = AIN(14)[cc]; vb[256 + F.tid] = ((const float*)(F.ws + WS_SP))[cc]; }
}
DI void lru_gate_rows(const Frame& F, int unit, u32x2 (&raw)[11]) {
    const int tile = unit >> 3, h = (unit & 7) >> 1; int segrow0, seglen, t0;
    if (tile < 128) { const int b = tile >> 4; t0 = (tile & 15) * 128; segrow0 = b * SEQ; seglen = SEQ; } else { const int tt = tile - 128; const int b = tt >> 1; t0 = (tt & 1) * 128; segrow0 = RL + b * CTXL; seglen = CTXL; }
    const bf16_t* P = (const bf16_t*)(F.ws + WS_ARENA + AR_P); const int c4 = F.tid & 31, tr = F.tid >> 5; const int ch = h * 128 + 4 * c4;
#pragma unroll
    for (int i = 0; i < 11; ++i) { const int ti = t0 + tr * 8 - 2 + i; raw[i] = (u32x2){0u, 0u}; if (ti >= 0 && ti < seglen) raw[i] = *(const u32x2*)(P + (size_t)(segrow0 + ti) * PC + C_AX + ch); }
}
DI void lru_gate_unit(const Frame& F, const Args& a, int layer, int unit, u32x2 (&raw)[11], int next_unit) {
    const int tile = unit >> 3, h = (unit & 7) >> 1, d = unit & 1;
    int segrow0, seglen, t0;
    if (tile < 128) { const int b = tile >> 4; t0 = (tile & 15) * 128; segrow0 = b * SEQ; seglen = SEQ; } else { const int tt = tile - 128; const int b = tt >> 1; t0 = (tt & 1) * 128; segrow0 = RL + b * CTXL; seglen = CTXL; }
    const bf16_t* P = (const bf16_t*)(F.ws + WS_ARENA + AR_P);
    LAS unsigned char* ub = F.lds;
    LAS unsigned char* wl = F.lds + 34816;
    { const int c4 = F.tid & 31, tr = F.tid >> 5; const int ch = h * 128 + 4 * c4;
      f32x4 w[4];
#pragma unroll
      for (int j = 0; j < 4; ++j) w[j] = *(const f32x4*)(AIN(9) + (size_t)(layer * 4 + j) * 512 + ch);
      const f32x4 cb = *(const f32x4*)(AIN(10) + layer * 512 + ch);
      f32x4 x[11];
#pragma unroll
      for (int i = 0; i < 11; ++i) x[i] = (f32x4){bflo(raw[i].x), bfhi(raw[i].x), bflo(raw[i].y), bfhi(raw[i].y)};
#pragma unroll
      for (int tk = 0; tk < 8; ++tk) { f32x4 u = cb;
#pragma unroll
          for (int j = 0; j < 4; ++j) u += w[j] * x[tk + j];
          const int r = tr * 8 + tk; u32x2 pw; pw.x = pk2(u.x, u.y); pw.y = pk2(u.z, u.w); *(LAS u32x2*)(ub + r * 272 + 8 * c4) = pw; } }
    __syncthreads();
    if (next_unit < 1152) lru_gate_rows(F, next_unit, raw);
    const int fr = F.lane & 15, fq = F.lane >> 4, w16 = F.wave * 16;
    bf16x8 af[4];
#pragma unroll
    for (int ks = 0; ks < 4; ++ks) af[ks] = *(const LAS bf16x8*)(ub + (w16 + fr) * 272 + (ks * 32 + fq * 8) * 2);
    unsigned* LAB = (unsigned*)(F.ws + WS_ARENA + AR_LA);
#pragma unroll 4
    for (int nb = 0; nb < 8; ++nb) {
        f32x4 ar = {0.f, 0.f, 0.f, 0.f}, ai = {0.f, 0.f, 0.f, 0.f};
#pragma unroll
        for (int ks = 0; ks < 4; ++ks) { const bf16x8 wr = *(const LAS bf16x8*)(wl + (nb * 16 + fr) * 272 + (ks * 32 + fq * 8) * 2), wi = *(const LAS bf16x8*)(wl + 34816 + (nb * 16 + fr) * 272 + (ks * 32 + fq * 8) * 2);
            ar = MFMA16(wr, af[ks], ar); ai = MFMA16(wi, af[ks], ai); }
        const int c = nb * 16 + 4 * fq; const LAS float* vb = (const LAS float*)(F.lds + 34816 + 2 * 34816); const f32x4 vbr = *(const LAS f32x4*)(vb + c), vbi = *(const LAS f32x4*)(vb + 128 + c), vl = *(const LAS f32x4*)(vb + 256 + c);
        const u32x2 uw = *(const LAS u32x2*)(ub + (w16 + fr) * 272 + c * 2); const float uu[4] = {bflo(uw.x), bfhi(uw.x), bflo(uw.y), bfhi(uw.y)};
        f32x4 oa, ob;
#pragma unroll
        for (int j = 0; j < 4; ++j) { const float r = __builtin_amdgcn_rcpf(1.0f + __expf(-(ar[j] + vbr[j]))), ii = __builtin_amdgcn_rcpf(1.0f + __expf(-(ai[j] + vbi[j])));
            const float la = -8.0f * r * vl[j]; const float om = -expm1_neg(la);
            oa[j] = om; ob[j] = __builtin_amdgcn_sqrtf(om * (2.0f - om)) * (ii * uu[j]); }
        const size_t o = ((size_t)d * RT + segrow0 + t0 + w16 + fr) * 512 + h * 128 + c;
        *(u32x4*)(LAB + o) = (u32x4){pk2(oa[0], ob[0]), pk2(oa[1], ob[1]), pk2(oa[2], ob[2]), pk2(oa[3], ob[3])};
    }
    __syncthreads();
}

DI float log_sigmoidf_(float x) { const float e = __expf(-fabsf(x)); const float l1p = e < 1e-3f ? e * (1.0f - 0.5f * e) : __logf(1.0f + e); return fminf(x, 0.f) - l1p; }
DI void gla_a_unit(const Frame& F, const Args& a, int layer, int unit) {
    const int cg = unit >> 2, head = unit & 3; int b, row0, cc;
    if (cg < 256) { b = cg >> 5; const int ci = cg & 31; row0 = b * SEQ + ci * 64; cc = 4 + ci; } else { const int cx = cg - 256; b = cx >> 2; const int ci = cx & 3; row0 = RL + b * CTXL + ci * 64; cc = ci; }
    const bf16_t* P = (const bf16_t*)(F.ws + WS_ARENA + AR_P);
    LAS unsigned char* L = F.lds;
    LAS unsigned char* QR = L; LAS unsigned char* KR = L + 8192; LAS float* ZF = (LAS float*)(L + 16384); LAS float* ZB = (LAS float*)(L + 20480); LAS float* TOT = (LAS float*)(L + 24576);
    LAS unsigned char* QE = L + 28672; LAS unsigned char* KE = QE + 2 * 9216; LAS unsigned char* KD = KE + 2 * 9216; LAS unsigned char* VI = KD + 2 * 9216;
    { const int t = F.tid >> 3, c8 = (F.tid & 7) * 8; const bf16_t* pr = P + (size_t)(row0 + t) * PC;
      *(LAS u32x4*)(QR + t * 128 + c8 * 2) = *(const u32x4*)(pr + C_BQ + head * 64 + c8); *(LAS u32x4*)(KR + t * 128 + c8 * 2) = *(const u32x4*)(pr + C_BK + head * 64 + c8);
      const int c16 = (F.tid & 7) * 16; *(LAS u32x4*)(VI + t * 272 + c16 * 2) = *(const u32x4*)(pr + C_BV + head * 128 + c16); *(LAS u32x4*)(VI + t * 272 + c16 * 2 + 16) = *(const u32x4*)(pr + C_BV + head * 128 + c16 + 8);
      if (F.tid < 256) { const int tz = F.tid >> 2, q4 = (F.tid & 3) * 4; const bf16_t* pz = P + (size_t)(row0 + tz) * PC; const u32x2 zf = *(const u32x2*)(pz + C_ZF + q4), zb = *(const u32x2*)(pz + C_ZB + q4);
          *(LAS f32x4*)(ZF + tz * 16 + q4) = (f32x4){bflo(zf.x), bfhi(zf.x), bflo(zf.y), bfhi(zf.y)}; *(LAS f32x4*)(ZB + tz * 16 + q4) = (f32x4){bflo(zb.x), bfhi(zb.x), bflo(zb.y), bfhi(zb.y)}; } }
    __syncthreads();
    const int j = F.tid & 63, grp = F.tid >> 6;
    float cf[8], cb[8];
    { float wf[16], wb[16];
#pragma unroll
      for (int r = 0; r < 16; ++r) { wf[r] = AIN(16)[((size_t)(layer * 2 + 0) * 16 + r) * 256 + head * 64 + j]; wb[r] = AIN(16)[((size_t)(layer * 2 + 1) * 16 + r) * 256 + head * 64 + j]; }
      const float b2f = AIN(17)[(layer * 2 + 0) * 256 + head * 64 + j], b2b = AIN(17)[(layer * 2 + 1) * 256 + head * 64 + j];
#pragma unroll
      for (int tk = 0; tk < 8; ++tk) { const int t = grp * 8 + tk; float xf = b2f, xb = b2b;
#pragma unroll
          for (int r4 = 0; r4 < 4; ++r4) { const f32x4 zf = *(const LAS f32x4*)(ZF + t * 16 + 4 * r4), zb = *(const LAS f32x4*)(ZB + t * 16 + 4 * r4);
              xf += (zf.x * wf[4 * r4] + zf.y * wf[4 * r4 + 1]) + (zf.z * wf[4 * r4 + 2] + zf.w * wf[4 * r4 + 3]); xb += (zb.x * wb[4 * r4] + zb.y * wb[4 * r4 + 1]) + (zb.z * wb[4 * r4 + 2] + zb.w * wb[4 * r4 + 3]); }
          cf[tk] = log_sigmoidf_(xf) * (1.0f / 16.0f); cb[tk] = log_sigmoidf_(xb) * (1.0f / 16.0f); }
#pragma unroll
      for (int tk = 1; tk < 8; ++tk) cf[tk] += cf[tk - 1];
#pragma unroll
      for (int tk = 6; tk >= 0; --tk) cb[tk] += cb[tk + 1];
      TOT[(0 * 8 + grp) * 64 + j] = cf[7]; TOT[(1 * 8 + grp) * 64 + j] = cb[0]; }
    __syncthreads();
    { float pf = 0.f, sb = 0.f, lastf = 0.f, lastb = 0.f;
#pragma unroll
      for (int g = 0; g < 8; ++g) { const float tf = TOT[(0 * 8 + g) * 64 + j], tb = TOT[(1 * 8 + g) * 64 + j]; lastf += tf; lastb += tb; pf += (g < grp) ? tf : 0.f; sb += (g > grp) ? tb : 0.f; }
      bf16_t* GQE = (bf16_t*)(F.ws + WS_ARENA + AR_GQE);
#pragma unroll
      for (int tk = 0; tk < 8; ++tk) { const int t = grp * 8 + tk; const float cumf = pf + cf[tk], cumb = sb + cb[tk];
          const float q = bf2f(*(const LAS unsigned short*)(QR + t * 128 + j * 2)) * 0.125f, k = bf2f(*(const LAS unsigned short*)(KR + t * 128 + j * 2));
          const unsigned qef = f2bf(q * __expf(cumf)), qeb = f2bf(q * __expf(cumb));
          *(LAS unsigned short*)(QE + t * 144 + j * 2) = (unsigned short)qef; *(LAS unsigned short*)(QE + 9216 + t * 144 + j * 2) = (unsigned short)qeb;
          *(LAS unsigned short*)(KE + t * 144 + j * 2) = (unsigned short)f2bf(k * __expf(-cumf)); *(LAS unsigned short*)(KE + 9216 + t * 144 + j * 2) = (unsigned short)f2bf(k * __expf(-cumb));
          *(LAS unsigned short*)(KD + t * 144 + j * 2) = (unsigned short)f2bf(k * __expf(lastf - cumf)); *(LAS unsigned short*)(KD + 9216 + t * 144 + j * 2) = (unsigned short)f2bf(k * __expf(lastb - cumb));
          GQE[((size_t)0 * RT + row0 + t) * 256 + head * 64 + j] = (bf16_t)qef; GQE[((size_t)1 * RT + row0 + t) * 256 + head * 64 + j] = (bf16_t)qeb; }
      if (grp == 0) { float* GD = (float*)(F.ws + WS_GLAD); GD[((size_t)((b * 4 + head) * 2 + 0) * NCHUNK + cc) * 64 + j] = __expf(lastf); GD[((size_t)((b * 4 + head) * 2 + 1) * NCHUNK + cc) * 64 + j] = __expf(lastb); } }
    __syncthreads();
    const int fr = F.lane & 15, fq = F.lane >> 4, q_ = (F.lane & 15) >> 2, p_ = F.lane & 3;
    const unsigned vbase = (unsigned)(uintptr_t)VI;
    {
      const int tb = F.wave & 3, vh = F.wave >> 2;
      f32x4 oacc[4];
#pragma unroll
      for (int i = 0; i < 4; ++i) oacc[i] = (f32x4){0.f, 0.f, 0.f, 0.f};
#pragma unroll
      for (int d = 0; d < 2; ++d) {
          f32x4 st[4];
#pragma unroll
          for (int si = 0; si < 4; ++si) { st[si] = (f32x4){0.f, 0.f, 0.f, 0.f};
#pragma unroll
              for (int ks = 0; ks < 2; ++ks) { const bf16x8 ka = *(const LAS bf16x8*)(KE + d * 9216 + (16 * si + fr) * 144 + (ks * 32 + fq * 8) * 2), qb = *(const LAS bf16x8*)(QE + d * 9216 + (16 * tb + fr) * 144 + (ks * 32 + fq * 8) * 2);
                  st[si] = MFMA16(ka, qb, st[si]); }
              const int t_ = 16 * tb + fr;
#pragma unroll
              for (int jj = 0; jj < 4; ++jj) { const int s_ = 16 * si + 4 * fq + jj; const bool keep = d == 0 ? (s_ <= t_) : (s_ >= t_); st[si][jj] = keep ? st[si][jj] : 0.f; } }
#pragma unroll
          for (int kk = 0; kk < 2; ++kk) { u32x4 pw; pw.x = cvt_pk_bf16(st[2 * kk][0], st[2 * kk][1]); pw.y = cvt_pk_bf16(st[2 * kk][2], st[2 * kk][3]); pw.z = cvt_pk_bf16(st[2 * kk + 1][0], st[2 * kk + 1][1]); pw.w = cvt_pk_bf16(st[2 * kk + 1][2], st[2 * kk + 1][3]);
              const bf16x8 pa = __builtin_bit_cast(bf16x8, pw);
#pragma unroll
              for (int i = 0; i < 4; ++i) { const unsigned col = (unsigned)((vh * 4 + i) * 16 + 4 * p_) * 2u;
                  const bf16x8 vf = tr_read_pair(vbase + (unsigned)(32 * kk + 4 * fq + q_) * 272u + col, vbase + (unsigned)(32 * kk + 16 + 4 * fq + q_) * 272u + col);
                  oacc[i] = MFMA16(vf, pa, oacc[i]); } }
      }
      bf16_t* GOI = (bf16_t*)(F.ws + WS_ARENA + AR_GOI);
#pragma unroll
      for (int i = 0; i < 4; ++i) *(u32x2*)(GOI + (size_t)(row0 + 16 * tb + fr) * 512 + head * 128 + (vh * 4 + i) * 16 + 4 * fq) = (u32x2){pk2(oacc[i][0], oacc[i][1]), pk2(oacc[i][2], oacc[i][3])};
    }
    {
      bf16_t* GS = (bf16_t*)(F.ws + WS_ARENA + AR_GS);
#pragma unroll
      for (int d = 0; d < 2; ++d) {
          const unsigned kdb = (unsigned)(uintptr_t)(KD + d * 9216);
          bf16x8 va[2];
#pragma unroll
          for (int ks = 0; ks < 2; ++ks) { const unsigned a0 = vbase + (unsigned)(32 * ks + 8 * fq + q_) * 272u + (unsigned)(16 * F.wave + 4 * p_) * 2u; va[ks] = tr_read_pair(a0, a0 + 4u * 272u); }
#pragma unroll
          for (int jt = 0; jt < 4; ++jt) { bf16x8 kb[2];
#pragma unroll
              for (int ks = 0; ks < 2; ++ks) { const unsigned a0 = kdb + (unsigned)(32 * ks + 8 * fq + q_) * 144u + (unsigned)(16 * jt + 4 * p_) * 2u; kb[ks] = tr_read_pair(a0, a0 + 4u * 144u); }
              f32x4 u = {0.f, 0.f, 0.f, 0.f};
#pragma unroll
              for (int ks = 0; ks < 2; ++ks) u = MFMA16(kb[ks], va[ks], u);
              bf16_t* dst = GS + ((size_t)((b * 4 + head) * 2 + d) * NCHUNK + cc) * 8192;
              *(u32x2*)(dst + (16 * F.wave + fr) * 64 + 16 * jt + 4 * fq) = (u32x2){pk2(u[0], u[1]), pk2(u[2], u[3])}; }
      }
    }
    __syncthreads();
}

template <int STP> DI void lru_scan_dir(const unsigned* pab, unsigned* phc) {
    float h = 0.f, cp = 1.f; unsigned w0[32], w1[32];
#define LS_LOAD(W_) do { _Pragma("unroll") for (int i = 0; i < 32; ++i) W_[i] = pab[i * STP]; pab += 32 * STP; } while (0)
#define LS_STEP(W_) do { _Pragma("unroll") for (int i = 0; i < 32; ++i) { const float a_ = 1.0f - bflo(W_[i]); h = a_ * h + bfhi(W_[i]); cp *= a_; phc[i * STP] = pk2(h, cp); } phc += 32 * STP; } while (0)
    LS_LOAD(w0);
#pragma unroll 1
    for (int t = 0; t < 256; t += 64) { LS_LOAD(w1); LS_STEP(w0); if (t + 64 < 256) LS_LOAD(w0); LS_STEP(w1); }
#undef LS_LOAD
#undef LS_STEP
}
DI void lru_scan_unit(const Frame& F, int unit) {
    const int seg = unit % 9, bd = unit / 9, b = bd >> 1, d = bd & 1; const int c = F.wave * 64 + F.lane;
    const int r0 = seg == 0 ? RL + b * CTXL : b * SEQ + (seg - 1) * 256;
    const size_t base = ((size_t)d * RT + (d == 0 ? r0 : r0 + 255)) * 512 + c;
    const unsigned* pab = (const unsigned*)(F.ws + WS_ARENA + AR_LA) + base; unsigned* phc = (unsigned*)(F.ws + WS_ARENA + AR_LH) + base;
    if (d == 0) lru_scan_dir<512>(pab, phc); else lru_scan_dir<-512>(pab, phc);
}
DI void lru_final_unit(const Frame& F, int unit4) {
    const int unit = unit4 >> 2, qtr = unit4 & 3; const int b = unit / 9, seg = unit % 9; const int c = F.tid;
    const unsigned* LHC = (const unsigned*)(F.ws + WS_ARENA + AR_LH) + c;
    const bf16_t* P = (const bf16_t*)(F.ws + WS_ARENA + AR_P); bf16_t* Y = (bf16_t*)(F.ws + WS_Y);
    unsigned wf[8], wb[9];
#pragma unroll
    for (int s2 = 0; s2 < 8; ++s2) { const size_t r = (s2 == 0 ? RL + b * CTXL : b * SEQ + (s2 - 1) * 256) + 255; wf[s2] = LHC[r * 512]; }
    wb[0] = LHC[((size_t)RT + RL + b * CTXL) * 512];
#pragma unroll
    for (int s2 = 1; s2 <= 8; ++s2) wb[s2] = LHC[((size_t)RT + b * SEQ + (s2 - 1) * 256) * 512];
    float cf = 0.f, cb = 0.f;
#pragma unroll
    for (int s2 = 0; s2 < 8; ++s2) if (s2 < seg) cf = bfhi(wf[s2]) * cf + bflo(wf[s2]);
    if (seg > 0) { cb = bflo(wb[0]);
#pragma unroll
        for (int s2 = 8; s2 >= 1; --s2) if (s2 > seg) cb = bfhi(wb[s2]) * cb + bflo(wb[s2]); }
    const size_t r0 = (seg == 0 ? RL + b * CTXL : b * SEQ + (seg - 1) * 256) + qtr * 64;
    const unsigned* pf = LHC + r0 * 512; const unsigned* pb = LHC + ((size_t)RT + r0) * 512;
    const bf16_t* px = P + r0 * PC + C_AG + c; bf16_t* py = Y + r0 * DM + c;
    unsigned fa[8], ba[8], fb[8], bb[8]; unsigned short xa[8], xb[8];
#define LF_LOAD(F_, B_, X_) do { _Pragma("unroll") for (int i = 0; i < 8; ++i) { F_[i] = pf[i * 512]; B_[i] = pb[i * 512]; X_[i] = (unsigned short)px[(size_t)i * PC]; } pf += 8 * 512; pb += 8 * 512; px += (size_t)8 * PC; } while (0)
#define LF_STEP(F_, B_, X_) do { _Pragma("unroll") for (int i = 0; i < 8; ++i) { const float hf = bflo(F_[i]) + bfhi(F_[i]) * cf, hb = bflo(B_[i]) + bfhi(B_[i]) * cb; const float x = bf2f(X_[i]); \
        const float ge = x / (1.0f + __expf(-1.5957691216057308f * (x + 0.044715f * x * x * x)));        \
        py[(size_t)i * DM] = (bf16_t)f2bf((hf + hb) * ge); } py += (size_t)8 * DM; } while (0)
    LF_LOAD(fa, ba, xa);
#pragma unroll 1
    for (int t = 0; t < 64; t += 16) { LF_LOAD(fb, bb, xb); LF_STEP(fa, ba, xa); if (t + 16 < 64) LF_LOAD(fa, ba, xa); LF_STEP(fb, bb, xb); }
#undef LF_LOAD
#undef LF_STEP
}
DI int gla_cc(int d, int step) { return d == 0 ? step : (step < 4 ? 3 - step : 39 - step); }
DI void gla_b_unit(const Frame& F, int chain) {
    const int d = chain & 1; const bf16_t* GS = (const bf16_t*)(F.ws + WS_ARENA + AR_GS) + (size_t)chain * NCHUNK * 8192 + F.tid * 4; bf16_t* GSB = (bf16_t*)(F.ws + WS_ARENA + AR_GSB) + (size_t)chain * NCHUNK * 8192 + F.tid * 4; const float* GD = (const float*)(F.ws + WS_GLAD) + (size_t)chain * NCHUNK * 64 + (F.tid & 15) * 4;
    f32x4 S[4], Dv[6]; u32x2 U[6][4];
#pragma unroll
    for (int i = 0; i < 4; ++i) S[i] = (f32x4){0.f, 0.f, 0.f, 0.f};
#define GB_LOAD(slot_, step_) do { const int cc_ = gla_cc(d, (step_)); _Pragma("unroll") for (int i = 0; i < 4; ++i) U[slot_][i] = *(const u32x2*)(GS + (size_t)cc_ * 8192 + 2048 * i); Dv[slot_] = *(const f32x4*)(GD + cc_ * 64); } while (0)
#define GB_STEP(slot_, step_) do { const int cc_ = gla_cc(d, (step_)); _Pragma("unroll") for (int i = 0; i < 4; ++i) { *(u32x2*)(GSB + (size_t)cc_ * 8192 + 2048 * i) = (u32x2){pk2(S[i].x, S[i].y), pk2(S[i].z, S[i].w)}; S[i] = Dv[slot_] * S[i] + (f32x4){bflo(U[slot_][i].x), bfhi(U[slot_][i].x), bflo(U[slot_][i].y), bfhi(U[slot_][i].y)}; } } while (0)
    GB_LOAD(0, 0); GB_LOAD(1, 1); GB_LOAD(2, 2); GB_LOAD(3, 3); GB_LOAD(4, 4);
#pragma unroll 1
    for (int step = 0; step < NCHUNK; step += 6) {
        GB_LOAD(5, step + 5); GB_STEP(0, step);
        if (step + 6 < NCHUNK) GB_LOAD(0, step + 6); GB_STEP(1, step + 1);
        if (step + 7 < NCHUNK) GB_LOAD(1, step + 7); GB_STEP(2, step + 2);
        if (step + 8 < NCHUNK) GB_LOAD(2, step + 8); GB_STEP(3, step + 3);
        if (step + 9 < NCHUNK) GB_LOAD(3, step + 9); GB_STEP(4, step + 4);
        if (step + 10 < NCHUNK) GB_LOAD(4, step + 10); GB_STEP(5, step + 5);
    }
#undef GB_LOAD
#undef GB_STEP
}
DI void gla_c_unit(const Frame& F, const Args& a, int layer, int unit) {
    const int cg = unit >> 1, head = (unit & 1) * 2 + (F.wave >> 2), tb = F.wave & 3; int b, row0, cc;
    if (cg < 256) { b = cg >> 5; const int ci = cg & 31; row0 = b * SEQ + ci * 64; cc = 4 + ci; } else { const int cx = cg - 256; b = cx >> 2; const int ci = cx & 3; row0 = RL + b * CTXL + ci * 64; cc = ci; }
    const int fr = F.lane & 15, fq = F.lane >> 4;
    const bf16_t* GQE = (const bf16_t*)(F.ws + WS_ARENA + AR_GQE); const bf16_t* GSB = (const bf16_t*)(F.ws + WS_ARENA + AR_GSB); const bf16_t* GOI = (const bf16_t*)(F.ws + WS_ARENA + AR_GOI);
    const bf16_t* P = (const bf16_t*)(F.ws + WS_ARENA + AR_P); bf16_t* Y = (bf16_t*)(F.ws + WS_Y);
    f32x4 acc[8];
#pragma unroll
    for (int nt = 0; nt < 8; ++nt) acc[nt] = (f32x4){0.f, 0.f, 0.f, 0.f};
#pragma unroll
    for (int d = 0; d < 2; ++d) { const bf16_t* ST = GSB + ((size_t)((b * 4 + head) * 2 + d) * NCHUNK + cc) * 8192;
#pragma unroll
        for (int ks = 0; ks < 2; ++ks) { const bf16x8 af = *(const bf16x8*)(GQE + ((size_t)d * RT + row0 + 16 * tb + fr) * 256 + head * 64 + ks * 32 + fq * 8);
#pragma unroll
            for (int nt = 0; nt < 8; ++nt) acc[nt] = MFMA16(*(const bf16x8*)(ST + (nt * 16 + fr) * 64 + ks * 32 + fq * 8), af, acc[nt]); } }
    const size_t r = (size_t)(row0 + 16 * tb + fr);
    u32x2 gr[8], oi[8]; f32x4 gnv[8];
#pragma unroll
    for (int nt = 0; nt < 8; ++nt) { gnv[nt] = *(const f32x4*)(AIN(18) + layer * 128 + nt * 16 + 4 * fq); gr[nt] = *(const u32x2*)(P + r * PC + C_BG + head * 128 + nt * 16 + 4 * fq);
        oi[nt] = *(const u32x2*)(GOI + r * 512 + head * 128 + nt * 16 + 4 * fq); }
    float ssq = 0.f;
#pragma unroll
    for (int nt = 0; nt < 8; ++nt)
#pragma unroll
        for (int jj = 0; jj < 4; ++jj) { const unsigned ow = (jj < 2) ? oi[nt].x : oi[nt].y; acc[nt][jj] += (jj & 1) ? bfhi(ow) : bflo(ow); ssq += acc[nt][jj] * acc[nt][jj]; }
    ssq += __shfl_xor(ssq, 16); ssq += __shfl_xor(ssq, 32);
    const float rstd = rsqrtf(ssq * (1.0f / 128.0f) + RMS_EPS);
#pragma unroll
    for (int nt = 0; nt < 8; ++nt) { const float g[4] = {bflo(gr[nt].x), bfhi(gr[nt].x), bflo(gr[nt].y), bfhi(gr[nt].y)}; float y[4];
#pragma unroll
        for (int jj = 0; jj < 4; ++jj) y[jj] = acc[nt][jj] * rstd * gnv[nt][jj] * siluf_(g[jj]);
        *(u32x2*)(Y + r * DM + 512 + head * 128 + nt * 16 + 4 * fq) = (u32x2){pk2(y[0], y[1]), pk2(y[2], y[3])}; }
}
DI void scan_attn_phase(const Frame& F, const Args& a, int layer, bool need_ctx, int rep) {
    volatile LAS unsigned* qw = (volatile LAS unsigned*)(F.lds + MISC_OFF + 64);
    unsigned* head = F.ctl + CW_QUEUE + 64 * (layer + 2 * rep);
    const int n_units = 256 + 256 + (need_ctx ? 64 : 0);
    const bf16_t* QC = (const bf16_t*)(F.ws + WS_ARENA + AR_QC); const bf16_t* KC = (const bf16_t*)(F.ws + WS_ARENA + AR_KC); const bf16_t* VC = (const bf16_t*)(F.ws + WS_ARENA + AR_VC);
    const bf16_t* QD = (const bf16_t*)(F.ws + WS_ARENA + AR_QD); const bf16_t* KD = (const bf16_t*)(F.ws + WS_ARENA + AR_KD); const bf16_t* VD = (const bf16_t*)(F.ws + WS_ARENA + AR_VD);
    bf16_t* Y = (bf16_t*)(F.ws + WS_Y);
    for (int u = F.bid; u < 208; u += F.G) { if (u < 64) { if (rep == 0) gla_b_unit(F, u); } else lru_scan_unit(F, u - 64); }
    if (F.bid < 208 && rep == 0) { asm volatile("s_waitcnt vmcnt(0)" ::: "memory"); __syncthreads();
        if (F.tid == 0) { __builtin_amdgcn_fence(__ATOMIC_RELEASE, "agent"); asm volatile("s_waitcnt vmcnt(0)" ::: "memory"); (void)xb_add(F.ctl + CW_QUEUE + 64 * (4 + layer), 1u); } }
    for (;;) {
        __syncthreads();
        if (F.tid == 0) qw[0] = __hip_atomic_fetch_add(head, 1u, __ATOMIC_RELAXED, __HIP_MEMORY_SCOPE_AGENT);
        __syncthreads();
        int u = (int)qw[0]; if (u >= n_units) break;
        { int b, h, qoff, yrow, ycol, NT = 4, skip = 0, q0 = 0; bool win = false, sink = false, isD = false;
          if (u < 256) { b = u >> 5; h = (u >> 3) & 3; const int qb = u & 7; qoff = CTXL + 256 * qb; yrow = b * SEQ + 256 * qb; NT = KT / 64; }
          else if (u < 512) { u -= 256; b = u >> 5; h = (u >> 3) & 3; const int qb = u & 7; const int bs = qb == 0 ? 0 : 256 * qb - 128, be = qb == 7 ? SEQ : 256 * qb + 384;
              qoff = CTXL + 256 * qb; yrow = b * SEQ + 256 * qb; NT = 4 + (be - bs) / 64; skip = bs; q0 = 256 * qb; win = true; sink = true; isD = true; }
          else if (u < 544) { u -= 512; b = u >> 2; h = u & 3; qoff = 0; yrow = RL + b * CTXL; }
          else { u -= 544; b = u >> 2; h = u & 3; qoff = 0; yrow = RL + b * CTXL; sink = true; isD = true; }
          ycol = (isD ? 1536 : 1024) + h * 128;
          const bf16_t* Qp = (isD ? QD : QC) + ((size_t)(b * 4 + h) * KT + qoff) * 128; const bf16_t* Kp = (isD ? KD : KC) + (size_t)(b * 2 + (h >> 1)) * KT * 128; const bf16_t* Vp = (isD ? VD : VC) + (size_t)(b * 2 + (h >> 1)) * KT * 128;
          att::attn_body(Qp, Kp, Vp, Y + (size_t)yrow * DM + ycol, NT, skip, q0, AIN(20)[layer * 4 + h], win, sink, (char*)F.lds, F.tid); }
    }
}

#ifndef LAST_PHASE
#define LAST_PHASE 21
#endif
constexpr int PH_PER_LAYER = 10, N_PHASES = 2 + NLAYER * PH_PER_LAYER;

#define PHASE_BEGIN() do { int w_s = wave_s; asm volatile("" : "+s"(w_s)); unsigned z_ = 0u; asm volatile("" : "+s"(z_)); int t_ = w_s * 64 + (int)__builtin_amdgcn_mbcnt_hi(~0u, __builtin_amdgcn_mbcnt_lo(~0u, z_)); asm volatile("" : "+v"(t_)); F.tid = t_; F.lane = t_ & 63; F.wave = w_s; \
        unsigned long long zo_ = 0ull; asm volatile("" : "+s"(zo_)); F.ws = args.ws + zo_; F.ctl = (unsigned*)(F.ws + WS_CTL);       int b_ = blockIdx.x; asm volatile("" : "+s"(b_)); F.bid = b_; } while (0)
#ifndef PH_MASK
#define PH_MASK 0xFFF
#endif
#define PHON(t) (((PH_MASK) >> (t)) & 1)
#ifndef DUP_MASK
#define DUP_MASK 0
#endif
#define NREP(t) (1 + (((DUP_MASK) >> (t)) & 1))
#define IN(k) ((k) <= LAST_PHASE)
#define SEAM(k) do { if ((k) < LAST_PHASE) { XcdBarrier b2_; b2_.bar = F.ctl + CW_BAR; b2_.x = (unsigned)__builtin_amdgcn_readfirstlane((int)xb_xcc_id()); b2_.st = (volatile LAS unsigned*)(F.lds + MISC_OFF) + 8; xcd_barrier(b2_, F.tid); } } while (0)
#define XL (args.out)
#define XLB ((bf16_t*)(F.ws + WS_ARENA + AR_XLB))
#define XCB ((bf16_t*)(F.ws + WS_XC))
#define H ((bf16_t*)(F.ws + WS_H))
#define Y ((bf16_t*)(F.ws + WS_Y))
#define P ((bf16_t*)(F.ws + WS_ARENA + AR_P))
template <int layer> DI void run_layer(Frame& F, const Args& args, const int wave_s) {
    constexpr bool F8 = MOE_FP8[layer]; constexpr bool G2F8 = MOE2_FP8[layer];
        const int pb = 2 + layer * PH_PER_LAYER; const bool need_ctx = layer < NLAYER - 1; const int ntok = need_ctx ? RT : RL;
        if (PHON(2) && IN(pb + 0)) { PHASE_BEGIN(); for (int rep = 0; rep < NREP(2); ++rep) {
            pg8::DenseSched S; S.T.init(RT / 256, PC / 256, F.G, F.bid);
            pg8::EpiBf16 E{P, PC, IN_FP8[layer] ? 1.0f / SW_IN : 1.0f};
            if constexpr (IN_FP8[layer]) pg8::gemm_phase<DM, 1, 2, SP2_FP8>(F.tid, F.lds, H, (const bf16_t*)(F.ws + WS_WIN) + (size_t)layer * PC * DM, nullptr, S, E);
            else pg8::gemm_phase<DM, 2, 0, SP2_BF16>(F.tid, F.lds, H, (const bf16_t*)(F.ws + WS_WIN) + (size_t)layer * PC * DM, nullptr, S, E);
            } SEAM(pb + 0);
        }
        if (PHON(3) && IN(pb + 1)) { PHASE_BEGIN(); for (int rep = 0; rep < NREP(3); ++rep) {
            for (int r2 = 0; r2 < NREP(12); ++r2) qkv_prep_rows(F, args, layer);
            __syncthreads();
            for (int r2 = 0; r2 < NREP(13); ++r2) { lru_gate_weights(F, layer, F.bid & 7); u32x2 graw[11]; lru_gate_rows(F, F.bid, graw); for (int u = F.bid; u < 1152; u += F.G) lru_gate_unit(F, args, layer, u, graw, u + F.G); }
            for (int r2 = 0; r2 < NREP(14); ++r2) for (int u = (F.bid + 128) & 255; u < 1152; u += F.G) gla_a_unit(F, args, layer, u);
            } SEAM(pb + 1);
        }
        if (PHON(4) && IN(pb + 2)) { PHASE_BEGIN(); scan_attn_phase(F, args, layer, need_ctx, 0); if (NREP(4) == 2) { __syncthreads(); scan_attn_phase(F, args, layer, need_ctx, 1); } }
        if (PHON(5) && IN(pb + 3)) { PHASE_BEGIN();
            { const int ngc = need_ctx ? 576 : 512, nlf = need_ctx ? 288 : 256;
              volatile LAS unsigned* qw = (volatile LAS unsigned*)(F.lds + MISC_OFF + 64); unsigned* head = F.ctl + CW_QUEUE + 64 * (6 + layer);
              __syncthreads();
              if (F.tid == 0) { unsigned* cnt = F.ctl + CW_QUEUE + 64 * (4 + layer); unsigned* bar = F.ctl + CW_BAR; XB_SPIN(xb_ld(cnt) < 208u, bar);
                  __builtin_amdgcn_fence(__ATOMIC_ACQUIRE, "agent"); asm volatile("s_waitcnt vmcnt(0)" ::: "memory"); }
              for (;;) {
                  __syncthreads();
                  if (F.tid == 0) qw[0] = __hip_atomic_fetch_add(head, 1u, __ATOMIC_RELAXED, __HIP_MEMORY_SCOPE_AGENT);
                  __syncthreads();
                  const int u = (int)qw[0]; if (u >= ngc + nlf) break;
                  if (u >= nlf) gla_c_unit(F, args, layer, u - nlf);
                  else { const int v = u; lru_final_unit(F, need_ctx ? v : (((v >> 5) * 9 + 1 + ((v >> 2) & 7)) * 4 + (v & 3))); } } }
            SEAM(pb + 3);
        }
        if (PHON(6) && IN(pb + 4)) { PHASE_BEGIN(); for (int rep = 0; rep < NREP(6); ++rep) {
            pg8::DenseSched S; S.T.init(ntok / 256, DM / 256, F.G, F.bid);
            pg8::EpiBf16 E{(bf16_t*)(F.ws + WS_ARENA + AR_YO), DM, 1.0f};
            pg8::gemm_phase<DM, 2, 0, SP2_BF16>(F.tid, F.lds, Y, (const bf16_t*)(F.ws + WS_WOUT) + (size_t)layer * DM * DM, nullptr, S, E);
            } SEAM(pb + 4);
        }
        if (PHON(7) && IN(pb + 5)) { PHASE_BEGIN(); postmix_phase<F8, layer != 0>(F, args, layer, layer == 0 ? (const void*)AIN(0) : (const void*)XLB, layer == 0 ? (const void*)AIN(2) : (const void*)XCB, XLB, XCB, ntok); if (layer == 0 && NREP(7) == 2) postmix_phase<F8, false>(F, args, layer, AIN(0), AIN(2), XLB, XCB, ntok); SEAM(pb + 5); }
        if (PHON(8) && IN(pb + 6)) { PHASE_BEGIN(); for (int rep = 0; rep < NREP(8); ++rep) { slots_phase(F, layer, ntok, F8 ? DM : DM * 2); } SEAM(pb + 6); }
        if (PHON(9) && IN(pb + 7)) { PHASE_BEGIN(); for (int rep = 0; rep < NREP(9); ++rep) {
            const LAS unsigned short* tile_e = (const LAS unsigned short*)(F.lds + TBL_OFF); const int nrt = (int)((LAS unsigned*)(F.lds + TBL_OFF + 2816))[0];
            pg8::MoeSched S; S.T.init(nrt + ntok / 256, 4, F.G, F.bid); S.tile_e = tile_e;
            pg8::EpiSwiGlu<G2F8> E{(void*)(F.ws + WS_ARENA + AR_ACT), F8 ? 1.0f / SW_GU : 1.0f, G2F8 ? S_ACT : 1.0f};
            LAS unsigned short* lrows = (LAS unsigned short*)(F.lds + LROWS_OFF);
            { const unsigned* ROWOFF = (const unsigned*)(F.ws + WS_META + MT_ROWOFF); pg8::Unit uu;
              for (int i = 0; i < 12 && S.next(i, uu); ++i) if (F.tid < 256) lrows[i * 256 + F.tid] = (unsigned short)(ROWOFF[uu.pm * 256 + F.tid] / (unsigned)(F8 ? DM : DM * 2));
              __syncthreads(); }
            pg8::gemm_phase<DM, F8 ? 1 : 2, 1, SP2_FP8>(F.tid, F.lds, H, (const bf16_t*)(F.ws + WS_WGU + (size_t)layer * 65 * 1024 * DM * 2), lrows, S, E);
            } SEAM(pb + 7);
        }
        if (PHON(10) && IN(pb + 8)) { PHASE_BEGIN(); for (int rep = 0; rep < NREP(10); ++rep) {
            const LAS unsigned short* tile_e = (const LAS unsigned short*)(F.lds + TBL_OFF); const int nrt = (int)((LAS unsigned*)(F.lds + TBL_OFF + 2816))[0];
            pg8::MoeSched S; S.T.init(nrt + ntok / 256, 8, F.G, F.bid); S.tile_e = tile_e;
            pg8::EpiFp8 E{(unsigned char*)(F.ws + WS_ARENA + AR_MO), DM, G2F8 ? S_MO / (S_ACT * SW_D) : S_MO};
            if constexpr (G2F8) pg8::gemm_phase<EH, 1, 2, SP2_FP8>(F.tid, F.lds, (const bf16_t*)(F.ws + WS_ARENA + AR_ACT), (const bf16_t*)(F.ws + WS_WD + (size_t)layer * 65 * DM * EH * 2), nullptr, S, E);
            else pg8::gemm_phase<EH, 2, 0, SP2_BF16>(F.tid, F.lds, (const bf16_t*)(F.ws + WS_ARENA + AR_ACT), (const bf16_t*)(F.ws + WS_WD + (size_t)layer * 65 * DM * EH * 2), nullptr, S, E);
            } SEAM(pb + 8);
        }
        if (PHON(11) && IN(pb + 9)) { PHASE_BEGIN();
            combine_phase_ol(F.ws, F.tid, F.wave, F.bid, layer, XL, ntok, need_ctx ? 1 : 0);
            SEAM(pb + 9);
        }
    }

__global__ void __launch_bounds__(NTHR, 2) fwd_kernel(Args args) {
    extern __shared__ __attribute__((aligned(16))) unsigned char lds_raw[];
    Frame F;
    F.lds = (LAS unsigned char*)lds_raw; F.ws = args.ws; F.ctl = (unsigned*)(F.ws + WS_CTL);
    F.tid = threadIdx.x; F.lane = F.tid & 63; F.wave = __builtin_amdgcn_readfirstlane(F.tid >> 6); F.bid = blockIdx.x;
    volatile LAS unsigned* MISC = (volatile LAS unsigned*)(F.lds + MISC_OFF);
    const int wave_s = F.wave;
    if (F.tid < 64) MISC[F.tid] = 0u;
    if (F.tid == 0) { LAS unsigned long long* tb = (LAS unsigned long long*)(F.lds + PTR_OFF);
#pragma unroll
        for (int i = 0; i < 29; ++i) tb[i] = (unsigned long long)args.in[i]; }
    __syncthreads();
    (void)xcd_barrier_post(F.ctl + CW_BAR, MISC + 8);
    if (PHON(0) && IN(0)) { PHASE_BEGIN(); p0_mod(F, args); for (int rep = 0; rep < NREP(0); ++rep) { p0_convert(F, args); p0_convert_fast(F); } }
    if (PHON(1) && IN(1)) { PHASE_BEGIN();
        __syncthreads();
        if (F.tid == 0) { unsigned* cnt = F.ctl + CW_QUEUE + 64 * 8; unsigned* bar = F.ctl + CW_BAR; XB_SPIN(xb_ld(cnt) < 32u, bar); __builtin_amdgcn_fence(__ATOMIC_ACQUIRE, "agent"); asm volatile("s_waitcnt vmcnt(0)" ::: "memory"); }
        __syncthreads();
        for (int rep = 0; rep < NREP(1); ++rep) pre_rows(F, args, 0, AIN(0), AIN(2), RT); SEAM(1); }
    run_layer<0>(F, args, wave_s);
    run_layer<1>(F, args, wave_s);
}
#undef IN
#undef SEAM
#undef XL
#undef XLB
#undef XCB
#undef H
#undef Y
#undef P

extern "C" void kernel_launch(void* const* d_in, const int* in_sizes, int n_in, void* d_out, int out_size, void* d_ws, size_t ws_size, hipStream_t stream) {
    static int grid = 0;
    if (grid == 0) {
        if (n_in != 29 || out_size != RL * DM || ws_size < WS_END) { fprintf(stderr, "kernel_launch: unexpected shapes / workspace (n_in %d out %d ws %zu need %zu)\n", n_in, out_size, ws_size, (size_t)WS_END); grid = -1; return; }
        int dev = 0, cus = 0, per_cu = 0;
        if (hipGetDevice(&dev) != hipSuccess || hipDeviceGetAttribute(&cus, hipDeviceAttributeMultiprocessorCount, dev) != hipSuccess) { grid = -1; return; }
        if (hipFuncSetAttribute((const void*)fwd_kernel, hipFuncAttributeMaxDynamicSharedMemorySize, LDS_BYTES) != hipSuccess) { fprintf(stderr, "kernel_launch: hipFuncSetAttribute failed\n"); grid = -1; return; }
        if (hipOccupancyMaxActiveBlocksPerMultiprocessor(&per_cu, (const void*)fwd_kernel, NTHR, LDS_BYTES) != hipSuccess || per_cu < 1) { fprintf(stderr, "kernel_launch: occupancy query reports %d\n", per_cu); }
        (void)hipGetLastError();
        if (cus < 256) { fprintf(stderr, "kernel_launch: this kernel needs 256 CUs (one resident workgroup each), device has %d\n", cus); grid = -1; return; }
        grid = 256;
    }
    if (grid < 0) return;
    (void)hipMemsetAsync((char*)d_ws + WS_CTL, 0, 1 * MiB, stream);
    Args a{};
    for (int i = 0; i < 29; ++i) a.in[i] = (const float*)d_in[i];
    a.out = (float*)d_out; a.ws = (unsigned char*)d_ws;
    a.ph_lo = 0; a.ph_hi = N_PHASES;
    hipLaunchKernelGGL(fwd_kernel, dim3(grid), dim3(NTHR), LDS_BYTES, stream, a);
    const hipError_t le = hipPeekAtLastError();
    if (le != hipSuccess) fprintf(stderr, "kernel_launch: launch failed: %s\n", hipGetErrorName(le));
}
```

```cpp
#include <hip/hip_runtime.h>
#include <cstdio>
#include <cstdint>

#define LAS __attribute__((address_space(3)))
#define GAS __attribute__((address_space(1)))
typedef unsigned short bf16_t;
typedef short bf16x8 __attribute__((ext_vector_type(8)));
typedef short s16x4 __attribute__((ext_vector_type(4)));
typedef float f32x4 __attribute__((ext_vector_type(4)));
typedef float f32x2 __attribute__((ext_vector_type(2)));
typedef float f32x16 __attribute__((ext_vector_type(16)));
typedef unsigned u32x4 __attribute__((ext_vector_type(4)));
typedef unsigned u32x2 __attribute__((ext_vector_type(2)));
#define DI __device__ __forceinline__

constexpr int DM = 2048, NB = 8, SEQ = 2048, CTXL = 256, NLAYER = 2;
constexpr int RL = NB * SEQ;
constexpr int RC = NB * CTXL;
constexpr int RT = RL + RC;
constexpr int INC = 4640;
constexpr int PC = 4864;
constexpr int C_AX = 0, C_AG = 512, C_BQ = 1024, C_BK = 1280, C_BV = 1536, C_BG = 2048, C_CQ = 2560, C_CK = 3072, C_CV = 3328, C_DQ = 3584, C_DK = 4096, C_DV = 4352, C_ZF = 4608, C_ZB = 4624;
constexpr int NEXP = 64, EH = 512, TOPK = 8;
#ifndef MOE_FP8_L0
#define MOE_FP8_L0 1
#endif
#ifndef MOE_FP8_L1
#define MOE_FP8_L1 1
#endif
constexpr bool MOE_FP8[2] = {MOE_FP8_L0 != 0, MOE_FP8_L1 != 0};
#ifndef MOE2_FP8_L0
#define MOE2_FP8_L0 1
#endif
#ifndef MOE2_FP8_L1
#define MOE2_FP8_L1 1
#endif
constexpr bool MOE2_FP8[2] = {MOE2_FP8_L0 != 0, MOE2_FP8_L1 != 0};
#ifndef IN1_FP8
#define IN1_FP8 1
#endif
#ifndef IN0_FP8
#define IN0_FP8 1
#endif
constexpr bool IN_FP8[2] = {IN0_FP8 != 0, IN1_FP8 != 0};
constexpr float SW_IN = 64.f;
#ifndef SP2_FP8
#define SP2_FP8 true
#endif
#ifndef SP2_BF16
#define SP2_BF16 true
#endif
constexpr float SW_GU = 64.f, SW_D = 32.f, S_ACT = 4.f, S_MO = 16.f;
constexpr int KT = SEQ + CTXL;
constexpr float RMS_EPS = 1e-6f;
constexpr int NCHUNK = KT / 64;

constexpr size_t MiB = 1u << 20;
constexpr size_t WS_CTL = 0;
constexpr size_t WS_MOD = 1 * MiB;
constexpr size_t WS_META = 2 * MiB;
constexpr size_t WS_GLAD = 10 * MiB;
constexpr size_t WS_SP = 10 * MiB + 768 * 1024;
constexpr size_t WS_ROWID = 9 * MiB;
constexpr size_t WS_RWS = 8 * MiB;
constexpr size_t WS_LRUW = 11 * MiB;
constexpr size_t WS_WIN = 12 * MiB;
constexpr size_t WS_WOUT = 50 * MiB;
constexpr size_t WS_WGU = 66 * MiB;
constexpr size_t WS_WD = 586 * MiB;
constexpr size_t WS_XC = 846 * MiB;
constexpr size_t WS_H = 862 * MiB;
constexpr size_t WS_Y = 934 * MiB;
constexpr size_t WS_ARENA = 1006 * MiB;
constexpr size_t AR_P = 0;
constexpr size_t AR_QC = 171 * MiB, AR_KC = 189 * MiB, AR_VC = 198 * MiB, AR_QD = 207 * MiB, AR_KD = 225 * MiB, AR_VD = 234 * MiB;
constexpr size_t AR_LA = 243 * MiB, AR_LB = 315 * MiB, AR_LH = 387 * MiB;
constexpr size_t AR_GS = 459 * MiB;
constexpr size_t AR_GOI = 531 * MiB;
constexpr size_t AR_GQE = 567 * MiB;
constexpr size_t AR_XLB = 672 * MiB;
constexpr size_t AR_GSB = AR_LB;
constexpr size_t AR_YO = 600 * MiB;
constexpr int SLOT_MAX = 163840 + RT;
constexpr size_t AR_ACT = 0;
constexpr size_t AR_MO = 178 * MiB;
constexpr size_t WS_END = WS_ARENA + 890 * MiB;
static_assert(AR_YO + 72 * MiB <= 890 * MiB, "arena");

constexpr int CW_TMO = 0;
constexpr int CW_BAR = 4096;
constexpr int CW_QUEUE = 8192;
constexpr size_t MT_BLKCNT = 0;
constexpr size_t MT_TOKE = 64 * 1024;
constexpr size_t MT_TOKR = MT_TOKE + 589824;
constexpr size_t MT_TOKG = MT_TOKR + 589824;
constexpr size_t MT_TOKS = MT_TOKG + 589824;
constexpr size_t MT_ROWOFF = MT_TOKS + 589824;
constexpr size_t MT_ROWW = MT_ROWOFF + 729088;
static_assert(MT_ROWW + 729088 <= 8 * MiB, "meta");

constexpr int RING_BYTES = 131072;
constexpr int TBL_OFF = RING_BYTES;
constexpr int MISC_OFF = RING_BYTES + 4096;
constexpr int LDS_BYTES = 147456;

#define MFMA16(a, b, c) __builtin_amdgcn_mfma_f32_16x16x32_bf16((a), (b), (c), 0, 0, 0)
typedef __bf16 bf16x2v __attribute__((ext_vector_type(2)));
DI unsigned cvt_pk_bf16(float lo, float hi) { f32x2 v = {lo, hi}; bf16x2v b = __builtin_convertvector(v, bf16x2v); return __builtin_bit_cast(unsigned, b); }
DI unsigned f2bf(float f) { return cvt_pk_bf16(f, 0.0f) & 0xffffu; }
DI unsigned pk2(float lo, float hi) { return cvt_pk_bf16(lo, hi); }
DI float bf2f(unsigned short b) { return __builtin_bit_cast(float, ((unsigned)b) << 16); }
DI float bflo(unsigned w) { return __builtin_bit_cast(float, w << 16); }
DI float bfhi(unsigned w) { return __builtin_bit_cast(float, w & 0xffff0000u); }
DI float rdlane(float x, int l) { return __builtin_bit_cast(float, __builtin_amdgcn_readlane(__builtin_bit_cast(int, x), l)); }
#define DPP_ADD(v_, ctrl_) (v_) += __builtin_bit_cast(float, __builtin_amdgcn_update_dpp(0, __builtin_bit_cast(int, (v_)), (ctrl_), 0xf, 0xf, true))
DI float wave_sum(float v) {
    DPP_ADD(v, 0xB1);
    DPP_ADD(v, 0x4E);
    DPP_ADD(v, 0x141);
    DPP_ADD(v, 0x140);
    return (rdlane(v, 0) + rdlane(v, 16)) + (rdlane(v, 32) + rdlane(v, 48));
}
DI float sigmoidf_(float x) { return 1.0f / (1.0f + __expf(-x)); }
DI float siluf_(float x) { return x / (1.0f + __expf(-x)); }
DI float siluf_fast(float x) { return x * __builtin_amdgcn_rcpf(1.0f + __expf(-x)); }
#define LDS_WAIT() asm volatile("s_waitcnt lgkmcnt(0)" ::: "memory")
#define VM_WAIT() asm volatile("s_waitcnt vmcnt(0)" ::: "memory")

#define XB_TMO      128
#define XB_XCNT(j)  (256  + 64 * (j))
#define XB_XSUB(j)  (1280 + 64 * (j))
#define XB_XGEN(j)  (2304 + 64 * (j))
#define XB_TOP      3328
#define XB_TOPGEN   3392
#define XCD_BAR_WORDS 3456
#define XB_SPIN_CAP (1u << 18)
__device__ __forceinline__ unsigned xb_ld(unsigned* p)              { return __hip_atomic_load(p, __ATOMIC_RELAXED, __HIP_MEMORY_SCOPE_AGENT); }
__device__ __forceinline__ unsigned xb_add(unsigned* p, unsigned v) { return __hip_atomic_fetch_add(p, v, __ATOMIC_RELAXED, __HIP_MEMORY_SCOPE_AGENT); }
__device__ __forceinline__ unsigned xb_xcc_id() { return (unsigned)__builtin_amdgcn_s_getreg((3 << 11) | 20) & 0xFu; }
#define XB_SPIN(cond, bar) do { unsigned _sp = 0; while (cond) { __builtin_amdgcn_s_sleep(1); \
    if ((++_sp & 255u) == 0u) { if (xb_ld(&(bar)[XB_TMO])) break; if (_sp > XB_SPIN_CAP) { atomicAdd(&(bar)[XB_TMO], 1u); break; } } } } while (0)
struct XcdBarrier { unsigned* bar; unsigned x; volatile LAS unsigned* st; };
__device__ __forceinline__ XcdBarrier xcd_barrier_post(unsigned* bar, volatile LAS unsigned* st) {
    XcdBarrier b; b.bar = bar; b.x = xb_xcc_id(); b.st = st;
    if (threadIdx.x == 0) (void)xb_add(&bar[XB_XCNT(b.x)], 1u);
    return b;
}
__device__ __forceinline__ void xcd_barrier_complete(unsigned* bar, unsigned x, unsigned& nloc, unsigned& nx) {
    const unsigned G = gridDim.x * gridDim.y * gridDim.z;
    unsigned sum, cnt, mine, sp = 0u;
    for (;;) {
        sum = 0u; cnt = 0u; mine = 0u;
#pragma unroll
        for (unsigned j = 0; j < 16; ++j) { const unsigned c = xb_ld(&bar[XB_XCNT(j)]); sum += c; cnt += (c > 0u) ? 1u : 0u; mine = (j == x) ? c : mine; }
        if (sum == G) break;
        __builtin_amdgcn_s_sleep(1);
        if ((++sp & 255u) == 0u) { if (xb_ld(&bar[XB_TMO])) break; if (sp > XB_SPIN_CAP) { atomicAdd(&bar[XB_TMO], 1u); break; } }
    }
    nloc = mine > 0u ? mine : 1u; nx = cnt > 0u ? cnt : 1u;
}
__device__ __forceinline__ void xcd_barrier(const XcdBarrier& b, int tid_) {
    asm volatile("s_waitcnt vmcnt(0)" ::: "memory");
    __syncthreads();
    if (tid_ == 0) {
        unsigned* bar = b.bar;
        __builtin_amdgcn_s_waitcnt(0);
        unsigned nloc = b.st[0], nx = b.st[1];
        if (nloc == 0u) { xcd_barrier_complete(bar, b.x, nloc, nx); b.st[0] = nloc; b.st[1] = nx; }
        const unsigned old = xb_add(&bar[XB_XSUB(b.x)], 1u);
        const unsigned gen = old / nloc;
        if (old + 1u == (gen + 1u) * nloc) {
            __builtin_amdgcn_fence(__ATOMIC_RELEASE, "agent");
            asm volatile("s_waitcnt vmcnt(0)" ::: "memory");
            const unsigned og = xb_add(&bar[XB_TOP], 1u);
            const unsigned tg = og / nx;
            if (og + 1u == (tg + 1u) * nx) xb_add(&bar[XB_TOPGEN], 1u);
            else XB_SPIN(xb_ld(&bar[XB_TOPGEN]) == tg, bar);
            __builtin_amdgcn_fence(__ATOMIC_ACQUIRE, "agent");
            xb_add(&bar[XB_XGEN(b.x)], 1u);
            asm volatile("s_waitcnt vmcnt(0)" ::: "memory");
        } else {
            XB_SPIN(xb_ld(&bar[XB_XGEN(b.x)]) == gen, bar);
            __builtin_amdgcn_fence(__ATOMIC_ACQUIRE, "agent");
            asm volatile("s_waitcnt vmcnt(0)" ::: "memory");
        }
    }
    __syncthreads();
}

namespace pg8 {
typedef int v8i __attribute__((ext_vector_type(8)));
typedef int v4i __attribute__((ext_vector_type(4)));
DI v8i cat8(bf16x8 lo, bf16x8 hi) { const v4i a = __builtin_bit_cast(v4i, lo), b = __builtin_bit_cast(v4i, hi); return __builtin_shufflevector(a, b, 0, 1, 2, 3, 4, 5, 6, 7); }
constexpr int BM = 256, BK = 64, HALF = 128, HTB = HALF * BK * 2, STAGE_BYTES = 8 * HTB, NXCD = 8, WGM = 8;
DI int lds_byte(int r, int c) { const int st = (r >> 4) * 2 + (c >> 5), rr = r & 15, cc = c & 31, ob = rr * 64 + cc * 2; return st * 1024 + (ob ^ (((ob >> 9) & 1) << 5)); }
DI void stage_rc(int b, int& R, int& C) { const int st = b / 1024, sb = b % 1024, swz = sb ^ (((sb >> 9) & 1) << 5); R = (st >> 1) * 16 + swz / 64; C = (st & 1) * 32 + (swz % 64) / 2; }
DI int perm32(int rho) { const int n = rho >> 4, i = rho & 15; return 8 * (i >> 2) + 4 * n + (i & 3); }

struct Unit { int pm, pn, pb, e; };

struct TileOrder {
    int nM, nN, nwg, G, c;
    DI void init(int nM_, int nN_, int G_, int c_) { nM = nM_; nN = nN_; nwg = nM * nN; G = G_; c = c_; }
    DI bool tile(int i, int& pm, int& pn) const {
        const long L = (long)i * G + c; if (L >= nwg) return false;
        int wgid = (int)L; { const int q = nwg / NXCD, r = nwg % NXCD, xcd = wgid % NXCD, off = wgid / NXCD; wgid = (xcd < r ? xcd * (q + 1) : r * (q + 1) + (xcd - r) * q) + off; }
        const int nig = WGM * nN, gid = wgid / nig, fm = gid * WGM, gsz = (nM - fm) < WGM ? (nM - fm) : WGM;
        pm = fm + ((wgid % nig) % gsz); pn = (wgid % nig) / gsz; return true;
    }
};
struct DenseSched {
    TileOrder T;
    DI bool next(int i, Unit& u) const { if (!T.tile(i, u.pm, u.pn)) return false; u.pb = u.pn; u.e = 0; return true; }
};
struct MoeSched {
    TileOrder T; const LAS unsigned short* tile_e;
    DI bool next(int i, Unit& u) const { if (!T.tile(i, u.pm, u.pn)) return false; u.e = (int)__builtin_amdgcn_readfirstlane((int)tile_e[u.pm]); u.pb = u.e * T.nN + u.pn; return true; }
};

struct EpiBf16 {
    static constexpr bool PERM = true;
    bf16_t* O; int ldc; float scale;
    DI void operator()(const f32x4 (&acc)[2][2][4][2], const Unit& u, int wr, int wc, int fr, int fq) const {
        const int row0 = u.pm * BM + wr * 64 + fr; const int col0 = u.pn * BM + wc * 32 + 8 * fq;
#pragma unroll
        for (int ai = 0; ai < 2; ++ai)
#pragma unroll
            for (int m = 0; m < 4; ++m) { const int row = row0 + ai * HALF + m * 16; bf16_t* rowp = O + (size_t)row * ldc + col0; const float rs = scale;
#pragma unroll
                for (int bj = 0; bj < 2; ++bj) { const f32x4 v0 = acc[ai][bj][m][0] * rs, v1 = acc[ai][bj][m][1] * rs;
                    u32x4 w; w.x = cvt_pk_bf16(v0[0], v0[1]); w.y = cvt_pk_bf16(v0[2], v0[3]); w.z = cvt_pk_bf16(v1[0], v1[1]); w.w = cvt_pk_bf16(v1[2], v1[3]);
                    asm volatile("global_store_dwordx4 %0, %1, off sc1\n\ts_nop 1" :: "v"(rowp + bj * HALF), "v"(w) : "memory"); } }
    }
};
DI unsigned pk4_fp8(float a, float b, float c, float d) {
    a = fminf(fmaxf(a, -448.f), 448.f); b = fminf(fmaxf(b, -448.f), 448.f); c = fminf(fmaxf(c, -448.f), 448.f); d = fminf(fmaxf(d, -448.f), 448.f);
    int w = 0; w = __builtin_amdgcn_cvt_pk_fp8_f32(a, b, w, false); w = __builtin_amdgcn_cvt_pk_fp8_f32(c, d, w, true); return (unsigned)w; }
struct EpiFp8 {
    static constexpr bool PERM = true;
    unsigned char* O; int ldc; float scale;
    DI void operator()(const f32x4 (&acc)[2][2][4][2], const Unit& u, int wr, int wc, int fr, int fq) const {
        const int odd = fq & 1; const int row0 = u.pm * BM + wr * 64 + fr + 16 * odd; const int col0 = u.pn * BM + wc * 32 + 8 * (fq - odd);
#pragma unroll
        for (int ai = 0; ai < 2; ++ai)
#pragma unroll
            for (int bj = 0; bj < 2; ++bj)
#pragma unroll
                for (int mp = 0; mp < 4; mp += 2) {
                    const f32x4 a0 = acc[ai][bj][mp][0] * scale, a1 = acc[ai][bj][mp][1] * scale, b0 = acc[ai][bj][mp + 1][0] * scale, b1 = acc[ai][bj][mp + 1][1] * scale;
                    const unsigned ax = pk4_fp8(a0[0], a0[1], a0[2], a0[3]), ay = pk4_fp8(a1[0], a1[1], a1[2], a1[3]), bx = pk4_fp8(b0[0], b0[1], b0[2], b0[3]), by = pk4_fp8(b1[0], b1[1], b1[2], b1[3]);
                    const auto rx = __builtin_amdgcn_permlane16_swap(ax, bx, false, false); const auto ry = __builtin_amdgcn_permlane16_swap(ay, by, false, false);
                    *(u32x4*)(O + (size_t)(row0 + ai * HALF + mp * 16) * ldc + col0 + bj * HALF) = (u32x4){rx[0], ry[0], rx[1], ry[1]}; }
    }
};
template <bool F8OUT> struct EpiSwiGlu {
    static constexpr bool PERM = false;
    void* ACT; float iscale, oscale;
    DI void operator()(const f32x4 (&acc)[2][2][4][2], const Unit& u, int wr, int wc, int fr, int fq) const {
        const int row0 = u.pm * BM + wr * 64 + fr;
        if constexpr (F8OUT) {
#pragma unroll
            for (int ai = 0; ai < 2; ++ai)
#pragma unroll
                for (int bj = 0; bj < 2; ++bj) { unsigned d[4];
#pragma unroll
                    for (int m = 0; m < 4; ++m) { const f32x4 g = acc[ai][bj][m][0] * iscale, up = acc[ai][bj][m][1] * iscale;
                        d[m] = pk4_fp8(siluf_fast(g[0]) * up[0] * oscale, siluf_fast(g[1]) * up[1] * oscale, siluf_fast(g[2]) * up[2] * oscale, siluf_fast(g[3]) * up[3] * oscale); }
                    const auto s1 = __builtin_amdgcn_permlane16_swap(d[0], d[1], false, false); const auto s2 = __builtin_amdgcn_permlane16_swap(d[2], d[3], false, false);
                    const auto t0 = __builtin_amdgcn_permlane32_swap(s1[0], s2[0], false, false); const auto t1 = __builtin_amdgcn_permlane32_swap(s1[1], s2[1], false, false);
                    *(u32x4*)((unsigned char*)ACT + (size_t)(row0 + ai * HALF + fq * 16) * EH + 16 * (8 * u.pn + 4 * bj + wc)) = (u32x4){t0[0], t1[0], t0[1], t1[1]}; }
            return;
        }
#pragma unroll
        for (int ai = 0; ai < 2; ++ai)
#pragma unroll
            for (int m = 0; m < 4; ++m) { const size_t rowi = (size_t)(row0 + ai * HALF + m * 16) * EH;
#pragma unroll
                for (int bj = 0; bj < 2; ++bj) { const int hid = 16 * (8 * u.pn + 4 * bj + wc) + 4 * fq; const f32x4 g = acc[ai][bj][m][0] * iscale, up = acc[ai][bj][m][1] * iscale;
                    float a0 = siluf_fast(g[0]) * up[0], a1 = siluf_fast(g[1]) * up[1], a2 = siluf_fast(g[2]) * up[2], a3 = siluf_fast(g[3]) * up[3];
                    if constexpr (F8OUT) { *(unsigned*)((unsigned char*)ACT + rowi + hid) = pk4_fp8(a0 * oscale, a1 * oscale, a2 * oscale, a3 * oscale); }
                    else { u32x2 w; w.x = cvt_pk_bf16(a0, a1); w.y = cvt_pk_bf16(a2, a3); *(u32x2*)((bf16_t*)ACT + rowi + hid) = w; } } }
    }
};

template <int K, int EB, int GMODE, bool SP2, class Epi, class Sched>
DI void gemm_phase(int tid_in, LAS unsigned char* lds, const bf16_t* A, const bf16_t* Bt, const LAS unsigned short* lrows, const Sched& S, const Epi& E) {
    constexpr bool GATHER = GMODE != 0;
    int tid = tid_in; asm volatile("" : "+v"(tid));
    const int wid = __builtin_amdgcn_readfirstlane(tid >> 6), lane = tid & 63, wr = wid >> 2, wc = wid & 3, fr = lane & 15, fq = lane >> 4;
    constexpr int KB = K * EB;
    constexpr int nt = KB / 128;
    unsigned voffA[2], voffB[2];
#pragma unroll
    for (int i = 0; i < 2; ++i) { int R, C; stage_rc(tid * 16 + i * 8192, R, C); const int Rb = Epi::PERM ? ((R & ~31) + perm32(R & 31)) : R;
        voffA[i] = (unsigned)(R * KB + C * 2); voffB[i] = (unsigned)(Rb * KB + C * 2); }
    constexpr size_t kstep = (size_t)(BK * 2);
    constexpr size_t hstep = (size_t)HALF * KB;
    constexpr size_t tstep = 2 * hstep;
    const unsigned ldsw = (unsigned)wid * 1024u;
    const int aoff = lds_byte(wr * 64 + fr, fq * 8), boff = lds_byte(wc * 32 + fr, fq * 8);
#define PG8_SA(b, h) (((b) * 2 + (h)) * HTB)
#define PG8_SB(b, h) ((4 + (b) * 2 + (h)) * HTB)
#define PG8_STAGE(bufoff, gbase, voff) do { _Pragma("unroll") for (int _i = 0; _i < 2; ++_i) \
        __builtin_amdgcn_global_load_lds((const unsigned*)((const char*)(gbase) + (voff)[_i]), (LAS unsigned*)(lds + (bufoff) + ldsw + _i * 8192), 16, 0, 0); } while (0)
#define PG8_STAGE_A(bufoff, ab, ao, h, koff) do { if constexpr (GATHER) { PG8_STAGE(bufoff, (const char*)A + (koff), (ao)[h]); } else { PG8_STAGE(bufoff, (ab) + (h) * hstep + (koff), voffA); } } while (0)
#define PG8_LDA(dst, b, h) do { _Pragma("unroll") for (int m = 0; m < 4; ++m) { if constexpr (EB == 2) { _Pragma("unroll") for (int k = 0; k < 2; ++k) dst[m][k] = *(const LAS bf16x8*)(lds + PG8_SA(b, h) + aoff + m * 2048 + k * 1024); } \
        else { dst##8[m] = cat8(*(const LAS bf16x8*)(lds + PG8_SA(b, h) + aoff + m * 2048), *(const LAS bf16x8*)(lds + PG8_SA(b, h) + aoff + m * 2048 + 1024)); } } } while (0)
#define PG8_LDB(dst, b, h) do { _Pragma("unroll") for (int n = 0; n < 2; ++n) { if constexpr (EB == 2) { _Pragma("unroll") for (int k = 0; k < 2; ++k) dst[n][k] = *(const LAS bf16x8*)(lds + PG8_SB(b, h) + boff + n * 2048 + k * 1024); } \
        else { dst##8[n] = cat8(*(const LAS bf16x8*)(lds + PG8_SB(b, h) + boff + n * 2048), *(const LAS bf16x8*)(lds + PG8_SB(b, h) + boff + n * 2048 + 1024)); } } } while (0)
#define PG8_MMA(ai, bj, At, Bt_) do { __builtin_amdgcn_s_setprio(1); _Pragma("unroll") for (int m = 0; m < 4; ++m) _Pragma("unroll") for (int n = 0; n < 2; ++n) { \
        if constexpr (EB == 2) { _Pragma("unroll") for (int k = 0; k < 2; ++k) acc[ai][bj][m][n] = __builtin_amdgcn_mfma_f32_16x16x32_bf16(Bt_[n][k], At[m][k], acc[ai][bj][m][n], 0, 0, 0); } \
        else { acc[ai][bj][m][n] = __builtin_amdgcn_mfma_scale_f32_16x16x128_f8f6f4(Bt_##8[n], At##8[m], acc[ai][bj][m][n], 0, 0, 0, 0, 0, 0); } } \
        __builtin_amdgcn_s_setprio(0); } while (0)
#define PG8_WAIT_V(n) asm volatile("s_waitcnt vmcnt(" #n ")" ::: "memory")
#define PG8_WAIT_L(n) asm volatile("s_waitcnt lgkmcnt(" #n ")" ::: "memory")
#define PG8_BAR __builtin_amdgcn_s_barrier()
#define PG8_SCHED __builtin_amdgcn_sched_barrier(0)
    Unit cur, nxt; int ui = 0;
    if (!S.next(0, cur)) return;
    f32x4 acc[2][2][4][2];
#pragma unroll
    for (int a = 0; a < 2; ++a)
#pragma unroll
        for (int b = 0; b < 2; ++b)
#pragma unroll
            for (int m = 0; m < 4; ++m)
#pragma unroll
                for (int n = 0; n < 2; ++n) acc[a][b][m][n] = (f32x4){0.f, 0.f, 0.f, 0.f};
    bf16x8 At[4][2], B0[2][2], B1[2][2];
    v8i At8[4], B08[2], B18[2];
    unsigned gA[2][2], gN[2][2];
    if constexpr (GATHER) {
#pragma unroll
        for (int i = 0; i < 2; ++i) { int R, C; stage_rc(tid * 16 + i * 8192, R, C);
#pragma unroll
            for (int h = 0; h < 2; ++h) gA[h][i] = (GMODE == 1 ? (unsigned)lrows[h * HALF + R] : (unsigned)(cur.pm * BM + h * HALF + R)) * (unsigned)KB + (unsigned)C * 2u; }
        asm volatile("" : "+v"(gA[0][0]), "+v"(gA[0][1]), "+v"(gA[1][0]), "+v"(gA[1][1]));
    } else {
#pragma unroll
        for (int h = 0; h < 2; ++h)
#pragma unroll
            for (int i = 0; i < 2; ++i) { gA[h][i] = 0u; gN[h][i] = 0u; }
    }
    const char* cA = (const char*)A + (size_t)cur.pm * tstep; const char* cB = (const char*)Bt + (size_t)cur.pb * tstep;
    if constexpr (SP2) {
        PG8_STAGE(PG8_SB(0, 0), cB, voffB); PG8_STAGE(PG8_SB(0, 1), cB + hstep, voffB); PG8_STAGE_A(PG8_SA(0, 0), cA, gA, 0, 0); PG8_STAGE_A(PG8_SA(0, 1), cA, gA, 1, 0);
        if (wr == 1) PG8_BAR;
        PG8_WAIT_V(2); PG8_BAR;
        PG8_STAGE(PG8_SB(1, 0), cB + kstep, voffB); PG8_STAGE_A(PG8_SA(1, 0), cA, gA, 0, kstep); PG8_STAGE(PG8_SB(1, 1), cB + hstep + kstep, voffB);
        PG8_WAIT_V(6); PG8_BAR;
    } else {
    PG8_STAGE(PG8_SB(0, 0), cB, voffB); PG8_STAGE_A(PG8_SA(0, 0), cA, gA, 0, 0); PG8_STAGE(PG8_SB(0, 1), cB + hstep, voffB); PG8_STAGE_A(PG8_SA(0, 1), cA, gA, 1, 0);
    if (wr == 1) PG8_BAR;
    PG8_WAIT_V(4); PG8_BAR;
    PG8_STAGE(PG8_SB(1, 0), cB + kstep, voffB); PG8_STAGE_A(PG8_SA(1, 0), cA, gA, 0, kstep); PG8_STAGE(PG8_SB(1, 1), cB + hstep + kstep, voffB);
    PG8_WAIT_V(6); PG8_BAR;
    }
    for (;;) {
        const bool has_next = S.next(ui + 1, nxt);
        const char* nA = has_next ? (const char*)A + (size_t)nxt.pm * tstep : cA; const char* nB = has_next ? (const char*)Bt + (size_t)nxt.pb * tstep : cB;
        if constexpr (GATHER) {
            const int npm = has_next ? nxt.pm : cur.pm; int tz = tid; asm volatile("" : "+v"(tz));
#pragma unroll
            for (int i = 0; i < 2; ++i) { int R, C; stage_rc(tz * 16 + i * 8192, R, C);
#pragma unroll
                for (int h = 0; h < 2; ++h) gN[h][i] = (GMODE == 1 ? (unsigned)lrows[(has_next ? ui + 1 : ui) * BM + h * HALF + R] : (unsigned)(npm * BM + h * HALF + R)) * (unsigned)KB + (unsigned)C * 2u; }
            asm volatile("" : "+v"(gN[0][0]), "+v"(gN[0][1]), "+v"(gN[1][0]), "+v"(gN[1][1]));
        }
        int ntv = nt; asm volatile("" : "+s"(ntv));
        for (int t = 0; t < ntv; t += 2) {
            const bool last = (t == ntv - 2);
            const size_t k1 = (size_t)(t + 1) * kstep;
            const char* a2 = last ? nA : cA; const char* b2 = last ? nB : cB + (size_t)(t + 2) * kstep;
            const size_t ka2 = last ? 0 : (size_t)(t + 2) * kstep;
            const char* b3 = b2 + kstep; const size_t ka3 = ka2 + kstep;
            if constexpr (SP2) {
            PG8_LDB(B0, 0, 0); PG8_LDB(B1, 0, 1); PG8_SCHED; PG8_LDA(At, 0, 0); PG8_STAGE_A(PG8_SA(1, 1), cA, gA, 1, k1);
            if constexpr (GATHER) { if (last) { gA[0][0] = gN[0][0]; gA[0][1] = gN[0][1]; gA[1][0] = gN[1][0]; gA[1][1] = gN[1][1]; } }
            PG8_WAIT_V(8); PG8_WAIT_L(0); PG8_BAR; PG8_MMA(0, 0, At, B0); PG8_MMA(0, 1, At, B1); PG8_BAR; PG8_SCHED;
            PG8_LDA(At, 0, 1); PG8_STAGE(PG8_SB(0, 0), b2, voffB); PG8_STAGE(PG8_SB(0, 1), b2 + hstep, voffB); PG8_STAGE_A(PG8_SA(0, 0), a2, gA, 0, ka2);
            PG8_WAIT_V(8); PG8_WAIT_L(0); PG8_BAR; PG8_MMA(1, 0, At, B0); PG8_MMA(1, 1, At, B1); PG8_BAR; PG8_SCHED;
            PG8_LDB(B0, 1, 0); PG8_LDB(B1, 1, 1); PG8_SCHED; PG8_LDA(At, 1, 0); PG8_STAGE_A(PG8_SA(0, 1), a2, gA, 1, ka2);
            PG8_WAIT_V(8); PG8_WAIT_L(0); PG8_BAR; PG8_MMA(0, 0, At, B0); PG8_MMA(0, 1, At, B1); PG8_BAR; PG8_SCHED;
            PG8_LDA(At, 1, 1); PG8_STAGE(PG8_SB(1, 0), b3, voffB); PG8_STAGE(PG8_SB(1, 1), b3 + hstep, voffB); PG8_STAGE_A(PG8_SA(1, 0), a2, gA, 0, ka3);
            PG8_WAIT_V(8); PG8_WAIT_L(0); PG8_BAR; PG8_MMA(1, 0, At, B0); PG8_MMA(1, 1, At, B1); PG8_BAR; PG8_SCHED;
            } else {
            PG8_LDB(B0, 0, 0); PG8_SCHED; PG8_LDA(At, 0, 0); PG8_STAGE_A(PG8_SA(1, 1), cA, gA, 1, k1);
            if constexpr (GATHER) { if (last) { gA[0][0] = gN[0][0]; gA[0][1] = gN[0][1]; gA[1][0] = gN[1][0]; gA[1][1] = gN[1][1]; } }
            PG8_WAIT_L(8); PG8_BAR; PG8_WAIT_L(0); PG8_MMA(0, 0, At, B0); PG8_BAR; PG8_SCHED;
            PG8_LDB(B1, 0, 1); PG8_STAGE(PG8_SB(0, 0), b2, voffB);
            PG8_BAR; PG8_WAIT_L(0); PG8_MMA(0, 1, At, B1); PG8_BAR;
            PG8_LDA(At, 0, 1); PG8_STAGE_A(PG8_SA(0, 0), a2, gA, 0, ka2);
            PG8_BAR; PG8_WAIT_L(0); PG8_MMA(1, 0, At, B0); PG8_BAR; PG8_SCHED;
            PG8_STAGE(PG8_SB(0, 1), b2 + hstep, voffB);
            PG8_WAIT_V(6); PG8_BAR; PG8_MMA(1, 1, At, B1); PG8_BAR;
            PG8_LDB(B0, 1, 0); PG8_SCHED; PG8_LDA(At, 1, 0); PG8_STAGE_A(PG8_SA(0, 1), a2, gA, 1, ka2);
            PG8_WAIT_L(8); PG8_BAR; PG8_WAIT_L(0); PG8_MMA(0, 0, At, B0); PG8_BAR; PG8_SCHED;
            PG8_LDB(B1, 1, 1); PG8_STAGE(PG8_SB(1, 0), b3, voffB);
            PG8_BAR; PG8_WAIT_L(0); PG8_MMA(0, 1, At, B1); PG8_BAR;
            PG8_LDA(At, 1, 1); PG8_STAGE_A(PG8_SA(1, 0), a2, gA, 0, ka3);
            PG8_BAR; PG8_WAIT_L(0); PG8_MMA(1, 0, At, B0); PG8_BAR; PG8_SCHED;
            PG8_STAGE(PG8_SB(1, 1), b3 + hstep, voffB);
            PG8_WAIT_V(6); PG8_BAR; PG8_MMA(1, 1, At, B1); PG8_BAR;
            }
        }
        E(acc, cur, wr, wc, fr, fq);
        if (!has_next) break;
#pragma unroll
        for (int a = 0; a < 2; ++a)
#pragma unroll
            for (int b = 0; b < 2; ++b)
#pragma unroll
                for (int m = 0; m < 4; ++m)
#pragma unroll
                    for (int n = 0; n < 2; ++n) acc[a][b][m][n] = (f32x4){0.f, 0.f, 0.f, 0.f};
        cur = nxt; cA = nA; cB = nB; ++ui;
    }
    PG8_WAIT_V(0);
    if (wr == 0) PG8_BAR;
    PG8_BAR;
#undef PG8_SA
#undef PG8_SB
#undef PG8_STAGE
#undef PG8_STAGE_A
#undef PG8_LDA
#undef PG8_LDB
#undef PG8_MMA
#undef PG8_WAIT_V
#undef PG8_WAIT_L
#undef PG8_BAR
#undef PG8_SCHED
}
}

namespace att {
constexpr int D = 128, NW = 8, QBLK = 32, KVBLK = 64;
constexpr float SCALE = 0.088388347648318440f;
constexpr float THR = 8.f;
constexpr int LDQ = D, LDK = D, LDO = DM;
constexpr size_t SHM_V = KVBLK * D * 2, SHM_K = KVBLK * D * 2, SHM_ATTN = 2 * SHM_V + 2 * SHM_K + NW * 64 * 4;
#define KSWZ(row, colB) ((row) * 256 + ((colB) ^ (((row) & 7) << 4)))
#define SBAR() __builtin_amdgcn_sched_barrier(0)
DI int crow(int r, int hi) { return (r & 3) + 8 * (r >> 2) + 4 * hi; }
DI unsigned cvtpk(float lo, float hi) { return cvt_pk_bf16(lo, hi); }

DI void wmask(f32x16& p0, f32x16& p1, int qp, int kb, int hi) {
#pragma unroll
    for (int r = 0; r < 16; ++r) { const int k0 = kb + crow(r, hi) - qp; const int k1 = k0 + 32;
        p0[r] = (k0 >= -128 && k0 <= 128) ? p0[r] : -1e30f; p1[r] = (k1 >= -128 && k1 <= 128) ? p1[r] : -1e30f; }
}
DI void partialSM(f32x16& p0, f32x16& p1, float& m_reg, float& mn, float& alpha) {
    constexpr float C = SCALE * 1.4426950408889634f;
    float pmax = p0[0];
#pragma unroll
    for (int r = 1; r < 16; ++r) pmax = fmaxf(pmax, p0[r]);
#pragma unroll
    for (int r = 0; r < 16; ++r) pmax = fmaxf(pmax, p1[r]);
    { auto rr = __builtin_amdgcn_permlane32_swap(__float_as_uint(pmax), __float_as_uint(pmax), false, false);
      pmax = fmaxf(__uint_as_float(rr[0]), __uint_as_float(rr[1])); }
    if (__builtin_expect(__all(pmax - m_reg <= THR / SCALE), 1)) { mn = m_reg; alpha = 1.f; }
    else { mn = fmaxf(m_reg, pmax); alpha = __builtin_amdgcn_exp2f((m_reg - mn) * C); m_reg = mn; }
    float mnC = -mn * C;
#pragma unroll
    for (int r = 0; r < 16; ++r) p0[r] = fmaf(p0[r], C, mnC);
#pragma unroll
    for (int r = 0; r < 16; ++r) p1[r] = fmaf(p1[r], C, mnC);
#pragma unroll
    for (int r = 0; r < 16; ++r) p0[r] = __builtin_amdgcn_exp2f(p0[r]);
}
DI void finishSM(f32x16& p0, f32x16& p1, float alpha, float& l_reg, bf16x8& pa0, bf16x8& pa1, bf16x8& pa2, bf16x8& pa3) {
#pragma unroll
    for (int r = 0; r < 16; ++r) p1[r] = __builtin_amdgcn_exp2f(p1[r]);
    float ps = 0;
#pragma unroll
    for (int r = 0; r < 16; ++r) ps += p0[r];
#pragma unroll
    for (int r = 0; r < 16; ++r) ps += p1[r];
    { auto rr = __builtin_amdgcn_permlane32_swap(__float_as_uint(ps), __float_as_uint(ps), false, false);
      ps = __uint_as_float(rr[0]) + __uint_as_float(rr[1]); }
    l_reg = l_reg * alpha + ps;
#define PK4(P, BASE, OUT) do { unsigned a0 = cvtpk(P[BASE + 0], P[BASE + 1]), a1 = cvtpk(P[BASE + 2], P[BASE + 3]);   \
    unsigned b0 = cvtpk(P[BASE + 4], P[BASE + 5]), b1 = cvtpk(P[BASE + 6], P[BASE + 7]);                              \
    auto r0 = __builtin_amdgcn_permlane32_swap(a0, b0, false, false); auto r1 = __builtin_amdgcn_permlane32_swap(a1, b1, false, false); \
    u32x4 w = {r0[0], r1[0], r0[1], r1[1]}; OUT = *reinterpret_cast<bf16x8*>(&w); } while (0)
    PK4(p0, 0, pa0); PK4(p0, 8, pa1); PK4(p1, 0, pa2); PK4(p1, 8, pa3);
#undef PK4
}
DI void qkt(f32x16& p0, f32x16& p1, const char* Ks, const bf16x8* qr, int r32, int hi) {
    p0 = f32x16{}; p1 = f32x16{};
#pragma unroll
    for (int d0 = 0; d0 < 8; ++d0) { int cb = (d0 * 16 + hi * 8) * 2;
        bf16x8 b0 = *reinterpret_cast<const bf16x8*>(Ks + KSWZ(r32, cb));
        bf16x8 b1 = *reinterpret_cast<const bf16x8*>(Ks + KSWZ(32 + r32, cb));
        p0 = __builtin_amdgcn_mfma_f32_32x32x16_bf16(b0, qr[d0], p0, 0, 0, 0);
        p1 = __builtin_amdgcn_mfma_f32_32x32x16_bf16(b1, qr[d0], p1, 0, 0, 0); }
}
DI int v_st(int k, int c) { const int kk = (k & ~0xC) | ((k & 4) << 1) | ((k & 8) >> 1); return ((kk >> 3) * 4 + (c >> 5)) * 512 + ((kk & 7) * 32 + (c & 31)) * 2; }
DI int v_rd_base(int lane) { return ((lane & 3) << 3) | (((lane >> 2) & 3) << 6) | (((lane >> 4) & 1) << 5) | (((lane >> 5) & 1) << 8); }
constexpr int v_rd_off(int d0, int ks, int half) { return d0 * 512 + ks * 4096 + half * 2048; }
template <int OFF> DI s16x4 tr_read(int vb) { s16x4 r; asm volatile("ds_read_b64_tr_b16 %0, %1 offset:%2" : "=&v"(r) : "v"(vb), "i"(OFF) : "memory"); return r; }
template <int D0> DI void pv_one(f32x16& od, int vb, bf16x8 pa0, bf16x8 pa1, bf16x8 pa2, bf16x8 pa3) {
    const s16x4 l0 = tr_read<v_rd_off(D0, 0, 0)>(vb), h0 = tr_read<v_rd_off(D0, 0, 1)>(vb), l1 = tr_read<v_rd_off(D0, 1, 0)>(vb), h1 = tr_read<v_rd_off(D0, 1, 1)>(vb);
    const s16x4 l2 = tr_read<v_rd_off(D0, 2, 0)>(vb), h2 = tr_read<v_rd_off(D0, 2, 1)>(vb), l3 = tr_read<v_rd_off(D0, 3, 0)>(vb), h3 = tr_read<v_rd_off(D0, 3, 1)>(vb);
    asm volatile("s_waitcnt lgkmcnt(0)" ::: "memory"); SBAR();
#define PK(L, H) (bf16x8){L[0], L[1], L[2], L[3], H[0], H[1], H[2], H[3]}
    od = __builtin_amdgcn_mfma_f32_32x32x16_bf16(pa0, PK(l0, h0), od, 0, 0, 0);
    od = __builtin_amdgcn_mfma_f32_32x32x16_bf16(pa1, PK(l1, h1), od, 0, 0, 0);
    od = __builtin_amdgcn_mfma_f32_32x32x16_bf16(pa2, PK(l2, h2), od, 0, 0, 0);
    od = __builtin_amdgcn_mfma_f32_32x32x16_bf16(pa3, PK(l3, h3), od, 0, 0, 0);
#undef PK
}
DI void pv_d0(f32x16* o, int vb, bf16x8 pa0, bf16x8 pa1, bf16x8 pa2, bf16x8 pa3) {
    pv_one<0>(o[0], vb, pa0, pa1, pa2, pa3); pv_one<1>(o[1], vb, pa0, pa1, pa2, pa3); pv_one<2>(o[2], vb, pa0, pa1, pa2, pa3); pv_one<3>(o[3], vb, pa0, pa1, pa2, pa3);
}

DI void attn_body(const bf16_t* __restrict__ Qb, const bf16_t* __restrict__ Kh, const bf16_t* __restrict__ Vh, bf16_t* __restrict__ Ob, int NT, int skip, int q0, float sinkv, bool WIN, bool SINK, char* lds, int tid_in) {
    int tid = tid_in; asm volatile("" : "+v"(tid));
    const int wid = tid >> 6, lane = tid & 63, r32 = lane & 31, hi = lane >> 5;
    char* V_lds = lds; char* K_lds = lds + 2 * SHM_V;
    float* ws = (float*)(lds + 2 * SHM_V + 2 * SHM_K) + wid * 64; float* li_l = ws; float* al_l = ws + 32;
    float m_reg = -1e30f, l_reg = 0; f32x16 o[4] = {}; bf16x8 qr[8];
    const bf16_t* Qw = Qb + (long)(wid * QBLK + r32) * LDQ + hi * 8;
#pragma unroll
    for (int d0 = 0; d0 < 8; ++d0) qr[d0] = *reinterpret_cast<const bf16x8*>(Qw + d0 * 16);
    const int sr = tid >> 4, sc = (tid & 15) * 8, vst0 = v_st(sr, sc), vst1 = v_st(32 + sr, sc);
    const int vb0 = (int)(uintptr_t)V_lds + v_rd_base(lane);
    const int qp = q0 + wid * QBLK + r32;
    struct { bf16x8 vs0, vs1, ks0, ks1; } sr_[2];
#define KOFF(j) (64 * (j) + ((j) >= 4 ? skip : 0))
#define SLOAD(i, jt) do { const int k0_ = KOFF(jt); sr_[i].vs0 = *reinterpret_cast<const bf16x8*>(&Vh[(long)(k0_ + sr) * LDK + sc]); sr_[i].vs1 = *reinterpret_cast<const bf16x8*>(&Vh[(long)(k0_ + 32 + sr) * LDK + sc]); \
    sr_[i].ks0 = *reinterpret_cast<const bf16x8*>(&Kh[(long)(k0_ + sr) * LDK + sc]); sr_[i].ks1 = *reinterpret_cast<const bf16x8*>(&Kh[(long)(k0_ + 32 + sr) * LDK + sc]); } while (0)
#define SWRITE(b, i) do { *(bf16x8*)(V_lds + (b) * SHM_V + vst0) = sr_[i].vs0;          \
    *(bf16x8*)(V_lds + (b) * SHM_V + vst1) = sr_[i].vs1; int kc = sc * 2;               \
    *(bf16x8*)(K_lds + (b) * SHM_K + KSWZ(sr, kc)) = sr_[i].ks0;                       \
    *(bf16x8*)(K_lds + (b) * SHM_K + KSWZ(32 + sr, kc)) = sr_[i].ks1; } while (0)
#define SWAIT() asm volatile("s_waitcnt vmcnt(4)" ::: "memory")
#define RESC(a) do { if (__any((a) < 1.f)) { if (hi == 0) al_l[r32] = (a); asm volatile("s_waitcnt lgkmcnt(0)" ::: "memory"); \
    _Pragma("unroll") for (int d = 0; d < 4; ++d) _Pragma("unroll") for (int r = 0; r < 16; ++r) o[d][r] *= al_l[crow(r, hi)]; } } while (0)
#define WMASK(PA, PB, jt) do { if (WIN && (jt) >= 4) wmask(PA, PB, qp, skip + 64 * ((jt) - 4), hi); } while (0)
    f32x16 pA0, pA1, pB0, pB1; float mnA, mnB, alA, alB; bf16x8 pa0, pa1, pa2, pa3;
    constexpr int SE = 0, SO = 1;
    SLOAD(SE, 0); asm volatile("s_waitcnt vmcnt(0)" ::: "memory"); SWRITE(0, SE); __syncthreads();
    qkt(pA0, pA1, K_lds, qr, r32, hi); partialSM(pA0, pA1, m_reg, mnA, alA);
    SLOAD(SO, 1); if (2 < NT) SLOAD(SE, 2);
    SWAIT(); SWRITE(1, SO); __syncthreads();
    for (int j = 1; j + 1 < NT; j += 2) {
        SBAR(); qkt(pB0, pB1, K_lds + SHM_K, qr, r32, hi); WMASK(pB0, pB1, j);
        finishSM(pA0, pA1, alA, l_reg, pa0, pa1, pa2, pa3); SBAR();
        SLOAD(SO, j + 2); SBAR();
        pv_d0(o, vb0, pa0, pa1, pa2, pa3); partialSM(pB0, pB1, m_reg, mnB, alB);
        __syncthreads(); SWAIT(); SWRITE(0, SE);
        RESC(alB); __syncthreads();
        SBAR(); qkt(pA0, pA1, K_lds, qr, r32, hi); WMASK(pA0, pA1, j + 1);
        finishSM(pB0, pB1, alB, l_reg, pa0, pa1, pa2, pa3); SBAR();
        if (j + 3 < NT) SLOAD(SE, j + 3); SBAR();
        pv_d0(o, vb0 + (int)SHM_V, pa0, pa1, pa2, pa3); partialSM(pA0, pA1, m_reg, mnA, alA);
        __syncthreads(); SWAIT(); SWRITE(1, SO);
        RESC(alA); __syncthreads();
    }
    SBAR(); qkt(pB0, pB1, K_lds + SHM_K, qr, r32, hi); WMASK(pB0, pB1, NT - 1);
    finishSM(pA0, pA1, alA, l_reg, pa0, pa1, pa2, pa3); SBAR();
    pv_d0(o, vb0, pa0, pa1, pa2, pa3); partialSM(pB0, pB1, m_reg, mnB, alB);
    __syncthreads(); RESC(alB);
    finishSM(pB0, pB1, alB, l_reg, pa0, pa1, pa2, pa3); SBAR();
    pv_d0(o, vb0 + (int)SHM_V, pa0, pa1, pa2, pa3);
    if (SINK) l_reg += __builtin_amdgcn_exp2f(sinkv * 1.4426950408889634f - m_reg * (SCALE * 1.4426950408889634f));
    if (hi == 0) li_l[r32] = l_reg; asm volatile("s_waitcnt lgkmcnt(0)" ::: "memory");
    float rli[16];
#pragma unroll
    for (int r = 0; r < 16; ++r) rli[r] = __builtin_amdgcn_rcpf(li_l[crow(r, hi)]);
    bf16_t* Ow = Ob + (long)(wid * QBLK) * LDO;
#pragma unroll
    for (int r = 0; r < 16; ++r) { int orow = crow(r, hi);
#pragma unroll
        for (int d0 = 0; d0 < 4; ++d0) Ow[(long)orow * LDO + d0 * 32 + r32] = (bf16_t)f2bf(o[d0][r] * rli[r]); }
    __syncthreads();
#undef KOFF
#undef SLOAD
#undef SWRITE
#undef SWAIT
#undef RESC
#undef WMASK
}
}

constexpr int NWAVES = 8, NTHR = 512;
struct Args { const float* in[29]; float* out; unsigned char* ws; int ph_lo, ph_hi; };
struct Frame {
    LAS unsigned char* lds; unsigned char* ws; unsigned* ctl;
    int tid, lane, wave, bid;
    static constexpr int G = 256;
};
constexpr int PTR_OFF = RING_BYTES + 4096 + 512;
constexpr int LROWS_OFF = PTR_OFF + 256;
static_assert(LROWS_OFF + 12 * 256 * 2 <= LDS_BYTES, "lds");
DI const float* in_ptr(const Frame& F, int i) { const unsigned long long v = ((const LAS unsigned long long*)(F.lds + PTR_OFF))[i];
    const unsigned lo = __builtin_amdgcn_readfirstlane((unsigned)v), hi = __builtin_amdgcn_readfirstlane((unsigned)(v >> 32)); return (const float*)(const GAS float*)(((unsigned long long)hi << 32) | lo); }
#define AIN(k) in_ptr(F, (k))
DI int modrow(int row) { return row < RL ? (row >> 11) : NB; }
DI const float* mod_vec(const Frame& F, int layer, int mr, int chunk) { return (const float*)(F.ws + WS_MOD) + ((size_t)(layer * 9 + mr) * 6 + chunk) * DM; }

DI bf16x8 tr_read_pair(unsigned a_lo, unsigned a_hi) { s16x4 lo, hi;
    asm volatile("ds_read_b64_tr_b16 %0, %2\n\tds_read_b64_tr_b16 %1, %3\n\ts_waitcnt lgkmcnt(0)" : "=&v"(lo), "=&v"(hi) : "v"(a_lo), "v"(a_hi) : "memory");
    return (bf16x8){lo[0], lo[1], lo[2], lo[3], hi[0], hi[1], hi[2], hi[3]}; }
DI bf16x8 cat4(s16x4 l, s16x4 h) { return (bf16x8){l[0], l[1], l[2], l[3], h[0], h[1], h[2], h[3]}; }
DI int rowmap(int kind, int n) {
    if (kind == 1) return n < 2560 ? n : (n < 2592 ? n + 2048 : n - 32);
    if (kind == 2) return ((n >> 4) << 5) + (n & 15);
    if (kind == 3) return ((n >> 4) << 5) + 16 + (n & 15);
    return n;
}
DI void transpose_item(const float* W, int K, int N, bf16_t* WT, int kind, LAS float* scr, int item, int lane) {
    const int nblk = N / 32, kb = item / nblk, nb = item % nblk, k0 = 64 * kb, n0 = 32 * nb;
#pragma unroll 8
    for (int i = 0; i < 32; ++i) { const int kk = 2 * i + (lane >> 5); scr[kk * 33 + (lane & 31)] = W[(size_t)(k0 + kk) * N + n0 + (lane & 31)]; }
    LDS_WAIT(); asm volatile("" ::: "memory");
    const int c = lane & 7;
#pragma unroll
    for (int j = 0; j < 4; ++j) { const int n = (lane >> 3) + 8 * j; const LAS float* s = scr + (8 * c) * 33 + n;
        u32x4 o; o.x = pk2(s[0 * 33], s[1 * 33]); o.y = pk2(s[2 * 33], s[3 * 33]); o.z = pk2(s[4 * 33], s[5 * 33]); o.w = pk2(s[6 * 33], s[7 * 33]);
        *(u32x4*)(WT + (size_t)rowmap(kind, n0 + n) * K + k0 + 8 * c) = o; }
    LDS_WAIT(); asm volatile("" ::: "memory");
}
DI bool conv_group(int& it, const float* src, size_t ss, int cnt, int K, int N, bf16_t* dst, size_t ds, int kind, LAS float* scr, int lane) {
    const int per = (K / 64) * (N / 32), tot = per * cnt;
    if (it >= tot) { it -= tot; return false; }
    const int m = it / per, r = it % per;
    transpose_item(src + (size_t)m * ss, K, N, dst + (size_t)m * ds, kind, scr, r, lane);
    return true;
}
struct ConvTile { const float* W; bf16_t* WT; int K, N, kind, k0, n0, f8; float scale; };
DI bool conv_tile_decode(const Frame& F, int t, ConvTile& c) {
    constexpr int PER_LAYER = 256 + 65 * 64 * 3 + 32 * 19;
    if (t >= 2 * PER_LAYER) return false;
    const int l = t / PER_LAYER; int r = t % PER_LAYER;
    bf16_t* WOUT = (bf16_t*)(F.ws + WS_WOUT); bf16_t* WGU = (bf16_t*)(F.ws + WS_WGU); bf16_t* WD = (bf16_t*)(F.ws + WS_WD);
    if (r < 256) { c.W = AIN(8) + (size_t)l * DM * DM; c.WT = WOUT + (size_t)l * DM * DM; c.K = DM; c.N = DM; c.kind = 0; c.k0 = (r >> 3) * 64; c.n0 = (r & 7) * 256; c.f8 = 0; c.scale = 1.f; return true; }
    r -= 256;
    if (r < 2 * 65 * 64) { const int up = r >= 65 * 64; if (up) r -= 65 * 64; const int e = r >> 6, q = r & 63;
        c.W = e < 64 ? AIN(up ? 24 : 23) + ((size_t)l * 64 + e) * DM * EH : AIN(up ? 27 : 26) + (size_t)l * DM * EH;
        c.f8 = MOE_FP8[l] ? 1 : 0; c.scale = SW_GU;
        c.WT = c.f8 ? (bf16_t*)((unsigned char*)(WGU + (size_t)l * 65 * 1024 * DM) + (size_t)e * 1024 * DM) : WGU + ((size_t)l * 65 + e) * 1024 * DM; c.K = DM; c.N = EH; c.kind = up ? 3 : 2; c.k0 = (q >> 1) * 64; c.n0 = (q & 1) * 256; return true; }
    r -= 2 * 65 * 64;
    if (r >= 65 * 64) { r -= 65 * 64;
        c.W = AIN(7) + (size_t)l * DM * INC; c.WT = (bf16_t*)(F.ws + WS_WIN) + (size_t)l * PC * DM; c.K = DM; c.N = INC; c.kind = 1; c.k0 = (r / 19) * 64; c.n0 = (r % 19) * 256; c.f8 = IN_FP8[l] ? 1 : 0; c.scale = SW_IN; return true; }
    { const int e = r >> 6, q = r & 63;
      c.W = e < 64 ? AIN(25) + ((size_t)l * 64 + e) * EH * DM : AIN(28) + (size_t)l * EH * DM;
      c.f8 = MOE2_FP8[l] ? 1 : 0; c.scale = SW_D;
      c.WT = c.f8 ? (bf16_t*)((unsigned char*)(WD + (size_t)l * 65 * DM * EH) + (size_t)e * DM * EH) : WD + ((size_t)l * 65 + e) * DM * EH; c.K = EH; c.N = DM; c.kind = 0; c.k0 = (q >> 3) * 64; c.n0 = (q & 7) * 256; return true; }
}
DI void conv_tile_load(const ConvTile& c, int tid, f32x4 (&r)[8]) {
#pragma unroll
    for (int i = 0; i < 8; ++i) r[i] = (c.n0 + 4 * (tid & 63) < c.N) ? *(const f32x4*)(c.W + (size_t)(c.k0 + (tid >> 6) + 8 * i) * c.N + c.n0 + 4 * (tid & 63)) : (f32x4){0.f, 0.f, 0.f, 0.f};
}
DI void p0_convert_fast(const Frame& F) {
    LAS unsigned char* img = F.lds;
    const int g = F.lane >> 4, q = (F.lane & 15) >> 2, p = F.lane & 3;
    ConvTile cur, nxt; f32x4 rc[8], rn[8];
    int t = F.bid; bool have = conv_tile_decode(F, t, cur);
    if (have) conv_tile_load(cur, F.tid, rc);
    while (have) {
        const bool hn = conv_tile_decode(F, t + F.G, nxt);
        if (hn) conv_tile_load(nxt, F.tid, rn);
#pragma unroll
        for (int i = 0; i < 8; ++i) { u32x2 w; w.x = pk2(rc[i].x, rc[i].y); w.y = pk2(rc[i].z, rc[i].w); *(LAS u32x2*)(img + ((F.tid >> 6) + 8 * i) * 528 + (F.tid & 63) * 8) = w; }
        __syncthreads();
        if (cur.f8) {
#pragma unroll
            for (int i = 0; i < 2; ++i) { const int nb = F.wave * 2 + i;
                const unsigned a0 = (unsigned)(uintptr_t)img + (unsigned)(16 * g + q) * 528u + (unsigned)(16 * nb + 4 * p) * 2u;
                const bf16x8 t01 = tr_read_pair(a0, a0 + 4u * 528u), t23 = tr_read_pair(a0 + 8u * 528u, a0 + 12u * 528u);
                const float sc = cur.scale; u32x4 w;
#define F8W(T_, O_) pg8::pk4_fp8(bf2f((unsigned short)T_[O_]) * sc, bf2f((unsigned short)T_[O_ + 1]) * sc, bf2f((unsigned short)T_[O_ + 2]) * sc, bf2f((unsigned short)T_[O_ + 3]) * sc)
                w.x = F8W(t01, 0); w.y = F8W(t01, 4); w.z = F8W(t23, 0); w.w = F8W(t23, 4);
#undef F8W
                const int n = cur.n0 + 16 * nb + (F.lane & 15);
                if (n < cur.N) *(u32x4*)((unsigned char*)cur.WT + (size_t)rowmap(cur.kind, n) * cur.K + cur.k0 + 16 * g) = w; }
        } else {
#pragma unroll
        for (int i = 0; i < 4; ++i) { const int combo = F.wave * 4 + i, nb = combo >> 1, kh = combo & 1;
            const unsigned a0 = (unsigned)(uintptr_t)img + (unsigned)(32 * kh + 8 * g + q) * 528u + (unsigned)(16 * nb + 4 * p) * 2u;
            const bf16x8 lohi = tr_read_pair(a0, a0 + 4u * 528u);
            const int n = cur.n0 + 16 * nb + (F.lane & 15);
            if (n < cur.N) *(bf16x8*)(cur.WT + (size_t)rowmap(cur.kind, n) * cur.K + cur.k0 + 32 * kh + 8 * g) = lohi; }
        }
        __syncthreads();
        cur = nxt; have = hn; t += F.G;
#pragma unroll
        for (int i = 0; i < 8; ++i) rc[i] = rn[i];
    }
}
DI void p0_convert(const Frame& F, const Args& a) {
    LAS float* scr = (LAS float*)(F.lds + F.wave * 16384);
    const int gw = F.bid * NWAVES + F.wave, NGW = F.G * NWAVES;
    bf16_t* WIN = (bf16_t*)(F.ws + WS_WIN); bf16_t* LRUW = (bf16_t*)(F.ws + WS_LRUW);
    constexpr int PER_LAYER = 2 * 8 * 8 + 224;
    for (int it0 = gw; it0 < 2 * PER_LAYER; it0 += NGW) {
        const int l = it0 / PER_LAYER; int it = it0 % PER_LAYER;
        { const int per = 8; if (it < 8 * per) { const int m = it / per, r = it % per, d = m >> 2, h = m & 3;
            transpose_item(AIN(11) + ((size_t)(l * 2 + d) * 4 + h) * 16384, 128, 128, LRUW + ((size_t)((l * 2 + d) * 2 + 0) * 4 + h) * 16384, 0, scr, r, F.lane); continue; } it -= 8 * per;
          if (it < 8 * per) { const int m = it / per, r = it % per, d = m >> 2, h = m & 3;
            transpose_item(AIN(13) + ((size_t)(l * 2 + d) * 4 + h) * 16384, 128, 128, LRUW + ((size_t)((l * 2 + d) * 2 + 1) * 4 + h) * 16384, 0, scr, r, F.lane); continue; } it -= 8 * per; }
        { u32x4 z = {0u, 0u, 0u, 0u}; const int rb = IN_FP8[l] ? DM : DM * 2;
          u32x4* p = (u32x4*)((unsigned char*)(WIN + (size_t)l * PC * DM) + (size_t)(INC + it) * rb) + F.lane;
          for (int j = 0; j < rb / 1024; ++j) p[64 * j] = z; }
    }
    __syncthreads();
}
DI void p0_mod(const Frame& F, const Args& a) {
    LAS float* st = (LAS float*)F.lds;
    LAS float* part = (LAS float*)(F.lds + 73728);
    if (F.bid == 200) { float* SP = (float*)(F.ws + WS_SP); for (int i = F.tid; i < 2048; i += NTHR) SP[i] = log1pf(expf(-AIN(15)[i])); }
    if (F.bid >= 208 && F.bid < 224) { bf16_t* RWS = (bf16_t*)(F.ws + WS_RWS); const float* rw = AIN(21);
        for (int i = (F.bid - 208) * NTHR + F.tid; i < 2 * DM * NEXP; i += 16 * NTHR) { const int l = i / (DM * NEXP), r = i % (DM * NEXP), k = r >> 6, e = r & 63; const float w = rw[i];
            const unsigned hi = f2bf(w); const float lo = w - bf2f((unsigned short)hi);
            const size_t fi = (size_t)l * NEXP * DM + (((((size_t)(k >> 8) * 8 + ((k >> 5) & 7)) * 4 + (e >> 4)) * 64 + (((k >> 3) & 3) * 16 + (e & 15))) * 8 + (k & 7));
            RWS[fi] = (bf16_t)hi; RWS[(size_t)2 * NEXP * DM + fi] = (bf16_t)f2bf(lo); } }
    if (F.bid == 224) { unsigned* rid = (unsigned*)(F.ws + WS_ROWID); for (int i = F.tid; i < RT; i += NTHR) rid[i] = (unsigned)i * (unsigned)DM; }
    if (F.bid >= 192) return;
    for (int i = F.tid; i < 9 * DM; i += NTHR) { const int r = i / DM, k = i % DM; const float c = r < 8 ? AIN(1)[r * DM + k] : AIN(3)[k]; st[k * 9 + r] = siluf_(c); }
    __syncthreads();
    const int l = F.bid / 96, cg = F.bid % 96;
    const float* W = AIN(4) + (size_t)l * DM * 12288 + cg * 128 + 2 * F.lane;
    float acc[9][2];
#pragma unroll
    for (int r = 0; r < 9; ++r) { acc[r][0] = 0.f; acc[r][1] = 0.f; }
    const int kb = F.wave * 256;
#pragma unroll 4
    for (int k = kb; k < kb + 256; ++k) { const f32x2 w = *(const f32x2*)(W + (size_t)k * 12288);
#pragma unroll
        for (int r = 0; r < 9; ++r) { const float s = st[k * 9 + r]; acc[r][0] += s * w.x; acc[r][1] += s * w.y; } }
#pragma unroll
    for (int r = 0; r < 9; ++r) { part[(F.wave * 9 + r) * 128 + 2 * F.lane] = acc[r][0]; part[(F.wave * 9 + r) * 128 + 2 * F.lane + 1] = acc[r][1]; }
    __syncthreads();
    float* MOD = (float*)(F.ws + WS_MOD);
    for (int i = F.tid; i < 9 * 128; i += NTHR) { const int r = i >> 7, c = i & 127; float s = AIN(5)[l * 12288 + cg * 128 + c];
#pragma unroll
        for (int w = 0; w < 8; ++w) s += part[(w * 9 + r) * 128 + c];
        MOD[(size_t)(l * 9 + r) * 12288 + cg * 128 + c] = s; }
    asm volatile("s_waitcnt vmcnt(0)" ::: "memory");
    __syncthreads();
    if (l == 0 && cg < 32 && F.tid == 0) { __builtin_amdgcn_fence(__ATOMIC_RELEASE, "agent"); asm volatile("s_waitcnt vmcnt(0)" ::: "memory"); (void)xb_add(F.ctl + CW_QUEUE + 64 * 8, 1u); }
}

DI float row_sumsq(const f32x4 (&v)[8]) { float s = 0.f;
#pragma unroll
    for (int j = 0; j < 8; ++j) s += (v[j].x * v[j].x + v[j].y * v[j].y) + (v[j].z * v[j].z + v[j].w * v[j].w);
    return wave_sum(s); }
DI void norm_mod_store(const f32x4 (&v)[8], float rstd, const float* g, const float* shift, const float* scale, bf16_t* hrow, int lane) {
#pragma unroll
    for (int j = 0; j < 8; ++j) { const int c = 256 * j + 4 * lane; const f32x4 gg = *(const f32x4*)(g + c), sh = *(const f32x4*)(shift + c), sc = *(const f32x4*)(scale + c);
        const f32x4 h = v[j] * rstd * gg * (sc + 1.0f) + sh;
        if (IN_FP8[0]) *(unsigned*)((unsigned char*)hrow + c) = pg8::pk4_fp8(h.x, h.y, h.z, h.w);
        else { u32x2 w; w.x = pk2(h.x, h.y); w.y = pk2(h.z, h.w); *(u32x2*)(hrow + c) = w; } }
}
DI void pre_rows(const Frame& F, const Args& a, int layer, const float* xl, const float* xc, int nrows) {
    const int gw = F.bid * NWAVES + F.wave, NGW = F.G * NWAVES; bf16_t* H = (bf16_t*)(F.ws + WS_H);
    const float* g0 = AIN(6) + (size_t)(layer * 4 + 0) * DM;
    f32x4 nv[8];
    if (gw < nrows) { const float* xr = gw < RL ? xl + (size_t)gw * DM : xc + (size_t)(gw - RL) * DM;
#pragma unroll
        for (int j = 0; j < 8; ++j) nv[j] = *(const f32x4*)(xr + 256 * j + 4 * F.lane); }
#pragma unroll 1
    for (int row = gw; row < nrows; row += NGW) {
        f32x4 v[8];
#pragma unroll
        for (int j = 0; j < 8; ++j) v[j] = nv[j];
        { const int nr = row + NGW; if (nr < nrows) { const float* xr = nr < RL ? xl + (size_t)nr * DM : xc + (size_t)(nr - RL) * DM;
#pragma unroll
            for (int j = 0; j < 8; ++j) nv[j] = *(const f32x4*)(xr + 256 * j + 4 * F.lane); } }
        const float rstd = rsqrtf(row_sumsq(v) * (1.0f / DM) + RMS_EPS); const int mr = modrow(row);
        norm_mod_store(v, rstd, g0, mod_vec(F, layer, mr, 0), mod_vec(F, layer, mr, 1), IN_FP8[0] ? (bf16_t*)((unsigned char*)H + (size_t)row * DM) : H + (size_t)row * DM, F.lane);
    }
}

template <bool F8, bool XIB> DI void postmix_phase(const Frame& F, const Args& a, int layer, const void* xl_src_, const void* xc_src_, bf16_t* xl_dst, bf16_t* xc_dst, int nrows) {
    LAS unsigned char* AH = F.lds;
    LAS unsigned char* AL = F.lds + 8 * 4112;
    LAS float* part = (LAS float*)(F.lds + 66048);
    LAS unsigned* hist = (LAS unsigned*)(F.lds + 66048 + 16384);
    const bf16_t* YO = (const bf16_t*)(F.ws + WS_ARENA + AR_YO); bf16_t* H = (bf16_t*)(F.ws + WS_H);
    int* TOKE = (int*)(F.ws + WS_META + MT_TOKE); int* TOKR = (int*)(F.ws + WS_META + MT_TOKR); float* TOKG = (float*)(F.ws + WS_META + MT_TOKG);
    const float* g1 = AIN(6) + (size_t)(layer * 4 + 1) * DM; const float* g2 = AIN(6) + (size_t)(layer * 4 + 2) * DM;
    const bf16_t* RWH = (const bf16_t*)(F.ws + WS_RWS) + (size_t)layer * NEXP * DM; const bf16_t* RWL = RWH + (size_t)2 * NEXP * DM; const float rbias = AIN(22)[layer * NEXP + F.lane];
    const int rpb = nrows / F.G;
    LAS float* VA1 = (LAS float*)(F.lds + 83968); LAS float* VA2 = VA1 + DM; LAS float* VB2 = VA2 + DM;
    if (F.tid < 64) hist[F.tid] = 0u;
    int cur_mr = -1;
    u32x2 yc[8], yn[8]; f32x4 xc[8], xn[8];
#define PM_LOAD(Y_, X_, it_) do { const int row_ = F.bid * rpb + (it_) * 8 + F.wave; \
        if constexpr (XIB) { const bf16_t* xs_ = row_ < RL ? (const bf16_t*)xl_src_ + (size_t)row_ * DM : (const bf16_t*)xc_src_ + (size_t)(row_ - RL) * DM; \
            _Pragma("unroll") for (int j = 0; j < 8; ++j) { Y_[j] = *(const u32x2*)(YO + (size_t)row_ * DM + 256 * j + 4 * F.lane); const u32x2 t_ = *(const u32x2*)(xs_ + 256 * j + 4 * F.lane); const unsigned tx_ = t_.x, ty_ = t_.y; X_[j].x = __builtin_bit_cast(float, tx_); X_[j].y = __builtin_bit_cast(float, ty_); } }        \
        else { const float* xs_ = row_ < RL ? (const float*)xl_src_ + (size_t)row_ * DM : (const float*)xc_src_ + (size_t)(row_ - RL) * DM; \
            _Pragma("unroll") for (int j = 0; j < 8; ++j) { Y_[j] = *(const u32x2*)(YO + (size_t)row_ * DM + 256 * j + 4 * F.lane); X_[j] = *(const f32x4*)(xs_ + 256 * j + 4 * F.lane); } } } while (0)
    PM_LOAD(yc, xc, 0);
    __syncthreads();
    for (int it = 0; it < rpb / 8; ++it) {
        const int row = F.bid * rpb + it * 8 + F.wave; const int mr = modrow(F.bid * rpb + it * 8);
        bf16_t* xd = row < RL ? xl_dst + (size_t)row * DM : xc_dst + (size_t)(row - RL) * DM;
        if (mr != cur_mr) { cur_mr = mr;
            const float* m2 = mod_vec(F, layer, mr, 2); const float* m3 = mod_vec(F, layer, mr, 3); const float* m4 = mod_vec(F, layer, mr, 4); const int c = 4 * F.tid;
            const f32x4 a1 = *(const f32x4*)(m2 + c) * *(const f32x4*)(g1 + c), a2 = *(const f32x4*)(g2 + c) * (*(const f32x4*)(m4 + c) + 1.0f), b2 = *(const f32x4*)(m3 + c);
            *(LAS f32x4*)(VA1 + c) = a1; *(LAS f32x4*)(VA2 + c) = a2; *(LAS f32x4*)(VB2 + c) = b2;
            __syncthreads(); }
        f32x4 v[8];
        { f32x4 y[8];
#pragma unroll
          for (int j = 0; j < 8; ++j) y[j] = (f32x4){bflo(yc[j].x), bfhi(yc[j].x), bflo(yc[j].y), bfhi(yc[j].y)};
          const float rstd = rsqrtf(row_sumsq(y) * (1.0f / DM) + RMS_EPS);
#pragma unroll
          for (int j = 0; j < 8; ++j) { const int c = 256 * j + 4 * F.lane; f32x4 xv = xc[j];
              if constexpr (XIB) { const float r0 = xc[j].x, r1 = xc[j].y; const unsigned w0 = __builtin_bit_cast(unsigned, r0), w1 = __builtin_bit_cast(unsigned, r1); xv = (f32x4){bflo(w0), bfhi(w0), bflo(w1), bfhi(w1)}; }
              v[j] = xv + *(const LAS f32x4*)(VA1 + c) * (y[j] * rstd); *(u32x2*)(xd + c) = (u32x2){pk2(v[j].x, v[j].y), pk2(v[j].z, v[j].w)}; } }
        { const float rstd = rsqrtf(row_sumsq(v) * (1.0f / DM) + RMS_EPS);
#pragma unroll
          for (int j = 0; j < 8; ++j) { const int c = 256 * j + 4 * F.lane;
              const f32x4 h = v[j] * rstd * *(const LAS f32x4*)(VA2 + c) + *(const LAS f32x4*)(VB2 + c);
              if constexpr (F8) { *(unsigned*)((unsigned char*)H + (size_t)row * DM + c) = pg8::pk4_fp8(h.x, h.y, h.z, h.w); } else { u32x2 w; w.x = pk2(h.x, h.y); w.y = pk2(h.z, h.w); *(u32x2*)(H + (size_t)row * DM + c) = w; }
              { const unsigned h0 = f2bf(h.x), h1 = f2bf(h.y), h2 = f2bf(h.z), h3 = f2bf(h.w); u32x2 wh, wl; wh.x = h0 | (h1 << 16); wh.y = h2 | (h3 << 16);
                wl.x = pk2(h.x - bf2f((unsigned short)h0), h.y - bf2f((unsigned short)h1)); wl.y = pk2(h.z - bf2f((unsigned short)h2), h.w - bf2f((unsigned short)h3));
                *(LAS u32x2*)(AH + F.wave * 4112 + c * 2) = wh; *(LAS u32x2*)(AL + F.wave * 4112 + c * 2) = wl; } } }
        if (it + 1 < rpb / 8) PM_LOAD(yn, xn, it + 1);
        __syncthreads();
        { const int fr = F.lane & 15, fq = F.lane >> 4; f32x4 acc[4];
#pragma unroll
          for (int et = 0; et < 4; ++et) acc[et] = (f32x4){0.f, 0.f, 0.f, 0.f};
          const bf16_t* wph = RWH + ((size_t)F.wave * 8 * 4 * 64 + F.lane) * 8; const bf16_t* wpl = RWL + ((size_t)F.wave * 8 * 4 * 64 + F.lane) * 8;
          bf16x8 wh[3][4], wl[3][4];
#define RT_LD(buf, s_) do { _Pragma("unroll") for (int et = 0; et < 4; ++et) { wh[buf][et] = *(const bf16x8*)(wph + ((s_) * 4 + et) * 512); wl[buf][et] = *(const bf16x8*)(wpl + ((s_) * 4 + et) * 512); } } while (0)
#define RT_MM(buf, s_) do { const bf16x8 bh = *(const LAS bf16x8*)(AH + (fr & 7) * 4112 + (F.wave * 256 + 32 * (s_) + fq * 8) * 2), bl = *(const LAS bf16x8*)(AL + (fr & 7) * 4112 + (F.wave * 256 + 32 * (s_) + fq * 8) * 2); \
              _Pragma("unroll") for (int et = 0; et < 4; ++et) { acc[et] = MFMA16(wh[buf][et], bh, acc[et]); acc[et] = MFMA16(wh[buf][et], bl, acc[et]); acc[et] = MFMA16(wl[buf][et], bh, acc[et]); } } while (0)
          RT_LD(0, 0); RT_LD(1, 1);
#pragma unroll 1
          for (int s2 = 0; s2 < 6; s2 += 3) { RT_LD(2, s2 + 2); RT_MM(0, s2); RT_LD(0, s2 + 3); RT_MM(1, s2 + 1); RT_LD(1, s2 + 4); RT_MM(2, s2 + 2); }
          RT_MM(0, 6); RT_MM(1, 7);
#undef RT_LD
#undef RT_MM
          if (fr < 8) {
#pragma unroll
              for (int et = 0; et < 4; ++et) *(LAS f32x4*)(part + (F.wave * 8 + fr) * 64 + et * 16 + 4 * fq) = acc[et]; } }
        __syncthreads();
        { int ln = F.lane; asm volatile("" : "+v"(ln));
          float logit = 0.f;
#pragma unroll
          for (int w = 0; w < 8; ++w) logit += part[(w * 8 + F.wave) * 64 + ln];
          const float s = 1.0f / (1.0f + expf(-logit)); const float bsd = s + rbias; const float NINF = -__builtin_inff();
          float m1 = bsd; m1 = fmaxf(m1, __shfl_xor(m1, 1)); m1 = fmaxf(m1, __shfl_xor(m1, 2)); m1 = fmaxf(m1, __shfl_xor(m1, 4));
          const unsigned long long bal = __ballot(bsd == m1); const int g = ln >> 3; const unsigned gm = (unsigned)(bal >> (8 * g)) & 0xffu; const int first = __ffs(gm) - 1;
          float b2 = ((ln & 7) == first) ? NINF : bsd; b2 = fmaxf(b2, __shfl_xor(b2, 1)); b2 = fmaxf(b2, __shfl_xor(b2, 2)); b2 = fmaxf(b2, __shfl_xor(b2, 4));
          const float gs = m1 + b2; int grank = 0;
#pragma unroll
          for (int gg = 0; gg < 8; ++gg) { const float og = rdlane(gs, gg * 8); grank += ((og > gs) || (og == gs && gg < g)) ? 1 : 0; }
          const bool elig = grank < 4; const float mk = elig ? bsd : NINF; int erank = 0;
#pragma unroll
          for (int ee = 0; ee < 64; ++ee) { const float ov = rdlane(mk, ee); erank += ((ov > mk) || (ov == mk && ee < ln)) ? 1 : 0; }
          const bool sel = elig && erank < 8; const float ssum = wave_sum(sel ? s : 0.f); const float gate = s / ssum * 2.5f;
          const unsigned long long sb = __ballot(sel); const int kidx = __popcll(sb & ((1ull << ln) - 1ull));
          if (sel) { const unsigned rk = __hip_atomic_fetch_add(hist + ln, 1u, __ATOMIC_RELAXED, __HIP_MEMORY_SCOPE_WORKGROUP);
              TOKE[row * 8 + kidx] = ln; TOKR[row * 8 + kidx] = (int)rk; TOKG[row * 8 + kidx] = gate; } }
        __syncthreads();
#pragma unroll
        for (int j = 0; j < 8; ++j) { yc[j] = yn[j]; xc[j] = xn[j]; }
    }
#undef PM_LOAD
    if (F.tid < 64) ((unsigned*)(F.ws + WS_META + MT_BLKCNT))[F.bid * 64 + F.tid] = hist[F.tid];
    __syncthreads();
}

DI void moe_tables(const Frame& F, int ntok) {
    LAS unsigned char* T = F.lds + TBL_OFF;
    LAS unsigned short* tile_e = (LAS unsigned short*)T; LAS unsigned* pstart = (LAS unsigned*)(T + 2048); LAS unsigned* cnt = (LAS unsigned*)(T + 2304); LAS unsigned* base = (LAS unsigned*)(T + 2560); LAS unsigned* misc = (LAS unsigned*)(T + 2816);
    LAS unsigned* tmp = (LAS unsigned*)F.lds;
    const unsigned* BC = (const unsigned*)(F.ws + WS_META + MT_BLKCNT);
    { const int e = F.tid & 63, p = F.tid >> 6; unsigned tot = 0, below = 0;
      for (int b = p * 32; b < p * 32 + 32; ++b) { const unsigned c = (b < F.G) ? BC[b * 64 + e] : 0u; tot += c; below += (b < F.bid) ? c : 0u; }
      tmp[p * 64 + e] = tot; tmp[512 + p * 64 + e] = below; }
    __syncthreads();
    if (F.tid < 64) { unsigned tot = 0, below = 0;
#pragma unroll
        for (int p = 0; p < 8; ++p) { tot += tmp[p * 64 + F.tid]; below += tmp[512 + p * 64 + F.tid]; }
        cnt[F.tid] = tot; base[F.tid] = below; }
    __syncthreads();
    if (F.tid < 64) { unsigned s = 0, tot = 0;
#pragma unroll 16
        for (int e = 0; e < 64; ++e) { const unsigned pc = (cnt[e] + 255u) & ~255u; s += (e < F.tid) ? pc : 0u; tot += pc; }
        pstart[F.tid] = s; if (F.tid == 0) misc[0] = tot >> 8; }
    __syncthreads();
    const int nrt = (int)misc[0], nst = ntok / 256;
    for (int t = F.tid; t < nrt + nst; t += NTHR) { int e = 64; if (t < nrt) { const unsigned s = (unsigned)t << 8; e = 0;
#pragma unroll 1
            for (int q = 32; q >= 1; q >>= 1) if (e + q < 64 && pstart[e + q] <= s) e += q;
            while (e < 63 && pstart[e + 1] <= s) ++e; }
        tile_e[t] = (unsigned short)e; }
    __syncthreads();
}
DI void slots_phase(const Frame& F, int layer, int ntok, unsigned rowbytes) {
    moe_tables(F, ntok);
    LAS unsigned char* T = F.lds + TBL_OFF;
    LAS unsigned* pstart = (LAS unsigned*)(T + 2048); LAS unsigned* cnt = (LAS unsigned*)(T + 2304); LAS unsigned* base = (LAS unsigned*)(T + 2560); LAS unsigned* misc = (LAS unsigned*)(T + 2816);
    const int* TOKE = (const int*)(F.ws + WS_META + MT_TOKE); const int* TOKR = (const int*)(F.ws + WS_META + MT_TOKR); const float* TOKG = (const float*)(F.ws + WS_META + MT_TOKG);
    int* TOKS = (int*)(F.ws + WS_META + MT_TOKS); unsigned* ROWOFF = (unsigned*)(F.ws + WS_META + MT_ROWOFF);
    const int rpb = ntok / F.G; const unsigned sslot0 = misc[0] << 8;
    for (int i = F.tid; i < rpb * 8; i += NTHR) { const int row = F.bid * rpb + (i >> 3), k = i & 7; const int e = TOKE[row * 8 + k];
        const unsigned slot = pstart[e] + base[e] + (unsigned)TOKR[row * 8 + k];
        TOKS[row * 8 + k] = (int)slot; ROWOFF[slot] = (unsigned)row * rowbytes; }
    for (int i = F.tid; i < rpb; i += NTHR) { const int row = F.bid * rpb + i; ROWOFF[sslot0 + row] = (unsigned)row * rowbytes; }
    if (F.bid < 64) { const unsigned e = F.bid, c = cnt[e], pe = (c + 255u) & ~255u;
        for (unsigned i = c + F.tid; i < pe; i += NTHR) { ROWOFF[pstart[e] + i] = 0u; } }
    (void)layer;
}

__device__ __attribute__((noinline)) void combine_phase_ol(unsigned char* ws_, int tid_, int wave_, int bid_, int layer, float* xout, int nrows, int next_pre_) {
    extern __shared__ __attribute__((aligned(16))) unsigned char lds_raw2[];
    Frame F; F.lds = (LAS unsigned char*)lds_raw2; F.ws = ws_; F.ctl = (unsigned*)(ws_ + WS_CTL); F.tid = tid_; F.lane = tid_ & 63; F.wave = wave_; F.bid = bid_; const bool next_pre = next_pre_ != 0;
    const unsigned char* MO = (const unsigned char*)(F.ws + WS_ARENA + AR_MO); const int* TOKS = (const int*)(F.ws + WS_META + MT_TOKS); const float* TOKG = (const float*)(F.ws + WS_META + MT_TOKG);
    const unsigned sslot0 = ((LAS unsigned*)(F.lds + TBL_OFF + 2816))[0] << 8;
    const float* g3 = AIN(6) + (size_t)(layer * 4 + 3) * DM; const float* g0n = AIN(6) + (size_t)((layer + 1 < NLAYER ? layer + 1 : layer) * 4 + 0) * DM; const int rpb = nrows / F.G;
    LAS float* VA3 = (LAS float*)F.lds; LAS float* VA0 = VA3 + DM; LAS float* VB0 = VA0 + DM;
    int cur_mr = -1;
    int sv = TOKS[(F.bid * rpb + F.wave) * 8 + (F.lane & 7)]; float gv = TOKG[(F.bid * rpb + F.wave) * 8 + (F.lane & 7)];
    __syncthreads();
    for (int i = 0; i < rpb / 8; ++i) { const int row = F.bid * rpb + i * 8 + F.wave; const int mr_ = modrow(F.bid * rpb + i * 8);
        if (mr_ != cur_mr) { cur_mr = mr_; __syncthreads(); int c = 4 * F.tid; asm volatile("" : "+v"(c));
            *(LAS f32x4*)(VA3 + c) = *(const f32x4*)(mod_vec(F, layer, mr_, 5) + c) * *(const f32x4*)(g3 + c);
            if (next_pre) { *(LAS f32x4*)(VA0 + c) = *(const f32x4*)(g0n + c) * (*(const f32x4*)(mod_vec(F, layer + 1, mr_, 1) + c) + 1.0f); *(LAS f32x4*)(VB0 + c) = *(const f32x4*)(mod_vec(F, layer + 1, mr_, 0) + c); }
            __syncthreads(); }
        unsigned slot[9]; float gk[9];
#pragma unroll
        for (int k = 0; k < 8; ++k) { slot[k] = (unsigned)__builtin_amdgcn_readlane(sv, k); gk[k] = rdlane(gv, k) * (1.0f / S_MO); }
        slot[8] = sslot0 + (unsigned)row; gk[8] = 1.0f / S_MO;
        if (i + 1 < rpb / 8) { sv = TOKS[(row + 8) * 8 + (F.lane & 7)]; gv = TOKG[(row + 8) * 8 + (F.lane & 7)]; }
        bf16_t* xr = row < RL ? (bf16_t*)(F.ws + WS_ARENA + AR_XLB) + (size_t)row * DM : (bf16_t*)(F.ws + WS_XC) + (size_t)(row - RL) * DM;
        float f[4][8];
#pragma unroll
        for (int j = 0; j < 4; ++j)
#pragma unroll
            for (int e = 0; e < 8; ++e) f[j][e] = 0.f;
#pragma unroll
        for (int k3 = 0; k3 < 9; k3 += 3) { u32x2 w[3][4];
#pragma unroll
            for (int q = 0; q < 3; ++q)
#pragma unroll
                for (int j = 0; j < 4; ++j) w[q][j] = *(const u32x2*)(MO + (size_t)slot[k3 + q] * DM + 512 * j + 8 * F.lane);
#pragma unroll
            for (int q = 0; q < 3; ++q)
#pragma unroll
                for (int j = 0; j < 4; ++j) { const f32x2 p0 = __builtin_amdgcn_cvt_pk_f32_fp8((int)w[q][j].x, false), p1 = __builtin_amdgcn_cvt_pk_f32_fp8((int)w[q][j].x, true), p2 = __builtin_amdgcn_cvt_pk_f32_fp8((int)w[q][j].y, false), p3 = __builtin_amdgcn_cvt_pk_f32_fp8((int)w[q][j].y, true);
                    const float g = gk[k3 + q]; f[j][0] += p0.x * g; f[j][1] += p0.y * g; f[j][2] += p1.x * g; f[j][3] += p1.y * g; f[j][4] += p2.x * g; f[j][5] += p2.y * g; f[j][6] += p3.x * g; f[j][7] += p3.y * g; } }
        float ss = 0.f;
#pragma unroll
        for (int j = 0; j < 4; ++j)
#pragma unroll
            for (int e = 0; e < 8; ++e) ss += f[j][e] * f[j][e];
        const float rstd = rsqrtf(wave_sum(ss) * (1.0f / DM) + RMS_EPS);
        float ss2 = 0.f;
#pragma unroll
        for (int j = 0; j < 4; ++j) { const int c8 = 512 * j + 8 * F.lane; const u32x4 xw = *(const u32x4*)(xr + c8);
            const float xv[8] = {bflo(xw.x), bfhi(xw.x), bflo(xw.y), bfhi(xw.y), bflo(xw.z), bfhi(xw.z), bflo(xw.w), bfhi(xw.w)};
#pragma unroll
            for (int h2 = 0; h2 < 2; ++h2) { const f32x4 a3 = *(const LAS f32x4*)(VA3 + c8 + 4 * h2);
#pragma unroll
                for (int e = 0; e < 4; ++e) { const float o = xv[4 * h2 + e] + a3[e] * (f[j][4 * h2 + e] * rstd); f[j][4 * h2 + e] = o; ss2 += o * o; } }
            if (next_pre) *(u32x4*)(xr + c8) = (u32x4){pk2(f[j][0], f[j][1]), pk2(f[j][2], f[j][3]), pk2(f[j][4], f[j][5]), pk2(f[j][6], f[j][7])};
            else { float* xo = xout + (size_t)row * DM + c8; *(f32x4*)xo = (f32x4){f[j][0], f[j][1], f[j][2], f[j][3]}; *(f32x4*)(xo + 4) = (f32x4){f[j][4], f[j][5], f[j][6], f[j][7]}; } }
        if (next_pre) { const float r2 = rsqrtf(wave_sum(ss2) * (1.0f / DM) + RMS_EPS); bf16_t* hrow = (bf16_t*)(F.ws + WS_H) + (size_t)row * DM;
#pragma unroll
            for (int j = 0; j < 4; ++j) { const int c = 512 * j + 8 * F.lane; float h[8];
#pragma unroll
                for (int h2 = 0; h2 < 2; ++h2) { const f32x4 a0 = *(const LAS f32x4*)(VA0 + c + 4 * h2), b0 = *(const LAS f32x4*)(VB0 + c + 4 * h2);
#pragma unroll
                    for (int e = 0; e < 4; ++e) h[4 * h2 + e] = f[j][4 * h2 + e] * r2 * a0[e] + b0[e]; }
                if (IN_FP8[1]) { u32x2 w8; w8.x = pg8::pk4_fp8(h[0], h[1], h[2], h[3]); w8.y = pg8::pk4_fp8(h[4], h[5], h[6], h[7]); *(u32x2*)((unsigned char*)(F.ws + WS_H) + (size_t)row * DM + c) = w8; }
                else { u32x4 wq; wq.x = pk2(h[0], h[1]); wq.y = pk2(h[2], h[3]); wq.z = pk2(h[4], h[5]); wq.w = pk2(h[6], h[7]); *(u32x4*)(hrow + c) = wq; } } }
    }
    __syncthreads();
}

DI void qkv_prep_rows(const Frame& F, const Args& a, int layer) {
    const int gw = F.bid * NWAVES + F.wave, NGW = F.G * NWAVES;
    const bf16_t* P = (const bf16_t*)(F.ws + WS_ARENA + AR_P);
    bf16_t* QC = (bf16_t*)(F.ws + WS_ARENA + AR_QC); bf16_t* KC = (bf16_t*)(F.ws + WS_ARENA + AR_KC); bf16_t* VC = (bf16_t*)(F.ws + WS_ARENA + AR_VC);
    bf16_t* QD = (bf16_t*)(F.ws + WS_ARENA + AR_QD); bf16_t* KD = (bf16_t*)(F.ws + WS_ARENA + AR_KD); bf16_t* VD = (bf16_t*)(F.ws + WS_ARENA + AR_VD);
    const int hh = F.lane >> 4, lp = F.lane & 15, ax = lp >> 3, second = (lp >> 2) & 1, d0 = 8 * lp;
    float invf[8], gq[8], gk[8];
#pragma unroll
    for (int j = 0; j < 8; ++j) { invf[j] = exp2f(-(float)((lp & 3) * 8 + j) * (13.287712379549449f / 32.0f)); gq[j] = AIN(19)[(layer * 2 + 0) * 128 + d0 + j]; gk[j] = AIN(19)[(layer * 2 + 1) * 128 + d0 + j]; }
    u32x4 nq_c, nk_c, nq_d, nk_d;
    { const bf16_t* Pr = P + (size_t)gw * PC; nq_c = *(const u32x4*)(Pr + C_CQ + 8 * F.lane); nk_c = *(const u32x4*)(Pr + C_CK + 8 * F.lane); nq_d = *(const u32x4*)(Pr + C_DQ + 8 * F.lane); nk_d = *(const u32x4*)(Pr + C_DK + 8 * F.lane); }
#pragma unroll 1
    for (int row = gw; row < RT; row += NGW) {
        const bool lat = row < RL; int b, t, kidx;
        if (lat) { b = row >> 11; t = row & 2047; kidx = CTXL + t; } else { const int rr = row - RL; b = rr >> 8; t = rr & 255; kidx = t; }
        const u32x4 wq_c = nq_c, wk_c = nk_c, wq_d = nq_d, wk_d = nk_d;
        if (row + NGW < RT) { const bf16_t* Pr = P + (size_t)(row + NGW) * PC; nq_c = *(const u32x4*)(Pr + C_CQ + 8 * F.lane); nk_c = *(const u32x4*)(Pr + C_CK + 8 * F.lane); nq_d = *(const u32x4*)(Pr + C_DQ + 8 * F.lane); nk_d = *(const u32x4*)(Pr + C_DK + 8 * F.lane); }
        float cs[8], sn[8];
        { const float pos = (float)(ax == 0 ? (t >> 6) : (t & 63));
#pragma unroll
          for (int j = 0; j < 8; ++j) { const float ang = pos * invf[j]; cs[j] = lat ? __cosf(ang) : 1.0f; sn[j] = lat ? __sinf(ang) : 0.0f; } }
#define QK_ONE(W_, NORM_, G_, OUT_) do { float x[8] = {bflo(W_.x), bfhi(W_.x), bflo(W_.y), bfhi(W_.y), bflo(W_.z), bfhi(W_.z), bflo(W_.w), bfhi(W_.w)}; \
        if (NORM_) { float ss = 0.f; _Pragma("unroll") for (int j = 0; j < 8; ++j) ss += x[j] * x[j]; DPP_ADD(ss, 0xB1); DPP_ADD(ss, 0x4E); DPP_ADD(ss, 0x141); DPP_ADD(ss, 0x140); \
            const float rs = rsqrtf(ss * (1.0f / 128.0f) + RMS_EPS); _Pragma("unroll") for (int j = 0; j < 8; ++j) x[j] = x[j] * rs * G_[j]; } \
        float o[8]; _Pragma("unroll") for (int j = 0; j < 8; ++j) { const float p = __shfl_xor(x[j], 4); o[j] = second ? (p * sn[j] + x[j] * cs[j]) : (x[j] * cs[j] - p * sn[j]); } \
        OUT_.x = pk2(o[0], o[1]); OUT_.y = pk2(o[2], o[3]); OUT_.z = pk2(o[4], o[5]); OUT_.w = pk2(o[6], o[7]); } while (0)
        u32x4 oq_c, ok_c, oq_d, ok_d;
        QK_ONE(wq_c, true, gq, oq_c); QK_ONE(wk_c, true, gk, ok_c); QK_ONE(wq_d, false, gq, oq_d); QK_ONE(wk_d, false, gk, ok_d);
#undef QK_ONE
        *(u32x4*)(QC + ((size_t)(b * 4 + hh) * KT + kidx) * 128 + d0) = oq_c; *(u32x4*)(QD + ((size_t)(b * 4 + hh) * KT + kidx) * 128 + d0) = oq_d;
        if (hh < 2) { *(u32x4*)(KC + ((size_t)(b * 2 + hh) * KT + kidx) * 128 + d0) = ok_c; *(u32x4*)(KD + ((size_t)(b * 2 + hh) * KT + kidx) * 128 + d0) = ok_d; }
        else { *(u32x4*)(VC + ((size_t)(b * 2 + hh - 2) * KT + kidx) * 128 + d0) = wk_c; *(u32x4*)(VD + ((size_t)(b * 2 + hh - 2) * KT + kidx) * 128 + d0) = wk_d; }
    }
}


DI float expm1_neg(float x) {
    const float p = x * (1.0f + x * (0.5f + x * (0.16666667f + x * (0.041666668f + x * (0.0083333338f + x * 0.0013888889f)))));
    return x > -0.25f ? p : __expf(x) - 1.0f;
}
DI void lru_gate_weights(const Frame& F, int layer, int hd) {
    const int h = hd >> 1, d = hd & 1; LAS unsigned char* wl = F.lds + 34816; const bf16_t* LRUW = (const bf16_t*)(F.ws + WS_LRUW);
#pragma unroll
    for (int i = 0; i < 8; ++i) { const int idx = F.tid + i * NTHR; const int g = idx >> 11, rem = idx & 2047, o = rem >> 4, ch = rem & 15;
        *(LAS u32x4*)(wl + g * 34816 + o * 272 + ch * 16) = *(const u32x4*)(LRUW + ((size_t)((layer * 2 + d) * 2 + g) * 4 + h) * 16384 + o * 128 + ch * 8); }
    if (F.tid < 128) { LAS float* vb = (LAS float*)(F.lds + 34816 + 2 * 34816); const int cc = (layer * 2 + d) * 512 + h * 128 + F.tid;
        vb[F.tid] = AIN(12)[cc]; vb[128 + F.tid] = AIN(14)[cc]; vb[256 + F.tid] = ((const float*)(F.ws + WS_SP))[cc]; }
}
DI void lru_gate_rows(const Frame& F, int unit, u32x2 (&raw)[11]) {
    const int tile = unit >> 3, h = (unit & 7) >> 1; int segrow0, seglen, t0;
    if (tile < 128) { const int b = tile >> 4; t0 = (tile & 15) * 128; segrow0 = b * SEQ; seglen = SEQ; } else { const int tt = tile - 128; const int b = tt >> 1; t0 = (tt & 1) * 128; segrow0 = RL + b * CTXL; seglen = CTXL; }
    const bf16_t* P = (const bf16_t*)(F.ws + WS_ARENA + AR_P); const int c4 = F.tid & 31, tr = F.tid >> 5; const int ch = h * 128 + 4 * c4;
#pragma unroll
    for (int i = 0; i < 11; ++i) { const int ti = t0 + tr * 8 - 2 + i; raw[i] = (u32x2){0u, 0u}; if (ti >= 0 && ti < seglen) raw[i] = *(const u32x2*)(P + (size_t)(segrow0 + ti) * PC + C_AX + ch); }
}
DI void lru_gate_unit(const Frame& F, const Args& a, int layer, int unit, u32x2 (&raw)[11], int next_unit) {
    const int tile = unit >> 3, h = (unit & 7) >> 1, d = unit & 1;
    int segrow0, seglen, t0;
    if (tile < 128) { const int b = tile >> 4; t0 = (tile & 15) * 128; segrow0 = b * SEQ; seglen = SEQ; } else { const int tt = tile - 128; const int b = tt >> 1; t0 = (tt & 1) * 128; segrow0 = RL + b * CTXL; seglen = CTXL; }
    const bf16_t* P = (const bf16_t*)(F.ws + WS_ARENA + AR_P);
    LAS unsigned char* ub = F.lds;
    LAS unsigned char* wl = F.lds + 34816;
    { const int c4 = F.tid & 31, tr = F.tid >> 5; const int ch = h * 128 + 4 * c4;
      f32x4 w[4];
#pragma unroll
      for (int j = 0; j < 4; ++j) w[j] = *(const f32x4*)(AIN(9) + (size_t)(layer * 4 + j) * 512 + ch);
      const f32x4 cb = *(const f32x4*)(AIN(10) + layer * 512 + ch);
      f32x4 x[11];
#pragma unroll
      for (int i = 0; i < 11; ++i) x[i] = (f32x4){bflo(raw[i].x), bfhi(raw[i].x), bflo(raw[i].y), bfhi(raw[i].y)};
#pragma unroll
      for (int tk = 0; tk < 8; ++tk) { f32x4 u = cb;
#pragma unroll
          for (int j = 0; j < 4; ++j) u += w[j] * x[tk + j];
          const int r = tr * 8 + tk; u32x2 pw; pw.x = pk2(u.x, u.y); pw.y = pk2(u.z, u.w); *(LAS u32x2*)(ub + r * 272 + 8 * c4) = pw; } }
    __syncthreads();
    if (next_unit < 1152) lru_gate_rows(F, next_unit, raw);
    const int fr = F.lane & 15, fq = F.lane >> 4, w16 = F.wave * 16;
    bf16x8 af[4];
#pragma unroll
    for (int ks = 0; ks < 4; ++ks) af[ks] = *(const LAS bf16x8*)(ub + (w16 + fr) * 272 + (ks * 32 + fq * 8) * 2);
    unsigned* LAB = (unsigned*)(F.ws + WS_ARENA + AR_LA);
#pragma unroll 4
    for (int nb = 0; nb < 8; ++nb) {
        f32x4 ar = {0.f, 0.f, 0.f, 0.f}, ai = {0.f, 0.f, 0.f, 0.f};
#pragma unroll
        for (int ks = 0; ks < 4; ++ks) { const bf16x8 wr = *(const LAS bf16x8*)(wl + (nb * 16 + fr) * 272 + (ks * 32 + fq * 8) * 2), wi = *(const LAS bf16x8*)(wl + 34816 + (nb * 16 + fr) * 272 + (ks * 32 + fq * 8) * 2);
            ar = MFMA16(wr, af[ks], ar); ai = MFMA16(wi, af[ks], ai); }
        const int c = nb * 16 + 4 * fq; const LAS float* vb = (const LAS float*)(F.lds + 34816 + 2 * 34816); const f32x4 vbr = *(const LAS f32x4*)(vb + c), vbi = *(const LAS f32x4*)(vb + 128 + c), vl = *(const LAS f32x4*)(vb + 256 + c);
        const u32x2 uw = *(const LAS u32x2*)(ub + (w16 + fr) * 272 + c * 2); const float uu[4] = {bflo(uw.x), bfhi(uw.x), bflo(uw.y), bfhi(uw.y)};
        f32x4 oa, ob;
#pragma unroll
        for (int j = 0; j < 4; ++j) { const float r = __builtin_amdgcn_rcpf(1.0f + __expf(-(ar[j] + vbr[j]))), ii = __builtin_amdgcn_rcpf(1.0f + __expf(-(ai[j] + vbi[j])));
            const float la = -8.0f * r * vl[j]; const float om = -expm1_neg(la);
            oa[j] = om; ob[j] = __builtin_amdgcn_sqrtf(om * (2.0f - om)) * (ii * uu[j]); }
        const size_t o = ((size_t)d * RT + segrow0 + t0 + w16 + fr) * 512 + h * 128 + c;
        *(u32x4*)(LAB + o) = (u32x4){pk2(oa[0], ob[0]), pk2(oa[1], ob[1]), pk2(oa[2], ob[2]), pk2(oa[3], ob[3])};
    }
    __syncthreads();
}

DI float log_sigmoidf_(float x) { const float e = __expf(-fabsf(x)); const float l1p = e < 1e-3f ? e * (1.0f - 0.5f * e) : __logf(1.0f + e); return fminf(x, 0.f) - l1p; }
DI void gla_a_unit(const Frame& F, const Args& a, int layer, int unit) {
    const int cg = unit >> 2, head = unit & 3; int b, row0, cc;
    if (cg < 256) { b = cg >> 5; const int ci = cg & 31; row0 = b * SEQ + ci * 64; cc = 4 + ci; } else { const int cx = cg - 256; b = cx >> 2; const int ci = cx & 3; row0 = RL + b * CTXL + ci * 64; cc = ci; }
    const bf16_t* P = (const bf16_t*)(F.ws + WS_ARENA + AR_P);
    LAS unsigned char* L = F.lds;
    LAS unsigned char* QR = L; LAS unsigned char* KR = L + 8192; LAS float* ZF = (LAS float*)(L + 16384); LAS float* ZB = (LAS float*)(L + 20480); LAS float* TOT = (LAS float*)(L + 24576);
    LAS unsigned char* QE = L + 28672; LAS unsigned char* KE = QE + 2 * 9216; LAS unsigned char* KD = KE + 2 * 9216; LAS unsigned char* VI = KD + 2 * 9216;
    { const int t = F.tid >> 3, c8 = (F.tid & 7) * 8; const bf16_t* pr = P + (size_t)(row0 + t) * PC;
      *(LAS u32x4*)(QR + t * 128 + c8 * 2) = *(const u32x4*)(pr + C_BQ + head * 64 + c8); *(LAS u32x4*)(KR + t * 128 + c8 * 2) = *(const u32x4*)(pr + C_BK + head * 64 + c8);
      const int c16 = (F.tid & 7) * 16; *(LAS u32x4*)(VI + t * 272 + c16 * 2) = *(const u32x4*)(pr + C_BV + head * 128 + c16); *(LAS u32x4*)(VI + t * 272 + c16 * 2 + 16) = *(const u32x4*)(pr + C_BV + head * 128 + c16 + 8);
      if (F.tid < 256) { const int tz = F.tid >> 2, q4 = (F.tid & 3) * 4; const bf16_t* pz = P + (size_t)(row0 + tz) * PC; const u32x2 zf = *(const u32x2*)(pz + C_ZF + q4), zb = *(const u32x2*)(pz + C_ZB + q4);
          *(LAS f32x4*)(ZF + tz * 16 + q4) = (f32x4){bflo(zf.x), bfhi(zf.x), bflo(zf.y), bfhi(zf.y)}; *(LAS f32x4*)(ZB + tz * 16 + q4) = (f32x4){bflo(zb.x), bfhi(zb.x), bflo(zb.y), bfhi(zb.y)}; } }
    __syncthreads();
    const int j = F.tid & 63, grp = F.tid >> 6;
    float cf[8], cb[8];
    { float wf[16], wb[16];
#pragma unroll
      for (int r = 0; r < 16; ++r) { wf[r] = AIN(16)[((size_t)(layer * 2 + 0) * 16 + r) * 256 + head * 64 + j]; wb[r] = AIN(16)[((size_t)(layer * 2 + 1) * 16 + r) * 256 + head * 64 + j]; }
      const float b2f = AIN(17)[(layer * 2 + 0) * 256 + head * 64 + j], b2b = AIN(17)[(layer * 2 + 1) * 256 + head * 64 + j];
#pragma unroll
      for (int tk = 0; tk < 8; ++tk) { const int t = grp * 8 + tk; float xf = b2f, xb = b2b;
#pragma unroll
          for (int r4 = 0; r4 < 4; ++r4) { const f32x4 zf = *(const LAS f32x4*)(ZF + t * 16 + 4 * r4), zb = *(const LAS f32x4*)(ZB + t * 16 + 4 * r4);
              xf += (zf.x * wf[4 * r4] + zf.y * wf[4 * r4 + 1]) + (zf.z * wf[4 * r4 + 2] + zf.w * wf[4 * r4 + 3]); xb += (zb.x * wb[4 * r4] + zb.y * wb[4 * r4 + 1]) + (zb.z * wb[4 * r4 + 2] + zb.w * wb[4 * r4 + 3]); }
          cf[tk] = log_sigmoidf_(xf) * (1.0f / 16.0f); cb[tk] = log_sigmoidf_(xb) * (1.0f / 16.0f); }
#pragma unroll
      for (int tk = 1; tk < 8; ++tk) cf[tk] += cf[tk - 1];
#pragma unroll
      for (int tk = 6; tk >= 0; --tk) cb[tk] += cb[tk + 1];
      TOT[(0 * 8 + grp) * 64 + j] = cf[7]; TOT[(1 * 8 + grp) * 64 + j] = cb[0]; }
    __syncthreads();
    { float pf = 0.f, sb = 0.f, lastf = 0.f, lastb = 0.f;
#pragma unroll
      for (int g = 0; g < 8; ++g) { const float tf = TOT[(0 * 8 + g) * 64 + j], tb = TOT[(1 * 8 + g) * 64 + j]; lastf += tf; lastb += tb; pf += (g < grp) ? tf : 0.f; sb += (g > grp) ? tb : 0.f; }
      bf16_t* GQE = (bf16_t*)(F.ws + WS_ARENA + AR_GQE);
#pragma unroll
      for (int tk = 0; tk < 8; ++tk) { const int t = grp * 8 + tk; const float cumf = pf + cf[tk], cumb = sb + cb[tk];
          const float q = bf2f(*(const LAS unsigned short*)(QR + t * 128 + j * 2)) * 0.125f, k = bf2f(*(const LAS unsigned short*)(KR + t * 128 + j * 2));
          const unsigned qef = f2bf(q * __expf(cumf)), qeb = f2bf(q * __expf(cumb));
          *(LAS unsigned short*)(QE + t * 144 + j * 2) = (unsigned short)qef; *(LAS unsigned short*)(QE + 9216 + t * 144 + j * 2) = (unsigned short)qeb;
          *(LAS unsigned short*)(KE + t * 144 + j * 2) = (unsigned short)f2bf(k * __expf(-cumf)); *(LAS unsigned short*)(KE + 9216 + t * 144 + j * 2) = (unsigned short)f2bf(k * __expf(-cumb));
          *(LAS unsigned short*)(KD + t * 144 + j * 2) = (unsigned short)f2bf(k * __expf(lastf - cumf)); *(LAS unsigned short*)(KD + 9216 + t * 144 + j * 2) = (unsigned short)f2bf(k * __expf(lastb - cumb));
          GQE[((size_t)0 * RT + row0 + t) * 256 + head * 64 + j] = (bf16_t)qef; GQE[((size_t)1 * RT + row0 + t) * 256 + head * 64 + j] = (bf16_t)qeb; }
      if (grp == 0) { float* GD = (float*)(F.ws + WS_GLAD); GD[((size_t)((b * 4 + head) * 2 + 0) * NCHUNK + cc) * 64 + j] = __expf(lastf); GD[((size_t)((b * 4 + head) * 2 + 1) * NCHUNK + cc) * 64 + j] = __expf(lastb); } }
    __syncthreads();
    const int fr = F.lane & 15, fq = F.lane >> 4, q_ = (F.lane & 15) >> 2, p_ = F.lane & 3;
    const unsigned vbase = (unsigned)(uintptr_t)VI;
    {
      const int tb = F.wave & 3, vh = F.wave >> 2;
      f32x4 oacc[4];
#pragma unroll
      for (int i = 0; i < 4; ++i) oacc[i] = (f32x4){0.f, 0.f, 0.f, 0.f};
#pragma unroll
      for (int d = 0; d < 2; ++d) {
          f32x4 st[4];
#pragma unroll
          for (int si = 0; si < 4; ++si) { st[si] = (f32x4){0.f, 0.f, 0.f, 0.f};
#pragma unroll
              for (int ks = 0; ks < 2; ++ks) { const bf16x8 ka = *(const LAS bf16x8*)(KE + d * 9216 + (16 * si + fr) * 144 + (ks * 32 + fq * 8) * 2), qb = *(const LAS bf16x8*)(QE + d * 9216 + (16 * tb + fr) * 144 + (ks * 32 + fq * 8) * 2);
                  st[si] = MFMA16(ka, qb, st[si]); }
              const int t_ = 16 * tb + fr;
#pragma unroll
              for (int jj = 0; jj < 4; ++jj) { const int s_ = 16 * si + 4 * fq + jj; const bool keep = d == 0 ? (s_ <= t_) : (s_ >= t_); st[si][jj] = keep ? st[si][jj] : 0.f; } }
#pragma unroll
          for (int kk = 0; kk < 2; ++kk) { u32x4 pw; pw.x = cvt_pk_bf16(st[2 * kk][0], st[2 * kk][1]); pw.y = cvt_pk_bf16(st[2 * kk][2], st[2 * kk][3]); pw.z = cvt_pk_bf16(st[2 * kk + 1][0], st[2 * kk + 1][1]); pw.w = cvt_pk_bf16(st[2 * kk + 1][2], st[2 * kk + 1][3]);
              const bf16x8 pa = __builtin_bit_cast(bf16x8, pw);
#pragma unroll
              for (int i = 0; i < 4; ++i) { const unsigned col = (unsigned)((vh * 4 + i) * 16 + 4 * p_) * 2u;
                  const bf16x8 vf = tr_read_pair(vbase + (unsigned)(32 * kk + 4 * fq + q_) * 272u + col, vbase + (unsigned)(32 * kk + 16 + 4 * fq + q_) * 272u + col);
                  oacc[i] = MFMA16(vf, pa, oacc[i]); } }
      }
      bf16_t* GOI = (bf16_t*)(F.ws + WS_ARENA + AR_GOI);
#pragma unroll
      for (int i = 0; i < 4; ++i) *(u32x2*)(GOI + (size_t)(row0 + 16 * tb + fr) * 512 + head * 128 + (vh * 4 + i) * 16 + 4 * fq) = (u32x2){pk2(oacc[i][0], oacc[i][1]), pk2(oacc[i][2], oacc[i][3])};
    }
    {
      bf16_t* GS = (bf16_t*)(F.ws + WS_ARENA + AR_GS);
#pragma unroll
      for (int d = 0; d < 2; ++d) {
          const unsigned kdb = (unsigned)(uintptr_t)(KD + d * 9216);
          bf16x8 va[2];
#pragma unroll
          for (int ks = 0; ks < 2; ++ks) { const unsigned a0 = vbase + (unsigned)(32 * ks + 8 * fq + q_) * 272u + (unsigned)(16 * F.wave + 4 * p_) * 2u; va[ks] = tr_read_pair(a0, a0 + 4u * 272u); }
#pragma unroll
          for (int jt = 0; jt < 4; ++jt) { bf16x8 kb[2];
#pragma unroll
              for (int ks = 0; ks < 2; ++ks) { const unsigned a0 = kdb + (unsigned)(32 * ks + 8 * fq + q_) * 144u + (unsigned)(16 * jt + 4 * p_) * 2u; kb[ks] = tr_read_pair(a0, a0 + 4u * 144u); }
              f32x4 u = {0.f, 0.f, 0.f, 0.f};
#pragma unroll
              for (int ks = 0; ks < 2; ++ks) u = MFMA16(kb[ks], va[ks], u);
              bf16_t* dst = GS + ((size_t)((b * 4 + head) * 2 + d) * NCHUNK + cc) * 8192;
              *(u32x2*)(dst + (16 * F.wave + fr) * 64 + 16 * jt + 4 * fq) = (u32x2){pk2(u[0], u[1]), pk2(u[2], u[3])}; }
      }
    }
    __syncthreads();
}

template <int STP> DI void lru_scan_dir(const unsigned* pab, unsigned* phc) {
    float h = 0.f, cp = 1.f; unsigned w0[32], w1[32];
#define LS_LOAD(W_) do { _Pragma("unroll") for (int i = 0; i < 32; ++i) W_[i] = pab[i * STP]; pab += 32 * STP; } while (0)
#define LS_STEP(W_) do { _Pragma("unroll") for (int i = 0; i < 32; ++i) { const float a_ = 1.0f - bflo(W_[i]); h = a_ * h + bfhi(W_[i]); cp *= a_; phc[i * STP] = pk2(h, cp); } phc += 32 * STP; } while (0)
    LS_LOAD(w0);
#pragma unroll 1
    for (int t = 0; t < 256; t += 64) { LS_LOAD(w1); LS_STEP(w0); if (t + 64 < 256) LS_LOAD(w0); LS_STEP(w1); }
#undef LS_LOAD
#undef LS_STEP
}
DI void lru_scan_unit(const Frame& F, int unit) {
    const int seg = unit % 9, bd = unit / 9, b = bd >> 1, d = bd & 1; const int c = F.wave * 64 + F.lane;
    const int r0 = seg == 0 ? RL + b * CTXL : b * SEQ + (seg - 1) * 256;
    const size_t base = ((size_t)d * RT + (d == 0 ? r0 : r0 + 255)) * 512 + c;
    const unsigned* pab = (const unsigned*)(F.ws + WS_ARENA + AR_LA) + base; unsigned* phc = (unsigned*)(F.ws + WS_ARENA + AR_LH) + base;
    if (d == 0) lru_scan_dir<512>(pab, phc); else lru_scan_dir<-512>(pab, phc);
}
DI void lru_final_unit(const Frame& F, int unit4) {
    const int unit = unit4 >> 2, qtr = unit4 & 3; const int b = unit / 9, seg = unit % 9; const int c = F.tid;
    const unsigned* LHC = (const unsigned*)(F.ws + WS_ARENA + AR_LH) + c;
    const bf16_t* P = (const bf16_t*)(F.ws + WS_ARENA + AR_P); bf16_t* Y = (bf16_t*)(F.ws + WS_Y);
    unsigned wf[8], wb[9];
#pragma unroll
    for (int s2 = 0; s2 < 8; ++s2) { const size_t r = (s2 == 0 ? RL + b * CTXL : b * SEQ + (s2 - 1) * 256) + 255; wf[s2] = LHC[r * 512]; }
    wb[0] = LHC[((size_t)RT + RL + b * CTXL) * 512];
#pragma unroll
    for (int s2 = 1; s2 <= 8; ++s2) wb[s2] = LHC[((size_t)RT + b * SEQ + (s2 - 1) * 256) * 512];
    float cf = 0.f, cb = 0.f;
#pragma unroll
    for (int s2 = 0; s2 < 8; ++s2) if (s2 < seg) cf = bfhi(wf[s2]) * cf + bflo(wf[s2]);
    if (seg > 0) { cb = bflo(wb[0]);
#pragma unroll
        for (int s2 = 8; s2 >= 1; --s2) if (s2 > seg) cb = bfhi(wb[s2]) * cb + bflo(wb[s2]); }
    const size_t r0 = (seg == 0 ? RL + b * CTXL : b * SEQ + (seg - 1) * 256) + qtr * 64;
    const unsigned* pf = LHC + r0 * 512; const unsigned* pb = LHC + ((size_t)RT + r0) * 512;
    const bf16_t* px = P + r0 * PC + C_AG + c; bf16_t* py = Y + r0 * DM + c;
    unsigned fa[8], ba[8], fb[8], bb[8]; unsigned short xa[8], xb[8];
#define LF_LOAD(F_, B_, X_) do { _Pragma("unroll") for (int i = 0; i < 8; ++i) { F_[i] = pf[i * 512]; B_[i] = pb[i * 512]; X_[i] = (unsigned short)px[(size_t)i * PC]; } pf += 8 * 512; pb += 8 * 512; px += (size_t)8 * PC; } while (0)
#define LF_STEP(F_, B_, X_) do { _Pragma("unroll") for (int i = 0; i < 8; ++i) { const float hf = bflo(F_[i]) + bfhi(F_[i]) * cf, hb = bflo(B_[i]) + bfhi(B_[i]) * cb; const float x = bf2f(X_[i]); \
        const float ge = x / (1.0f + __expf(-1.5957691216057308f * (x + 0.044715f * x * x * x)));        \
        py[(size_t)i * DM] = (bf16_t)f2bf((hf + hb) * ge); } py += (size_t)8 * DM; } while (0)
    LF_LOAD(fa, ba, xa);
#pragma unroll 1
    for (int t = 0; t < 64; t += 16) { LF_LOAD(fb, bb, xb); LF_STEP(fa, ba, xa); if (t + 16 < 64) LF_LOAD(fa, ba, xa); LF_STEP(fb, bb, xb); }
#undef LF_LOAD
#undef LF_STEP
}
DI int gla_cc(int d, int step) { return d == 0 ? step : (step < 4 ? 3 - step : 39 - step); }
DI void gla_b_unit(const Frame& F, int chain) {
    const int d = chain & 1; const bf16_t* GS = (const bf16_t*)(F.ws + WS_ARENA + AR_GS) + (size_t)chain * NCHUNK * 8192 + F.tid * 4; bf16_t* GSB = (bf16_t*)(F.ws + WS_ARENA + AR_GSB) + (size_t)chain * NCHUNK * 8192 + F.tid * 4; const float* GD = (const float*)(F.ws + WS_GLAD) + (size_t)chain * NCHUNK * 64 + (F.tid & 15) * 4;
    f32x4 S[4], Dv[6]; u32x2 U[6][4];
#pragma unroll
    for (int i = 0; i < 4; ++i) S[i] = (f32x4){0.f, 0.f, 0.f, 0.f};
#define GB_LOAD(slot_, step_) do { const int cc_ = gla_cc(d, (step_)); _Pragma("unroll") for (int i = 0; i < 4; ++i) U[slot_][i] = *(const u32x2*)(GS + (size_t)cc_ * 8192 + 2048 * i); Dv[slot_] = *(const f32x4*)(GD + cc_ * 64); } while (0)
#define GB_STEP(slot_, step_) do { const int cc_ = gla_cc(d, (step_)); _Pragma("unroll") for (int i = 0; i < 4; ++i) { *(u32x2*)(GSB + (size_t)cc_ * 8192 + 2048 * i) = (u32x2){pk2(S[i].x, S[i].y), pk2(S[i].z, S[i].w)}; S[i] = Dv[slot_] * S[i] + (f32x4){bflo(U[slot_][i].x), bfhi(U[slot_][i].x), bflo(U[slot_][i].y), bfhi(U[slot_][i].y)}; } } while (0)
    GB_LOAD(0, 0); GB_LOAD(1, 1); GB_LOAD(2, 2); GB_LOAD(3, 3); GB_LOAD(4, 4);
#pragma unroll 1
    for (int step = 0; step < NCHUNK; step += 6) {
        GB_LOAD(5, step + 5); GB_STEP(0, step);
        if (step + 6 < NCHUNK) GB_LOAD(0, step + 6); GB_STEP(1, step + 1);
        if (step + 7 < NCHUNK) GB_LOAD(1, step + 7); GB_STEP(2, step + 2);
        if (step + 8 < NCHUNK) GB_LOAD(2, step + 8); GB_STEP(3, step + 3);
        if (step + 9 < NCHUNK) GB_LOAD(3, step + 9); GB_STEP(4, step + 4);
        if (step + 10 < NCHUNK) GB_LOAD(4, step + 10); GB_STEP(5, step + 5);
    }
#undef GB_LOAD
#undef GB_STEP
}
DI void gla_c_unit(const Frame& F, const Args& a, int layer, int unit) {
    const int cg = unit >> 1, head = (unit & 1) * 2 + (F.wave >> 2), tb = F.wave & 3; int b, row0, cc;
    if (cg < 256) { b = cg >> 5; const int ci = cg & 31; row0 = b * SEQ + ci * 64; cc = 4 + ci; } else { const int cx = cg - 256; b = cx >> 2; const int ci = cx & 3; row0 = RL + b * CTXL + ci * 64; cc = ci; }
    const int fr = F.lane & 15, fq = F.lane >> 4;
    const bf16_t* GQE = (const bf16_t*)(F.ws + WS_ARENA + AR_GQE); const bf16_t* GSB = (const bf16_t*)(F.ws + WS_ARENA + AR_GSB); const bf16_t* GOI = (const bf16_t*)(F.ws + WS_ARENA + AR_GOI);
    const bf16_t* P = (const bf16_t*)(F.ws + WS_ARENA + AR_P); bf16_t* Y = (bf16_t*)(F.ws + WS_Y);
    f32x4 acc[8];
#pragma unroll
    for (int nt = 0; nt < 8; ++nt) acc[nt] = (f32x4){0.f, 0.f, 0.f, 0.f};
#pragma unroll
    for (int d = 0; d < 2; ++d) { const bf16_t* ST = GSB + ((size_t)((b * 4 + head) * 2 + d) * NCHUNK + cc) * 8192;
#pragma unroll
        for (int ks = 0; ks < 2; ++ks) { const bf16x8 af = *(const bf16x8*)(GQE + ((size_t)d * RT + row0 + 16 * tb + fr) * 256 + head * 64 + ks * 32 + fq * 8);
#pragma unroll
            for (int nt = 0; nt < 8; ++nt) acc[nt] = MFMA16(*(const bf16x8*)(ST + (nt * 16 + fr) * 64 + ks * 32 + fq * 8), af, acc[nt]); } }
    const size_t r = (size_t)(row0 + 16 * tb + fr);
    u32x2 gr[8], oi[8]; f32x4 gnv[8];
#pragma unroll
    for (int nt = 0; nt < 8; ++nt) { gnv[nt] = *(const f32x4*)(AIN(18) + layer * 128 + nt * 16 + 4 * fq); gr[nt] = *(const u32x2*)(P + r * PC + C_BG + head * 128 + nt * 16 + 4 * fq);
        oi[nt] = *(const u32x2*)(GOI + r * 512 + head * 128 + nt * 16 + 4 * fq); }
    float ssq = 0.f;
#pragma unroll
    for (int nt = 0; nt < 8; ++nt)
#pragma unroll
        for (int jj = 0; jj < 4; ++jj) { const unsigned ow = (jj < 2) ? oi[nt].x : oi[nt].y; acc[nt][jj] += (jj & 1) ? bfhi(ow) : bflo(ow); ssq += acc[nt][jj] * acc[nt][jj]; }
    ssq += __shfl_xor(ssq, 16); ssq += __shfl_xor(ssq, 32);
    const float rstd = rsqrtf(ssq * (1.0f / 128.0f) + RMS_EPS);
#pragma unroll
    for (int nt = 0; nt < 8; ++nt) { const float g[4] = {bflo(gr[nt].x), bfhi(gr[nt].x), bflo(gr[nt].y), bfhi(gr[nt].y)}; float y[4];
#pragma unroll
        for (int jj = 0; jj < 4; ++jj) y[jj] = acc[nt][jj] * rstd * gnv[nt][jj] * siluf_(g[jj]);
        *(u32x2*)(Y + r * DM + 512 + head * 128 + nt * 16 + 4 * fq) = (u32x2){pk2(y[0], y[1]), pk2(y[2], y[3])}; }
}
DI void scan_attn_phase(const Frame& F, const Args& a, int layer, bool need_ctx, int rep) {
    volatile LAS unsigned* qw = (volatile LAS unsigned*)(F.lds + MISC_OFF + 64);
    unsigned* head = F.ctl + CW_QUEUE + 64 * (layer + 2 * rep);
    const int n_units = 256 + 256 + (need_ctx ? 64 : 0);
    const bf16_t* QC = (const bf16_t*)(F.ws + WS_ARENA + AR_QC); const bf16_t* KC = (const bf16_t*)(F.ws + WS_ARENA + AR_KC); const bf16_t* VC = (const bf16_t*)(F.ws + WS_ARENA + AR_VC);
    const bf16_t* QD = (const bf16_t*)(F.ws + WS_ARENA + AR_QD); const bf16_t* KD = (const bf16_t*)(F.ws + WS_ARENA + AR_KD); const bf16_t* VD = (const bf16_t*)(F.ws + WS_ARENA + AR_VD);
    bf16_t* Y = (bf16_t*)(F.ws + WS_Y);
    for (int u = F.bid; u < 208; u += F.G) { if (u < 64) { if (rep == 0) gla_b_unit(F, u); } else lru_scan_unit(F, u - 64); }
    if (F.bid < 208 && rep == 0) { asm volatile("s_waitcnt vmcnt(0)" ::: "memory"); __syncthreads();
        if (F.tid == 0) { __builtin_amdgcn_fence(__ATOMIC_RELEASE, "agent"); asm volatile("s_waitcnt vmcnt(0)" ::: "memory"); (void)xb_add(F.ctl + CW_QUEUE + 64 * (4 + layer), 1u); } }
    for (;;) {
        __syncthreads();
        if (F.tid == 0) qw[0] = __hip_atomic_fetch_add(head, 1u, __ATOMIC_RELAXED, __HIP_MEMORY_SCOPE_AGENT);
        __syncthreads();
        int u = (int)qw[0]; if (u >= n_units) break;
        { int b, h, qoff, yrow, ycol, NT = 4, skip = 0, q0 = 0; bool win = false, sink = false, isD = false;
          if (u < 256) { b = u >> 5; h = (u >> 3) & 3; const int qb = u & 7; qoff = CTXL + 256 * qb; yrow = b * SEQ + 256 * qb; NT = KT / 64; }
          else if (u < 512) { u -= 256; b = u >> 5; h = (u >> 3) & 3; const int qb = u & 7; const int bs = qb == 0 ? 0 : 256 * qb - 128, be = qb == 7 ? SEQ : 256 * qb + 384;
              qoff = CTXL + 256 * qb; yrow = b * SEQ + 256 * qb; NT = 4 + (be - bs) / 64; skip = bs; q0 = 256 * qb; win = true; sink = true; isD = true; }
          else if (u < 544) { u -= 512; b = u >> 2; h = u & 3; qoff = 0; yrow = RL + b * CTXL; }
          else { u -= 544; b = u >> 2; h = u & 3; qoff = 0; yrow = RL + b * CTXL; sink = true; isD = true; }
          ycol = (isD ? 1536 : 1024) + h * 128;
          const bf16_t* Qp = (isD ? QD : QC) + ((size_t)(b * 4 + h) * KT + qoff) * 128; const bf16_t* Kp = (isD ? KD : KC) + (size_t)(b * 2 + (h >> 1)) * KT * 128; const bf16_t* Vp = (isD ? VD : VC) + (size_t)(b * 2 + (h >> 1)) * KT * 128;
          att::attn_body(Qp, Kp, Vp, Y + (size_t)yrow * DM + ycol, NT, skip, q0, AIN(20)[layer * 4 + h], win, sink, (char*)F.lds, F.tid); }
    }
}

#ifndef LAST_PHASE
#define LAST_PHASE 21
#endif
constexpr int PH_PER_LAYER = 10, N_PHASES = 2 + NLAYER * PH_PER_LAYER;

#define PHASE_BEGIN() do { int w_s = wave_s; asm volatile("" : "+s"(w_s)); unsigned z_ = 0u; asm volatile("" : "+s"(z_)); int t_ = w_s * 64 + (int)__builtin_amdgcn_mbcnt_hi(~0u, __builtin_amdgcn_mbcnt_lo(~0u, z_)); asm volatile("" : "+v"(t_)); F.tid = t_; F.lane = t_ & 63; F.wave = w_s; \
        unsigned long long zo_ = 0ull; asm volatile("" : "+s"(zo_)); F.ws = args.ws + zo_; F.ctl = (unsigned*)(F.ws + WS_CTL);       int b_ = blockIdx.x; asm volatile("" : "+s"(b_)); F.bid = b_; } while (0)
#ifndef PH_MASK
#define PH_MASK 0xFFF
#endif
#define PHON(t) (((PH_MASK) >> (t)) & 1)
#ifndef DUP_MASK
#define DUP_MASK 0
#endif
#define NREP(t) (1 + (((DUP_MASK) >> (t)) & 1))
#define IN(k) ((k) <= LAST_PHASE)
#define SEAM(k) do { if ((k) < LAST_PHASE) { XcdBarrier b2_; b2_.bar = F.ctl + CW_BAR; b2_.x = (unsigned)__builtin_amdgcn_readfirstlane((int)xb_xcc_id()); b2_.st = (volatile LAS unsigned*)(F.lds + MISC_OFF) + 8; xcd_barrier(b2_, F.tid); } } while (0)
#define XL (args.out)
#define XLB ((bf16_t*)(F.ws + WS_ARENA + AR_XLB))
#define XCB ((bf16_t*)(F.ws + WS_XC))
#define H ((bf16_t*)(F.ws + WS_H))
#define Y ((bf16_t*)(F.ws + WS_Y))
#define P ((bf16_t*)(F.ws + WS_ARENA + AR_P))
template <int layer> DI void run_layer(Frame& F, const Args& args, const int wave_s) {
    constexpr bool F8 = MOE_FP8[layer]; constexpr bool G2F8 = MOE2_FP8[layer];
        const int pb = 2 + layer * PH_PER_LAYER; const bool need_ctx = layer < NLAYER - 1; const int ntok = need_ctx ? RT : RL;
        if (PHON(2) && IN(pb + 0)) { PHASE_BEGIN(); for (int rep = 0; rep < NREP(2); ++rep) {
            pg8::DenseSched S; S.T.init(RT / 256, PC / 256, F.G, F.bid);
            pg8::EpiBf16 E{P, PC, IN_FP8[layer] ? 1.0f / SW_IN : 1.0f};
            if constexpr (IN_FP8[layer]) pg8::gemm_phase<DM, 1, 2, SP2_FP8>(F.tid, F.lds, H, (const bf16_t*)(F.ws + WS_WIN) + (size_t)layer * PC * DM, nullptr, S, E);
            else pg8::gemm_phase<DM, 2, 0, SP2_BF16>(F.tid, F.lds, H, (const bf16_t*)(F.ws + WS_WIN) + (size_t)layer * PC * DM, nullptr, S, E);
            } SEAM(pb + 0);
        }
        if (PHON(3) && IN(pb + 1)) { PHASE_BEGIN(); for (int rep = 0; rep < NREP(3); ++rep) {
            for (int r2 = 0; r2 < NREP(12); ++r2) qkv_prep_rows(F, args, layer);
            __syncthreads();
            for (int r2 = 0; r2 < NREP(13); ++r2) { lru_gate_weights(F, layer, F.bid & 7); u32x2 graw[11]; lru_gate_rows(F, F.bid, graw); for (int u = F.bid; u < 1152; u += F.G) lru_gate_unit(F, args, layer, u, graw, u + F.G); }
            for (int r2 = 0; r2 < NREP(14); ++r2) for (int u = (F.bid + 128) & 255; u < 1152; u += F.G) gla_a_unit(F, args, layer, u);
            } SEAM(pb + 1);
        }
        if (PHON(4) && IN(pb + 2)) { PHASE_BEGIN(); scan_attn_phase(F, args, layer, need_ctx, 0); if (NREP(4) == 2) { __syncthreads(); scan_attn_phase(F, args, layer, need_ctx, 1); } }
        if (PHON(5) && IN(pb + 3)) { PHASE_BEGIN();
            { const int ngc = need_ctx ? 576 : 512, nlf = need_ctx ? 288 : 256;
              volatile LAS unsigned* qw = (volatile LAS unsigned*)(F.lds + MISC_OFF + 64); unsigned* head = F.ctl + CW_QUEUE + 64 * (6 + layer);
              __syncthreads();
              if (F.tid == 0) { unsigned* cnt = F.ctl + CW_QUEUE + 64 * (4 + layer); unsigned* bar = F.ctl + CW_BAR; XB_SPIN(xb_ld(cnt) < 208u, bar);
                  __builtin_amdgcn_fence(__ATOMIC_ACQUIRE, "agent"); asm volatile("s_waitcnt vmcnt(0)" ::: "memory"); }
              for (;;) {
                  __syncthreads();
                  if (F.tid == 0) qw[0] = __hip_atomic_fetch_add(head, 1u, __ATOMIC_RELAXED, __HIP_MEMORY_SCOPE_AGENT);
                  __syncthreads();
                  const int u = (int)qw[0]; if (u >= ngc + nlf) break;
                  if (u < ngc) gla_c_unit(F, args, layer, u);
                  else { const int v = u - ngc; lru_final_unit(F, need_ctx ? v : (((v >> 5) * 9 + 1 + ((v >> 2) & 7)) * 4 + (v & 3))); } } }
            SEAM(pb + 3);
        }
        if (PHON(6) && IN(pb + 4)) { PHASE_BEGIN(); for (int rep = 0; rep < NREP(6); ++rep) {
            pg8::DenseSched S; S.T.init(ntok / 256, DM / 256, F.G, F.bid);
            pg8::EpiBf16 E{(bf16_t*)(F.ws + WS_ARENA + AR_YO), DM, 1.0f};
            pg8::gemm_phase<DM, 2, 0, SP2_BF16>(F.tid, F.lds, Y, (const bf16_t*)(F.ws + WS_WOUT) + (size_t)layer * DM * DM, nullptr, S, E);
            } SEAM(pb + 4);
        }
        if (PHON(7) && IN(pb + 5)) { PHASE_BEGIN(); postmix_phase<F8, layer != 0>(F, args, layer, layer == 0 ? (const void*)AIN(0) : (const void*)XLB, layer == 0 ? (const void*)AIN(2) : (const void*)XCB, XLB, XCB, ntok); if (layer == 0 && NREP(7) == 2) postmix_phase<F8, false>(F, args, layer, AIN(0), AIN(2), XLB, XCB, ntok); SEAM(pb + 5); }
        if (PHON(8) && IN(pb + 6)) { PHASE_BEGIN(); for (int rep = 0; rep < NREP(8); ++rep) { slots_phase(F, layer, ntok, F8 ? DM : DM * 2); } SEAM(pb + 6); }
        if (PHON(9) && IN(pb + 7)) { PHASE_BEGIN(); for (int rep = 0; rep < NREP(9); ++rep) {
            const LAS unsigned short* tile_e = (const LAS unsigned short*)(F.lds + TBL_OFF); const int nrt = (int)((LAS unsigned*)(F.lds + TBL_OFF + 2816))[0];
            pg8::MoeSched S; S.T.init(nrt + ntok / 256, 4, F.G, F.bid); S.tile_e = tile_e;
            pg8::EpiSwiGlu<G2F8> E{(void*)(F.ws + WS_ARENA + AR_ACT), F8 ? 1.0f / SW_GU : 1.0f, G2F8 ? S_ACT : 1.0f};
            LAS unsigned short* lrows = (LAS unsigned short*)(F.lds + LROWS_OFF);
            { const unsigned* ROWOFF = (const unsigned*)(F.ws + WS_META + MT_ROWOFF); pg8::Unit uu;
              for (int i = 0; i < 12 && S.next(i, uu); ++i) if (F.tid < 256) lrows[i * 256 + F.tid] = (unsigned short)(ROWOFF[uu.pm * 256 + F.tid] / (unsigned)(F8 ? DM : DM * 2));
              __syncthreads(); }
            pg8::gemm_phase<DM, F8 ? 1 : 2, 1, SP2_FP8>(F.tid, F.lds, H, (const bf16_t*)(F.ws + WS_WGU + (size_t)layer * 65 * 1024 * DM * 2), lrows, S, E);
            } SEAM(pb + 7);
        }
        if (PHON(10) && IN(pb + 8)) { PHASE_BEGIN(); for (int rep = 0; rep < NREP(10); ++rep) {
            const LAS unsigned short* tile_e = (const LAS unsigned short*)(F.lds + TBL_OFF); const int nrt = (int)((LAS unsigned*)(F.lds + TBL_OFF + 2816))[0];
            pg8::MoeSched S; S.T.init(nrt + ntok / 256, 8, F.G, F.bid); S.tile_e = tile_e;
            pg8::EpiFp8 E{(unsigned char*)(F.ws + WS_ARENA + AR_MO), DM, G2F8 ? S_MO / (S_ACT * SW_D) : S_MO};
            if constexpr (G2F8) pg8::gemm_phase<EH, 1, 2, SP2_FP8>(F.tid, F.lds, (const bf16_t*)(F.ws + WS_ARENA + AR_ACT), (const bf16_t*)(F.ws + WS_WD + (size_t)layer * 65 * DM * EH * 2), nullptr, S, E);
            else pg8::gemm_phase<EH, 2, 0, SP2_BF16>(F.tid, F.lds, (const bf16_t*)(F.ws + WS_ARENA + AR_ACT), (const bf16_t*)(F.ws + WS_WD + (size_t)layer * 65 * DM * EH * 2), nullptr, S, E);
            } SEAM(pb + 8);
        }
        if (PHON(11) && IN(pb + 9)) { PHASE_BEGIN();
            combine_phase_ol(F.ws, F.tid, F.wave, F.bid, layer, XL, ntok, need_ctx ? 1 : 0);
            SEAM(pb + 9);
        }
    }

__global__ void __launch_bounds__(NTHR, 2) fwd_kernel(Args args) {
    extern __shared__ __attribute__((aligned(16))) unsigned char lds_raw[];
    Frame F;
    F.lds = (LAS unsigned char*)lds_raw; F.ws = args.ws; F.ctl = (unsigned*)(F.ws + WS_CTL);
    F.tid = threadIdx.x; F.lane = F.tid & 63; F.wave = __builtin_amdgcn_readfirstlane(F.tid >> 6); F.bid = blockIdx.x;
    volatile LAS unsigned* MISC = (volatile LAS unsigned*)(F.lds + MISC_OFF);
    const int wave_s = F.wave;
    if (F.tid < 64) MISC[F.tid] = 0u;
    if (F.tid == 0) { LAS unsigned long long* tb = (LAS unsigned long long*)(F.lds + PTR_OFF);
#pragma unroll
        for (int i = 0; i < 29; ++i) tb[i] = (unsigned long long)args.in[i]; }
    __syncthreads();
    (void)xcd_barrier_post(F.ctl + CW_BAR, MISC + 8);
    if (PHON(0) && IN(0)) { PHASE_BEGIN(); p0_mod(F, args); for (int rep = 0; rep < NREP(0); ++rep) { p0_convert(F, args); p0_convert_fast(F); } }
    if (PHON(1) && IN(1)) { PHASE_BEGIN();
        __syncthreads();
        if (F.tid == 0) { unsigned* cnt = F.ctl + CW_QUEUE + 64 * 8; unsigned* bar = F.ctl + CW_BAR; XB_SPIN(xb_ld(cnt) < 32u, bar); __builtin_amdgcn_fence(__ATOMIC_ACQUIRE, "agent"); asm volatile("s_waitcnt vmcnt(0)" ::: "memory"); }
        __syncthreads();
        for (int rep = 0; rep < NREP(1); ++rep) pre_rows(F, args, 0, AIN(0), AIN(2), RT); SEAM(1); }
    run_layer<0>(F, args, wave_s);
    run_layer<1>(F, args, wave_s);
}
#undef IN
#undef SEAM
#undef XL
#undef XLB
#undef XCB
#undef H
#undef Y
#undef P

extern "C" void kernel_launch(void* const* d_in, const int* in_sizes, int n_in, void* d_out, int out_size, void* d_ws, size_t ws_size, hipStream_t stream) {
    static int grid = 0;
    if (grid == 0) {
        if (n_in != 29 || out_size != RL * DM || ws_size < WS_END) { fprintf(stderr, "kernel_launch: unexpected shapes / workspace (n_in %d out %d ws %zu need %zu)\n", n_in, out_size, ws_size, (size_t)WS_END); grid = -1; return; }
        int dev = 0, cus = 0, per_cu = 0;
        if (hipGetDevice(&dev) != hipSuccess || hipDeviceGetAttribute(&cus, hipDeviceAttributeMultiprocessorCount, dev) != hipSuccess) { grid = -1; return; }
        if (hipFuncSetAttribute((const void*)fwd_kernel, hipFuncAttributeMaxDynamicSharedMemorySize, LDS_BYTES) != hipSuccess) { fprintf(stderr, "kernel_launch: hipFuncSetAttribute failed\n"); grid = -1; return; }
        if (hipOccupancyMaxActiveBlocksPerMultiprocessor(&per_cu, (const void*)fwd_kernel, NTHR, LDS_BYTES) != hipSuccess || per_cu < 1) { fprintf(stderr, "kernel_launch: occupancy query reports %d\n", per_cu); }
        (void)hipGetLastError();
        if (cus < 256) { fprintf(stderr, "kernel_launch: this kernel needs 256 CUs (one resident workgroup each), device has %d\n", cus); grid = -1; return; }
        grid = 256;
    }
    if (grid < 0) return;
    (void)hipMemsetAsync((char*)d_ws + WS_CTL, 0, 1 * MiB, stream);
    Args a{};
    for (int i = 0; i < 29; ++i) a.in[i] = (const float*)d_in[i];
    a.out = (float*)d_out; a.ws = (unsigned char*)d_ws;
    a.ph_lo = 0; a.ph_hi = N_PHASES;
    hipLaunchKernelGGL(fwd_kernel, dim3(grid), dim3(NTHR), LDS_BYTES, stream, a);
    const hipError_t le = hipPeekAtLastError();
    if (le != hipSuccess) fprintf(stderr, "kernel_launch: launch failed: %s\n", hipGetErrorName(le));
}
```

```cpp
#include <hip/hip_runtime.h>
#include <cstdio>
#include <cstdint>

#define LAS __attribute__((address_space(3)))
#define GAS __attribute__((address_space(1)))
typedef unsigned short bf16_t;
typedef short bf16x8 __attribute__((ext_vector_type(8)));
typedef short s16x4 __attribute__((ext_vector_type(4)));
typedef float f32x4 __attribute__((ext_vector_type(4)));
typedef float f32x2 __attribute__((ext_vector_type(2)));
typedef float f32x16 __attribute__((ext_vector_type(16)));
typedef unsigned u32x4 __attribute__((ext_vector_type(4)));
typedef unsigned u32x2 __attribute__((ext_vector_type(2)));
#define DI __device__ __forceinline__

constexpr int DM = 2048, NB = 8, SEQ = 2048, CTXL = 256, NLAYER = 2;
constexpr int RL = NB * SEQ;
constexpr int RC = NB * CTXL;
constexpr int RT = RL + RC;
constexpr int INC = 4640;
constexpr int PC = 4864;
constexpr int C_AX = 0, C_AG = 512, C_BQ = 1024, C_BK = 1280, C_BV = 1536, C_BG = 2048, C_CQ = 2560, C_CK = 3072, C_CV = 3328, C_DQ = 3584, C_DK = 4096, C_DV = 4352, C_ZF = 4608, C_ZB = 4624;
constexpr int NEXP = 64, EH = 512, TOPK = 8;
#ifndef MOE_FP8_L0
#define MOE_FP8_L0 1
#endif
#ifndef MOE_FP8_L1
#define MOE_FP8_L1 1
#endif
constexpr bool MOE_FP8[2] = {MOE_FP8_L0 != 0, MOE_FP8_L1 != 0};
#ifndef MOE2_FP8_L0
#define MOE2_FP8_L0 1
#endif
#ifndef MOE2_FP8_L1
#define MOE2_FP8_L1 1
#endif
constexpr bool MOE2_FP8[2] = {MOE2_FP8_L0 != 0, MOE2_FP8_L1 != 0};
#ifndef IN1_FP8
#define IN1_FP8 1
#endif
#ifndef IN0_FP8
#define IN0_FP8 1
#endif
constexpr bool IN_FP8[2] = {IN0_FP8 != 0, IN1_FP8 != 0};
constexpr float SW_IN = 64.f;
#ifndef SP2_FP8
#define SP2_FP8 true
#endif
#ifndef SP2_BF16
#define SP2_BF16 true
#endif
constexpr float SW_GU = 64.f, SW_D = 32.f, S_ACT = 4.f, S_MO = 16.f;
constexpr int KT = SEQ + CTXL;
constexpr float RMS_EPS = 1e-6f;
constexpr int NCHUNK = KT / 64;

constexpr size_t MiB = 1u << 20;
constexpr size_t WS_CTL = 0;
constexpr size_t WS_MOD = 1 * MiB;
constexpr size_t WS_META = 2 * MiB;
constexpr size_t WS_GLAD = 10 * MiB;
constexpr size_t WS_SP = 10 * MiB + 768 * 1024;
constexpr size_t WS_ROWID = 9 * MiB;
constexpr size_t WS_RWS = 8 * MiB;
constexpr size_t WS_LRUW = 11 * MiB;
constexpr size_t WS_WIN = 12 * MiB;
constexpr size_t WS_WOUT = 50 * MiB;
constexpr size_t WS_WGU = 66 * MiB;
constexpr size_t WS_WD = 586 * MiB;
constexpr size_t WS_XC = 846 * MiB;
constexpr size_t WS_H = 862 * MiB;
constexpr size_t WS_Y = 934 * MiB;
constexpr size_t WS_ARENA = 1006 * MiB;
constexpr size_t AR_P = 0;
constexpr size_t AR_QC = 171 * MiB, AR_KC = 189 * MiB, AR_VC = 198 * MiB, AR_QD = 207 * MiB, AR_KD = 225 * MiB, AR_VD = 234 * MiB;
constexpr size_t AR_LA = 243 * MiB, AR_LB = 315 * MiB, AR_LH = 387 * MiB;
constexpr size_t AR_GS = 459 * MiB;
constexpr size_t AR_GOI = 531 * MiB;
constexpr size_t AR_GQE = 567 * MiB;
constexpr size_t AR_XLB = 672 * MiB;
constexpr size_t AR_GSB = AR_LB;
constexpr size_t AR_YO = 600 * MiB;
constexpr int SLOT_MAX = 163840 + RT;
constexpr size_t AR_ACT = 0;
constexpr size_t AR_MO = 178 * MiB;
constexpr size_t WS_END = WS_ARENA + 890 * MiB;
static_assert(AR_YO + 72 * MiB <= 890 * MiB, "arena");

constexpr int CW_TMO = 0;
constexpr int CW_BAR = 4096;
constexpr int CW_QUEUE = 8192;
constexpr size_t MT_BLKCNT = 0;
constexpr size_t MT_TOKE = 64 * 1024;
constexpr size_t MT_TOKR = MT_TOKE + 589824;
constexpr size_t MT_TOKG = MT_TOKR + 589824;
constexpr size_t MT_TOKS = MT_TOKG + 589824;
constexpr size_t MT_ROWOFF = MT_TOKS + 589824;
constexpr size_t MT_ROWW = MT_ROWOFF + 729088;
static_assert(MT_ROWW + 729088 <= 8 * MiB, "meta");

constexpr int RING_BYTES = 131072;
constexpr int TBL_OFF = RING_BYTES;
constexpr int MISC_OFF = RING_BYTES + 4096;
constexpr int LDS_BYTES = 147456;

#define MFMA16(a, b, c) __builtin_amdgcn_mfma_f32_16x16x32_bf16((a), (b), (c), 0, 0, 0)
typedef __bf16 bf16x2v __attribute__((ext_vector_type(2)));
DI unsigned cvt_pk_bf16(float lo, float hi) { f32x2 v = {lo, hi}; bf16x2v b = __builtin_convertvector(v, bf16x2v); return __builtin_bit_cast(unsigned, b); }
DI unsigned f2bf(float f) { return cvt_pk_bf16(f, 0.0f) & 0xffffu; }
DI unsigned pk2(float lo, float hi) { return cvt_pk_bf16(lo, hi); }
DI float bf2f(unsigned short b) { return __builtin_bit_cast(float, ((unsigned)b) << 16); }
DI float bflo(unsigned w) { return __builtin_bit_cast(float, w << 16); }
DI float bfhi(unsigned w) { return __builtin_bit_cast(float, w & 0xffff0000u); }
DI float rdlane(float x, int l) { return __builtin_bit_cast(float, __builtin_amdgcn_readlane(__builtin_bit_cast(int, x), l)); }
#define DPP_ADD(v_, ctrl_) (v_) += __builtin_bit_cast(float, __builtin_amdgcn_update_dpp(0, __builtin_bit_cast(int, (v_)), (ctrl_), 0xf, 0xf, true))
DI float wave_sum(float v) {
    DPP_ADD(v, 0xB1);
    DPP_ADD(v, 0x4E);
    DPP_ADD(v, 0x141);
    DPP_ADD(v, 0x140);
    return (rdlane(v, 0) + rdlane(v, 16)) + (rdlane(v, 32) + rdlane(v, 48));
}
DI float sigmoidf_(float x) { return 1.0f / (1.0f + __expf(-x)); }
DI float siluf_(float x) { return x / (1.0f + __expf(-x)); }
DI float siluf_fast(float x) { return x * __builtin_amdgcn_rcpf(1.0f + __expf(-x)); }
#define LDS_WAIT() asm volatile("s_waitcnt lgkmcnt(0)" ::: "memory")
#define VM_WAIT() asm volatile("s_waitcnt vmcnt(0)" ::: "memory")

#define XB_TMO      128
#define XB_XCNT(j)  (256  + 64 * (j))
#define XB_XSUB(j)  (1280 + 64 * (j))
#define XB_XGEN(j)  (2304 + 64 * (j))
#define XB_TOP      3328
#define XB_TOPGEN   3392
#define XCD_BAR_WORDS 3456
#define XB_SPIN_CAP (1u << 18)
__device__ __forceinline__ unsigned xb_ld(unsigned* p)              { return __hip_atomic_load(p, __ATOMIC_RELAXED, __HIP_MEMORY_SCOPE_AGENT); }
__device__ __forceinline__ unsigned xb_add(unsigned* p, unsigned v) { return __hip_atomic_fetch_add(p, v, __ATOMIC_RELAXED, __HIP_MEMORY_SCOPE_AGENT); }
__device__ __forceinline__ unsigned xb_xcc_id() { return (unsigned)__builtin_amdgcn_s_getreg((3 << 11) | 20) & 0xFu; }
#define XB_SPIN(cond, bar) do { unsigned _sp = 0; while (cond) { __builtin_amdgcn_s_sleep(1); \
    if ((++_sp & 255u) == 0u) { if (xb_ld(&(bar)[XB_TMO])) break; if (_sp > XB_SPIN_CAP) { atomicAdd(&(bar)[XB_TMO], 1u); break; } } } } while (0)
struct XcdBarrier { unsigned* bar; unsigned x; volatile LAS unsigned* st; };
__device__ __forceinline__ XcdBarrier xcd_barrier_post(unsigned* bar, volatile LAS unsigned* st) {
    XcdBarrier b; b.bar = bar; b.x = xb_xcc_id(); b.st = st;
    if (threadIdx.x == 0) (void)xb_add(&bar[XB_XCNT(b.x)], 1u);
    return b;
}
__device__ __forceinline__ void xcd_barrier_complete(unsigned* bar, unsigned x, unsigned& nloc, unsigned& nx) {
    const unsigned G = gridDim.x * gridDim.y * gridDim.z;
    unsigned sum, cnt, mine, sp = 0u;
    for (;;) {
        sum = 0u; cnt = 0u; mine = 0u;
#pragma unroll
        for (unsigned j = 0; j < 16; ++j) { const unsigned c = xb_ld(&bar[XB_XCNT(j)]); sum += c; cnt += (c > 0u) ? 1u : 0u; mine = (j == x) ? c : mine; }
        if (sum == G) break;
        __builtin_amdgcn_s_sleep(1);
        if ((++sp & 255u) == 0u) { if (xb_ld(&bar[XB_TMO])) break; if (sp > XB_SPIN_CAP) { atomicAdd(&bar[XB_TMO], 1u); break; } }
    }
    nloc = mine > 0u ? mine : 1u; nx = cnt > 0u ? cnt : 1u;
}
__device__ __forceinline__ void xcd_barrier(const XcdBarrier& b, int tid_) {
    asm volatile("s_waitcnt vmcnt(0)" ::: "memory");
    __syncthreads();
    if (tid_ == 0) {
        unsigned* bar = b.bar;
        __builtin_amdgcn_s_waitcnt(0);
        unsigned nloc = b.st[0], nx = b.st[1];
        if (nloc == 0u) { xcd_barrier_complete(bar, b.x, nloc, nx); b.st[0] = nloc; b.st[1] = nx; }
        const unsigned old = xb_add(&bar[XB_XSUB(b.x)], 1u);
        const unsigned gen = old / nloc;
        if (old + 1u == (gen + 1u) * nloc) {
            __builtin_amdgcn_fence(__ATOMIC_RELEASE, "agent");
            asm volatile("s_waitcnt vmcnt(0)" ::: "memory");
            const unsigned og = xb_add(&bar[XB_TOP], 1u);
            const unsigned tg = og / nx;
            if (og + 1u == (tg + 1u) * nx) xb_add(&bar[XB_TOPGEN], 1u);
            else XB_SPIN(xb_ld(&bar[XB_TOPGEN]) == tg, bar);
            __builtin_amdgcn_fence(__ATOMIC_ACQUIRE, "agent");
            xb_add(&bar[XB_XGEN(b.x)], 1u);
            asm volatile("s_waitcnt vmcnt(0)" ::: "memory");
        } else {
            XB_SPIN(xb_ld(&bar[XB_XGEN(b.x)]) == gen, bar);
            __builtin_amdgcn_fence(__ATOMIC_ACQUIRE, "agent");
            asm volatile("s_waitcnt vmcnt(0)" ::: "memory");
        }
    }
    __syncthreads();
}

namespace pg8 {
typedef int v8i __attribute__((ext_vector_type(8)));
typedef int v4i __attribute__((ext_vector_type(4)));
DI v8i cat8(bf16x8 lo, bf16x8 hi) { const v4i a = __builtin_bit_cast(v4i, lo), b = __builtin_bit_cast(v4i, hi); return __builtin_shufflevector(a, b, 0, 1, 2, 3, 4, 5, 6, 7); }
constexpr int BM = 256, BK = 64, HALF = 128, HTB = HALF * BK * 2, STAGE_BYTES = 8 * HTB, NXCD = 8, WGM = 8;
DI int lds_byte(int r, int c) { const int st = (r >> 4) * 2 + (c >> 5), rr = r & 15, cc = c & 31, ob = rr * 64 + cc * 2; return st * 1024 + (ob ^ (((ob >> 9) & 1) << 5)); }
DI void stage_rc(int b, int& R, int& C) { const int st = b / 1024, sb = b % 1024, swz = sb ^ (((sb >> 9) & 1) << 5); R = (st >> 1) * 16 + swz / 64; C = (st & 1) * 32 + (swz % 64) / 2; }
DI int perm32(int rho) { const int n = rho >> 4, i = rho & 15; return 8 * (i >> 2) + 4 * n + (i & 3); }

struct Unit { int pm, pn, pb, e; };

struct TileOrder {
    int nM, nN, nwg, G, c;
    DI void init(int nM_, int nN_, int G_, int c_) { nM = nM_; nN = nN_; nwg = nM * nN; G = G_; c = c_; }
    DI bool tile(int i, int& pm, int& pn) const {
        const long L = (long)i * G + c; if (L >= nwg) return false;
        int wgid = (int)L; { const int q = nwg / NXCD, r = nwg % NXCD, xcd = wgid % NXCD, off = wgid / NXCD; wgid = (xcd < r ? xcd * (q + 1) : r * (q + 1) + (xcd - r) * q) + off; }
        const int nig = WGM * nN, gid = wgid / nig, fm = gid * WGM, gsz = (nM - fm) < WGM ? (nM - fm) : WGM;
        pm = fm + ((wgid % nig) % gsz); pn = (wgid % nig) / gsz; return true;
    }
};
struct DenseSched {
    TileOrder T;
    DI bool next(int i, Unit& u) const { if (!T.tile(i, u.pm, u.pn)) return false; u.pb = u.pn; u.e = 0; return true; }
};
struct MoeSched {
    TileOrder T; const LAS unsigned short* tile_e;
    DI bool next(int i, Unit& u) const { if (!T.tile(i, u.pm, u.pn)) return false; u.e = (int)__builtin_amdgcn_readfirstlane((int)tile_e[u.pm]); u.pb = u.e * T.nN + u.pn; return true; }
};

struct EpiBf16 {
    static constexpr bool PERM = true;
    bf16_t* O; int ldc; float scale;
    DI void operator()(const f32x4 (&acc)[2][2][4][2], const Unit& u, int wr, int wc, int fr, int fq) const {
        const int row0 = u.pm * BM + wr * 64 + fr; const int col0 = u.pn * BM + wc * 32 + 8 * fq;
#pragma unroll
        for (int ai = 0; ai < 2; ++ai)
#pragma unroll
            for (int m = 0; m < 4; ++m) { const int row = row0 + ai * HALF + m * 16; bf16_t* rowp = O + (size_t)row * ldc + col0; const float rs = scale;
#pragma unroll
                for (int bj = 0; bj < 2; ++bj) { const f32x4 v0 = acc[ai][bj][m][0] * rs, v1 = acc[ai][bj][m][1] * rs;
                    u32x4 w; w.x = cvt_pk_bf16(v0[0], v0[1]); w.y = cvt_pk_bf16(v0[2], v0[3]); w.z = cvt_pk_bf16(v1[0], v1[1]); w.w = cvt_pk_bf16(v1[2], v1[3]);
                    *(u32x4*)(rowp + bj * HALF) = w; } }
    }
};
DI unsigned pk4_fp8(float a, float b, float c, float d) {
    a = fminf(fmaxf(a, -448.f), 448.f); b = fminf(fmaxf(b, -448.f), 448.f); c = fminf(fmaxf(c, -448.f), 448.f); d = fminf(fmaxf(d, -448.f), 448.f);
    int w = 0; w = __builtin_amdgcn_cvt_pk_fp8_f32(a, b, w, false); w = __builtin_amdgcn_cvt_pk_fp8_f32(c, d, w, true); return (unsigned)w; }
struct EpiFp8 {
    static constexpr bool PERM = true;
    unsigned char* O; int ldc; float scale;
    DI void operator()(const f32x4 (&acc)[2][2][4][2], const Unit& u, int wr, int wc, int fr, int fq) const {
        const int odd = fq & 1; const int row0 = u.pm * BM + wr * 64 + fr + 16 * odd; const int col0 = u.pn * BM + wc * 32 + 8 * (fq - odd);
#pragma unroll
        for (int ai = 0; ai < 2; ++ai)
#pragma unroll
            for (int bj = 0; bj < 2; ++bj)
#pragma unroll
                for (int mp = 0; mp < 4; mp += 2) {
                    const f32x4 a0 = acc[ai][bj][mp][0] * scale, a1 = acc[ai][bj][mp][1] * scale, b0 = acc[ai][bj][mp + 1][0] * scale, b1 = acc[ai][bj][mp + 1][1] * scale;
                    const unsigned ax = pk4_fp8(a0[0], a0[1], a0[2], a0[3]), ay = pk4_fp8(a1[0], a1[1], a1[2], a1[3]), bx = pk4_fp8(b0[0], b0[1], b0[2], b0[3]), by = pk4_fp8(b1[0], b1[1], b1[2], b1[3]);
                    const auto rx = __builtin_amdgcn_permlane16_swap(ax, bx, false, false); const auto ry = __builtin_amdgcn_permlane16_swap(ay, by, false, false);
                    *(u32x4*)(O + (size_t)(row0 + ai * HALF + mp * 16) * ldc + col0 + bj * HALF) = (u32x4){rx[0], ry[0], rx[1], ry[1]}; }
    }
};
template <bool F8OUT> struct EpiSwiGlu {
    static constexpr bool PERM = false;
    void* ACT; float iscale, oscale;
    DI void operator()(const f32x4 (&acc)[2][2][4][2], const Unit& u, int wr, int wc, int fr, int fq) const {
        const int row0 = u.pm * BM + wr * 64 + fr;
        if constexpr (F8OUT) {
#pragma unroll
            for (int ai = 0; ai < 2; ++ai)
#pragma unroll
                for (int bj = 0; bj < 2; ++bj) { unsigned d[4];
#pragma unroll
                    for (int m = 0; m < 4; ++m) { const f32x4 g = acc[ai][bj][m][0] * iscale, up = acc[ai][bj][m][1] * iscale;
                        d[m] = pk4_fp8(siluf_fast(g[0]) * up[0] * oscale, siluf_fast(g[1]) * up[1] * oscale, siluf_fast(g[2]) * up[2] * oscale, siluf_fast(g[3]) * up[3] * oscale); }
                    const auto s1 = __builtin_amdgcn_permlane16_swap(d[0], d[1], false, false); const auto s2 = __builtin_amdgcn_permlane16_swap(d[2], d[3], false, false);
                    const auto t0 = __builtin_amdgcn_permlane32_swap(s1[0], s2[0], false, false); const auto t1 = __builtin_amdgcn_permlane32_swap(s1[1], s2[1], false, false);
                    *(u32x4*)((unsigned char*)ACT + (size_t)(row0 + ai * HALF + fq * 16) * EH + 16 * (8 * u.pn + 4 * bj + wc)) = (u32x4){t0[0], t1[0], t0[1], t1[1]}; }
            return;
        }
#pragma unroll
        for (int ai = 0; ai < 2; ++ai)
#pragma unroll
            for (int m = 0; m < 4; ++m) { const size_t rowi = (size_t)(row0 + ai * HALF + m * 16) * EH;
#pragma unroll
                for (int bj = 0; bj < 2; ++bj) { const int hid = 16 * (8 * u.pn + 4 * bj + wc) + 4 * fq; const f32x4 g = acc[ai][bj][m][0] * iscale, up = acc[ai][bj][m][1] * iscale;
                    float a0 = siluf_fast(g[0]) * up[0], a1 = siluf_fast(g[1]) * up[1], a2 = siluf_fast(g[2]) * up[2], a3 = siluf_fast(g[3]) * up[3];
                    if constexpr (F8OUT) { *(unsigned*)((unsigned char*)ACT + rowi + hid) = pk4_fp8(a0 * oscale, a1 * oscale, a2 * oscale, a3 * oscale); }
                    else { u32x2 w; w.x = cvt_pk_bf16(a0, a1); w.y = cvt_pk_bf16(a2, a3); *(u32x2*)((bf16_t*)ACT + rowi + hid) = w; } } }
    }
};

template <int K, int EB, int GMODE, bool SP2, class Epi, class Sched>
DI void gemm_phase(int tid_in, LAS unsigned char* lds, const bf16_t* A, const bf16_t* Bt, const LAS unsigned short* lrows, const Sched& S, const Epi& E) {
    constexpr bool GATHER = GMODE != 0;
    int tid = tid_in; asm volatile("" : "+v"(tid));
    const int wid = __builtin_amdgcn_readfirstlane(tid >> 6), lane = tid & 63, wr = wid >> 2, wc = wid & 3, fr = lane & 15, fq = lane >> 4;
    constexpr int KB = K * EB;
    constexpr int nt = KB / 128;
    unsigned voffA[2], voffB[2];
#pragma unroll
    for (int i = 0; i < 2; ++i) { int R, C; stage_rc(tid * 16 + i * 8192, R, C); const int Rb = Epi::PERM ? ((R & ~31) + perm32(R & 31)) : R;
        voffA[i] = (unsigned)(R * KB + C * 2); voffB[i] = (unsigned)(Rb * KB + C * 2); }
    constexpr size_t kstep = (size_t)(BK * 2);
    constexpr size_t hstep = (size_t)HALF * KB;
    constexpr size_t tstep = 2 * hstep;
    const unsigned ldsw = (unsigned)wid * 1024u;
    const int aoff = lds_byte(wr * 64 + fr, fq * 8), boff = lds_byte(wc * 32 + fr, fq * 8);
#define PG8_SA(b, h) (((b) * 2 + (h)) * HTB)
#define PG8_SB(b, h) ((4 + (b) * 2 + (h)) * HTB)
#define PG8_STAGE(bufoff, gbase, voff) do { _Pragma("unroll") for (int _i = 0; _i < 2; ++_i) \
        __builtin_amdgcn_global_load_lds((const unsigned*)((const char*)(gbase) + (voff)[_i]), (LAS unsigned*)(lds + (bufoff) + ldsw + _i * 8192), 16, 0, 0); } while (0)
#define PG8_STAGE_A(bufoff, ab, ao, h, koff) do { if constexpr (GATHER) { PG8_STAGE(bufoff, (const char*)A + (koff), (ao)[h]); } else { PG8_STAGE(bufoff, (ab) + (h) * hstep + (koff), voffA); } } while (0)
#define PG8_LDA(dst, b, h) do { _Pragma("unroll") for (int m = 0; m < 4; ++m) { if constexpr (EB == 2) { _Pragma("unroll") for (int k = 0; k < 2; ++k) dst[m][k] = *(const LAS bf16x8*)(lds + PG8_SA(b, h) + aoff + m * 2048 + k * 1024); } \
        else { dst##8[m] = cat8(*(const LAS bf16x8*)(lds + PG8_SA(b, h) + aoff + m * 2048), *(const LAS bf16x8*)(lds + PG8_SA(b, h) + aoff + m * 2048 + 1024)); } } } while (0)
#define PG8_LDB(dst, b, h) do { _Pragma("unroll") for (int n = 0; n < 2; ++n) { if constexpr (EB == 2) { _Pragma("unroll") for (int k = 0; k < 2; ++k) dst[n][k] = *(const LAS bf16x8*)(lds + PG8_SB(b, h) + boff + n * 2048 + k * 1024); } \
        else { dst##8[n] = cat8(*(const LAS bf16x8*)(lds + PG8_SB(b, h) + boff + n * 2048), *(const LAS bf16x8*)(lds + PG8_SB(b, h) + boff + n * 2048 + 1024)); } } } while (0)
#define PG8_MMA(ai, bj, At, Bt_) do { __builtin_amdgcn_s_setprio(1); _Pragma("unroll") for (int m = 0; m < 4; ++m) _Pragma("unroll") for (int n = 0; n < 2; ++n) { \
        if constexpr (EB == 2) { _Pragma("unroll") for (int k = 0; k < 2; ++k) acc[ai][bj][m][n] = __builtin_amdgcn_mfma_f32_16x16x32_bf16(Bt_[n][k], At[m][k], acc[ai][bj][m][n], 0, 0, 0); } \
        else { acc[ai][bj][m][n] = __builtin_amdgcn_mfma_scale_f32_16x16x128_f8f6f4(Bt_##8[n], At##8[m], acc[ai][bj][m][n], 0, 0, 0, 0, 0, 0); } } \
        __builtin_amdgcn_s_setprio(0); } while (0)
#define PG8_WAIT_V(n) asm volatile("s_waitcnt vmcnt(" #n ")" ::: "memory")
#define PG8_WAIT_L(n) asm volatile("s_waitcnt lgkmcnt(" #n ")" ::: "memory")
#define PG8_BAR __builtin_amdgcn_s_barrier()
#define PG8_SCHED __builtin_amdgcn_sched_barrier(0)
    Unit cur, nxt; int ui = 0;
    if (!S.next(0, cur)) return;
    f32x4 acc[2][2][4][2];
#pragma unroll
    for (int a = 0; a < 2; ++a)
#pragma unroll
        for (int b = 0; b < 2; ++b)
#pragma unroll
            for (int m = 0; m < 4; ++m)
#pragma unroll
                for (int n = 0; n < 2; ++n) acc[a][b][m][n] = (f32x4){0.f, 0.f, 0.f, 0.f};
    bf16x8 At[4][2], B0[2][2], B1[2][2];
    v8i At8[4], B08[2], B18[2];
    unsigned gA[2][2], gN[2][2];
    if constexpr (GATHER) {
#pragma unroll
        for (int i = 0; i < 2; ++i) { int R, C; stage_rc(tid * 16 + i * 8192, R, C);
#pragma unroll
            for (int h = 0; h < 2; ++h) gA[h][i] = (GMODE == 1 ? (unsigned)lrows[h * HALF + R] : (unsigned)(cur.pm * BM + h * HALF + R)) * (unsigned)KB + (unsigned)C * 2u; }
        asm volatile("" : "+v"(gA[0][0]), "+v"(gA[0][1]), "+v"(gA[1][0]), "+v"(gA[1][1]));
    } else {
#pragma unroll
        for (int h = 0; h < 2; ++h)
#pragma unroll
            for (int i = 0; i < 2; ++i) { gA[h][i] = 0u; gN[h][i] = 0u; }
    }
    const char* cA = (const char*)A + (size_t)cur.pm * tstep; const char* cB = (const char*)Bt + (size_t)cur.pb * tstep;
    if constexpr (SP2) {
        PG8_STAGE(PG8_SB(0, 0), cB, voffB); PG8_STAGE(PG8_SB(0, 1), cB + hstep, voffB); PG8_STAGE_A(PG8_SA(0, 0), cA, gA, 0, 0); PG8_STAGE_A(PG8_SA(0, 1), cA, gA, 1, 0);
        if (wr == 1) PG8_BAR;
        PG8_WAIT_V(2); PG8_BAR;
        PG8_STAGE(PG8_SB(1, 0), cB + kstep, voffB); PG8_STAGE_A(PG8_SA(1, 0), cA, gA, 0, kstep); PG8_STAGE(PG8_SB(1, 1), cB + hstep + kstep, voffB);
        PG8_WAIT_V(6); PG8_BAR;
    } else {
    PG8_STAGE(PG8_SB(0, 0), cB, voffB); PG8_STAGE_A(PG8_SA(0, 0), cA, gA, 0, 0); PG8_STAGE(PG8_SB(0, 1), cB + hstep, voffB); PG8_STAGE_A(PG8_SA(0, 1), cA, gA, 1, 0);
    if (wr == 1) PG8_BAR;
    PG8_WAIT_V(4); PG8_BAR;
    PG8_STAGE(PG8_SB(1, 0), cB + kstep, voffB); PG8_STAGE_A(PG8_SA(1, 0), cA, gA, 0, kstep); PG8_STAGE(PG8_SB(1, 1), cB + hstep + kstep, voffB);
    PG8_WAIT_V(6); PG8_BAR;
    }
    for (;;) {
        const bool has_next = S.next(ui + 1, nxt);
        const char* nA = has_next ? (const char*)A + (size_t)nxt.pm * tstep : cA; const char* nB = has_next ? (const char*)Bt + (size_t)nxt.pb * tstep : cB;
        if constexpr (GATHER) {
            const int npm = has_next ? nxt.pm : cur.pm; int tz = tid; asm volatile("" : "+v"(tz));
#pragma unroll
            for (int i = 0; i < 2; ++i) { int R, C; stage_rc(tz * 16 + i * 8192, R, C);
#pragma unroll
                for (int h = 0; h < 2; ++h) gN[h][i] = (GMODE == 1 ? (unsigned)lrows[(has_next ? ui + 1 : ui) * BM + h * HALF + R] : (unsigned)(npm * BM + h * HALF + R)) * (unsigned)KB + (unsigned)C * 2u; }
            asm volatile("" : "+v"(gN[0][0]), "+v"(gN[0][1]), "+v"(gN[1][0]), "+v"(gN[1][1]));
        }
        int ntv = nt; asm volatile("" : "+s"(ntv));
        for (int t = 0; t < ntv; t += 2) {
            const bool last = (t == ntv - 2);
            const size_t k1 = (size_t)(t + 1) * kstep;
            const char* a2 = last ? nA : cA; const char* b2 = last ? nB : cB + (size_t)(t + 2) * kstep;
            const size_t ka2 = last ? 0 : (size_t)(t + 2) * kstep;
            const char* b3 = b2 + kstep; const size_t ka3 = ka2 + kstep;
            if constexpr (SP2) {
            PG8_LDB(B0, 0, 0); PG8_LDB(B1, 0, 1); PG8_SCHED; PG8_LDA(At, 0, 0); PG8_STAGE_A(PG8_SA(1, 1), cA, gA, 1, k1);
            if constexpr (GATHER) { if (last) { gA[0][0] = gN[0][0]; gA[0][1] = gN[0][1]; gA[1][0] = gN[1][0]; gA[1][1] = gN[1][1]; } }
            PG8_WAIT_V(8); PG8_WAIT_L(0); PG8_BAR; PG8_MMA(0, 0, At, B0); PG8_MMA(0, 1, At, B1); PG8_BAR; PG8_SCHED;
            PG8_LDA(At, 0, 1); PG8_STAGE(PG8_SB(0, 0), b2, voffB); PG8_STAGE(PG8_SB(0, 1), b2 + hstep, voffB); PG8_STAGE_A(PG8_SA(0, 0), a2, gA, 0, ka2);
            PG8_WAIT_V(8); PG8_WAIT_L(0); PG8_BAR; PG8_MMA(1, 0, At, B0); PG8_MMA(1, 1, At, B1); PG8_BAR; PG8_SCHED;
            PG8_LDB(B0, 1, 0); PG8_LDB(B1, 1, 1); PG8_SCHED; PG8_LDA(At, 1, 0); PG8_STAGE_A(PG8_SA(0, 1), a2, gA, 1, ka2);
            PG8_WAIT_V(8); PG8_WAIT_L(0); PG8_BAR; PG8_MMA(0, 0, At, B0); PG8_MMA(0, 1, At, B1); PG8_BAR; PG8_SCHED;
            PG8_LDA(At, 1, 1); PG8_STAGE(PG8_SB(1, 0), b3, voffB); PG8_STAGE(PG8_SB(1, 1), b3 + hstep, voffB); PG8_STAGE_A(PG8_SA(1, 0), a2, gA, 0, ka3);
            PG8_WAIT_V(8); PG8_WAIT_L(0); PG8_BAR; PG8_MMA(1, 0, At, B0); PG8_MMA(1, 1, At, B1); PG8_BAR; PG8_SCHED;
            } else {
            PG8_LDB(B0, 0, 0); PG8_SCHED; PG8_LDA(At, 0, 0); PG8_STAGE_A(PG8_SA(1, 1), cA, gA, 1, k1);
            if constexpr (GATHER) { if (last) { gA[0][0] = gN[0][0]; gA[0][1] = gN[0][1]; gA[1][0] = gN[1][0]; gA[1][1] = gN[1][1]; } }
            PG8_WAIT_L(8); PG8_BAR; PG8_WAIT_L(0); PG8_MMA(0, 0, At, B0); PG8_BAR; PG8_SCHED;
            PG8_LDB(B1, 0, 1); PG8_STAGE(PG8_SB(0, 0), b2, voffB);
            PG8_BAR; PG8_WAIT_L(0); PG8_MMA(0, 1, At, B1); PG8_BAR;
            PG8_LDA(At, 0, 1); PG8_STAGE_A(PG8_SA(0, 0), a2, gA, 0, ka2);
            PG8_BAR; PG8_WAIT_L(0); PG8_MMA(1, 0, At, B0); PG8_BAR; PG8_SCHED;
            PG8_STAGE(PG8_SB(0, 1), b2 + hstep, voffB);
            PG8_WAIT_V(6); PG8_BAR; PG8_MMA(1, 1, At, B1); PG8_BAR;
            PG8_LDB(B0, 1, 0); PG8_SCHED; PG8_LDA(At, 1, 0); PG8_STAGE_A(PG8_SA(0, 1), a2, gA, 1, ka2);
            PG8_WAIT_L(8); PG8_BAR; PG8_WAIT_L(0); PG8_MMA(0, 0, At, B0); PG8_BAR; PG8_SCHED;
            PG8_LDB(B1, 1, 1); PG8_STAGE(PG8_SB(1, 0), b3, voffB);
            PG8_BAR; PG8_WAIT_L(0); PG8_MMA(0, 1, At, B1); PG8_BAR;
            PG8_LDA(At, 1, 1); PG8_STAGE_A(PG8_SA(1, 0), a2, gA, 0, ka3);
            PG8_BAR; PG8_WAIT_L(0); PG8_MMA(1, 0, At, B0); PG8_BAR; PG8_SCHED;
            PG8_STAGE(PG8_SB(1, 1), b3 + hstep, voffB);
            PG8_WAIT_V(6); PG8_BAR; PG8_MMA(1, 1, At, B1); PG8_BAR;
            }
        }
        E(acc, cur, wr, wc, fr, fq);
        if (!has_next) break;
#pragma unroll
        for (int a = 0; a < 2; ++a)
#pragma unroll
            for (int b = 0; b < 2; ++b)
#pragma unroll
                for (int m = 0; m < 4; ++m)
#pragma unroll
                    for (int n = 0; n < 2; ++n) acc[a][b][m][n] = (f32x4){0.f, 0.f, 0.f, 0.f};
        cur = nxt; cA = nA; cB = nB; ++ui;
    }
    PG8_WAIT_V(0);
    if (wr == 0) PG8_BAR;
    PG8_BAR;
#undef PG8_SA
#undef PG8_SB
#undef PG8_STAGE
#undef PG8_STAGE_A
#undef PG8_LDA
#undef PG8_LDB
#undef PG8_MMA
#undef PG8_WAIT_V
#undef PG8_WAIT_L
#undef PG8_BAR
#undef PG8_SCHED
}
}

namespace att {
constexpr int D = 128, NW = 8, QBLK = 32, KVBLK = 64;
constexpr float SCALE = 0.088388347648318440f;
constexpr float THR = 8.f;
constexpr int LDQ = D, LDK = D, LDO = DM;
constexpr size_t SHM_V = KVBLK * D * 2, SHM_K = KVBLK * D * 2, SHM_ATTN = 2 * SHM_V + 2 * SHM_K + NW * 64 * 4;
#define KSWZ(row, colB) ((row) * 256 + ((colB) ^ (((row) & 7) << 4)))
#define SBAR() __builtin_amdgcn_sched_barrier(0)
DI int crow(int r, int hi) { return (r & 3) + 8 * (r >> 2) + 4 * hi; }
DI unsigned cvtpk(float lo, float hi) { return cvt_pk_bf16(lo, hi); }

DI void wmask(f32x16& p0, f32x16& p1, int qp, int kb, int hi) {
#pragma unroll
    for (int r = 0; r < 16; ++r) { const int k0 = kb + crow(r, hi) - qp; const int k1 = k0 + 32;
        p0[r] = (k0 >= -128 && k0 <= 128) ? p0[r] : -1e30f; p1[r] = (k1 >= -128 && k1 <= 128) ? p1[r] : -1e30f; }
}
DI void partialSM(f32x16& p0, f32x16& p1, float& m_reg, float& mn, float& alpha) {
    constexpr float C = SCALE * 1.4426950408889634f;
    float pmax = p0[0];
#pragma unroll
    for (int r = 1; r < 16; ++r) pmax = fmaxf(pmax, p0[r]);
#pragma unroll
    for (int r = 0; r < 16; ++r) pmax = fmaxf(pmax, p1[r]);
    { auto rr = __builtin_amdgcn_permlane32_swap(__float_as_uint(pmax), __float_as_uint(pmax), false, false);
      pmax = fmaxf(__uint_as_float(rr[0]), __uint_as_float(rr[1])); }
    if (__builtin_expect(__all(pmax - m_reg <= THR / SCALE), 1)) { mn = m_reg; alpha = 1.f; }
    else { mn = fmaxf(m_reg, pmax); alpha = __builtin_amdgcn_exp2f((m_reg - mn) * C); m_reg = mn; }
    float mnC = -mn * C;
#pragma unroll
    for (int r = 0; r < 16; ++r) p0[r] = fmaf(p0[r], C, mnC);
#pragma unroll
    for (int r = 0; r < 16; ++r) p1[r] = fmaf(p1[r], C, mnC);
#pragma unroll
    for (int r = 0; r < 16; ++r) p0[r] = __builtin_amdgcn_exp2f(p0[r]);
}
DI void finishSM(f32x16& p0, f32x16& p1, float alpha, float& l_reg, bf16x8& pa0, bf16x8& pa1, bf16x8& pa2, bf16x8& pa3) {
#pragma unroll
    for (int r = 0; r < 16; ++r) p1[r] = __builtin_amdgcn_exp2f(p1[r]);
    float ps = 0;
#pragma unroll
    for (int r = 0; r < 16; ++r) ps += p0[r];
#pragma unroll
    for (int r = 0; r < 16; ++r) ps += p1[r];
    { auto rr = __builtin_amdgcn_permlane32_swap(__float_as_uint(ps), __float_as_uint(ps), false, false);
      ps = __uint_as_float(rr[0]) + __uint_as_float(rr[1]); }
    l_reg = l_reg * alpha + ps;
#define PK4(P, BASE, OUT) do { unsigned a0 = cvtpk(P[BASE + 0], P[BASE + 1]), a1 = cvtpk(P[BASE + 2], P[BASE + 3]);   \
    unsigned b0 = cvtpk(P[BASE + 4], P[BASE + 5]), b1 = cvtpk(P[BASE + 6], P[BASE + 7]);                              \
    auto r0 = __builtin_amdgcn_permlane32_swap(a0, b0, false, false); auto r1 = __builtin_amdgcn_permlane32_swap(a1, b1, false, false); \
    u32x4 w = {r0[0], r1[0], r0[1], r1[1]}; OUT = *reinterpret_cast<bf16x8*>(&w); } while (0)
    PK4(p0, 0, pa0); PK4(p0, 8, pa1); PK4(p1, 0, pa2); PK4(p1, 8, pa3);
#undef PK4
}
DI void qkt(f32x16& p0, f32x16& p1, const char* Ks, const bf16x8* qr, int r32, int hi) {
    p0 = f32x16{}; p1 = f32x16{};
#pragma unroll
    for (int d0 = 0; d0 < 8; ++d0) { int cb = (d0 * 16 + hi * 8) * 2;
        bf16x8 b0 = *reinterpret_cast<const bf16x8*>(Ks + KSWZ(r32, cb));
        bf16x8 b1 = *reinterpret_cast<const bf16x8*>(Ks + KSWZ(32 + r32, cb));
        p0 = __builtin_amdgcn_mfma_f32_32x32x16_bf16(b0, qr[d0], p0, 0, 0, 0);
        p1 = __builtin_amdgcn_mfma_f32_32x32x16_bf16(b1, qr[d0], p1, 0, 0, 0); }
}
DI int v_st(int k, int c) { const int kk = (k & ~0xC) | ((k & 4) << 1) | ((k & 8) >> 1); return ((kk >> 3) * 4 + (c >> 5)) * 512 + ((kk & 7) * 32 + (c & 31)) * 2; }
DI int v_rd_base(int lane) { return ((lane & 3) << 3) | (((lane >> 2) & 3) << 6) | (((lane >> 4) & 1) << 5) | (((lane >> 5) & 1) << 8); }
constexpr int v_rd_off(int d0, int ks, int half) { return d0 * 512 + ks * 4096 + half * 2048; }
template <int OFF> DI s16x4 tr_read(int vb) { s16x4 r; asm volatile("ds_read_b64_tr_b16 %0, %1 offset:%2" : "=&v"(r) : "v"(vb), "i"(OFF) : "memory"); return r; }
template <int D0> DI void pv_one(f32x16& od, int vb, bf16x8 pa0, bf16x8 pa1, bf16x8 pa2, bf16x8 pa3) {
    const s16x4 l0 = tr_read<v_rd_off(D0, 0, 0)>(vb), h0 = tr_read<v_rd_off(D0, 0, 1)>(vb), l1 = tr_read<v_rd_off(D0, 1, 0)>(vb), h1 = tr_read<v_rd_off(D0, 1, 1)>(vb);
    const s16x4 l2 = tr_read<v_rd_off(D0, 2, 0)>(vb), h2 = tr_read<v_rd_off(D0, 2, 1)>(vb), l3 = tr_read<v_rd_off(D0, 3, 0)>(vb), h3 = tr_read<v_rd_off(D0, 3, 1)>(vb);
    asm volatile("s_waitcnt lgkmcnt(0)" ::: "memory"); SBAR();
#define PK(L, H) (bf16x8){L[0], L[1], L[2], L[3], H[0], H[1], H[2], H[3]}
    od = __builtin_amdgcn_mfma_f32_32x32x16_bf16(pa0, PK(l0, h0), od, 0, 0, 0);
    od = __builtin_amdgcn_mfma_f32_32x32x16_bf16(pa1, PK(l1, h1), od, 0, 0, 0);
    od = __builtin_amdgcn_mfma_f32_32x32x16_bf16(pa2, PK(l2, h2), od, 0, 0, 0);
    od = __builtin_amdgcn_mfma_f32_32x32x16_bf16(pa3, PK(l3, h3), od, 0, 0, 0);
#undef PK
}
DI void pv_d0(f32x16* o, int vb, bf16x8 pa0, bf16x8 pa1, bf16x8 pa2, bf16x8 pa3) {
    pv_one<0>(o[0], vb, pa0, pa1, pa2, pa3); pv_one<1>(o[1], vb, pa0, pa1, pa2, pa3); pv_one<2>(o[2], vb, pa0, pa1, pa2, pa3); pv_one<3>(o[3], vb, pa0, pa1, pa2, pa3);
}

DI void attn_body(const bf16_t* __restrict__ Qb, const bf16_t* __restrict__ Kh, const bf16_t* __restrict__ Vh, bf16_t* __restrict__ Ob, int NT, int skip, int q0, float sinkv, bool WIN, bool SINK, char* lds, int tid_in) {
    int tid = tid_in; asm volatile("" : "+v"(tid));
    const int wid = tid >> 6, lane = tid & 63, r32 = lane & 31, hi = lane >> 5;
    char* V_lds = lds; char* K_lds = lds + 2 * SHM_V;
    float* ws = (float*)(lds + 2 * SHM_V + 2 * SHM_K) + wid * 64; float* li_l = ws; float* al_l = ws + 32;
    float m_reg = -1e30f, l_reg = 0; f32x16 o[4] = {}; bf16x8 qr[8];
    const bf16_t* Qw = Qb + (long)(wid * QBLK + r32) * LDQ + hi * 8;
#pragma unroll
    for (int d0 = 0; d0 < 8; ++d0) qr[d0] = *reinterpret_cast<const bf16x8*>(Qw + d0 * 16);
    const int sr = tid >> 4, sc = (tid & 15) * 8, vst0 = v_st(sr, sc), vst1 = v_st(32 + sr, sc);
    const int vb0 = (int)(uintptr_t)V_lds + v_rd_base(lane);
    const int qp = q0 + wid * QBLK + r32;
    struct { bf16x8 vs0, vs1, ks0, ks1; } sr_[2];
#define KOFF(j) (64 * (j) + ((j) >= 4 ? skip : 0))
#define SLOAD(i, jt) do { const int k0_ = KOFF(jt); sr_[i].vs0 = *reinterpret_cast<const bf16x8*>(&Vh[(long)(k0_ + sr) * LDK + sc]); sr_[i].vs1 = *reinterpret_cast<const bf16x8*>(&Vh[(long)(k0_ + 32 + sr) * LDK + sc]); \
    sr_[i].ks0 = *reinterpret_cast<const bf16x8*>(&Kh[(long)(k0_ + sr) * LDK + sc]); sr_[i].ks1 = *reinterpret_cast<const bf16x8*>(&Kh[(long)(k0_ + 32 + sr) * LDK + sc]); } while (0)
#define SWRITE(b, i) do { *(bf16x8*)(V_lds + (b) * SHM_V + vst0) = sr_[i].vs0;          \
    *(bf16x8*)(V_lds + (b) * SHM_V + vst1) = sr_[i].vs1; int kc = sc * 2;               \
    *(bf16x8*)(K_lds + (b) * SHM_K + KSWZ(sr, kc)) = sr_[i].ks0;                       \
    *(bf16x8*)(K_lds + (b) * SHM_K + KSWZ(32 + sr, kc)) = sr_[i].ks1; } while (0)
#define SWAIT() asm volatile("s_waitcnt vmcnt(4)" ::: "memory")
#define RESC(a) do { if (__any((a) < 1.f)) { if (hi == 0) al_l[r32] = (a); asm volatile("s_waitcnt lgkmcnt(0)" ::: "memory"); \
    _Pragma("unroll") for (int d = 0; d < 4; ++d) _Pragma("unroll") for (int r = 0; r < 16; ++r) o[d][r] *= al_l[crow(r, hi)]; } } while (0)
#define WMASK(PA, PB, jt) do { if (WIN && (jt) >= 4) wmask(PA, PB, qp, skip + 64 * ((jt) - 4), hi); } while (0)
    f32x16 pA0, pA1, pB0, pB1; float mnA, mnB, alA, alB; bf16x8 pa0, pa1, pa2, pa3;
    constexpr int SE = 0, SO = 1;
    SLOAD(SE, 0); asm volatile("s_waitcnt vmcnt(0)" ::: "memory"); SWRITE(0, SE); __syncthreads();
    qkt(pA0, pA1, K_lds, qr, r32, hi); partialSM(pA0, pA1, m_reg, mnA, alA);
    SLOAD(SO, 1); if (2 < NT) SLOAD(SE, 2);
    SWAIT(); SWRITE(1, SO); __syncthreads();
    for (int j = 1; j + 1 < NT; j += 2) {
        SBAR(); qkt(pB0, pB1, K_lds + SHM_K, qr, r32, hi); WMASK(pB0, pB1, j);
        finishSM(pA0, pA1, alA, l_reg, pa0, pa1, pa2, pa3); SBAR();
        SLOAD(SO, j + 2); SBAR();
        pv_d0(o, vb0, pa0, pa1, pa2, pa3); partialSM(pB0, pB1, m_reg, mnB, alB);
        __syncthreads(); SWAIT(); SWRITE(0, SE);
        RESC(alB); __syncthreads();
        SBAR(); qkt(pA0, pA1, K_lds, qr, r32, hi); WMASK(pA0, pA1, j + 1);
        finishSM(pB0, pB1, alB, l_reg, pa0, pa1, pa2, pa3); SBAR();
        if (j + 3 < NT) SLOAD(SE, j + 3); SBAR();
        pv_d0(o, vb0 + (int)SHM_V, pa0, pa1, pa2, pa3); partialSM(pA0, pA1, m_reg, mnA, alA);
        __syncthreads(); SWAIT(); SWRITE(1, SO);
        RESC(alA); __syncthreads();
    }
    SBAR(); qkt(pB0, pB1, K_lds + SHM_K, qr, r32, hi); WMASK(pB0, pB1, NT - 1);
    finishSM(pA0, pA1, alA, l_reg, pa0, pa1, pa2, pa3); SBAR();
    pv_d0(o, vb0, pa0, pa1, pa2, pa3); partialSM(pB0, pB1, m_reg, mnB, alB);
    __syncthreads(); RESC(alB);
    finishSM(pB0, pB1, alB, l_reg, pa0, pa1, pa2, pa3); SBAR();
    pv_d0(o, vb0 + (int)SHM_V, pa0, pa1, pa2, pa3);
    if (SINK) l_reg += __builtin_amdgcn_exp2f(sinkv * 1.4426950408889634f - m_reg * (SCALE * 1.4426950408889634f));
    if (hi == 0) li_l[r32] = l_reg; asm volatile("s_waitcnt lgkmcnt(0)" ::: "memory");
    float rli[16];
#pragma unroll
    for (int r = 0; r < 16; ++r) rli[r] = __builtin_amdgcn_rcpf(li_l[crow(r, hi)]);
    bf16_t* Ow = Ob + (long)(wid * QBLK) * LDO;
#pragma unroll
    for (int r = 0; r < 16; ++r) { int orow = crow(r, hi);
#pragma unroll
        for (int d0 = 0; d0 < 4; ++d0) Ow[(long)orow * LDO + d0 * 32 + r32] = (bf16_t)f2bf(o[d0][r] * rli[r]); }
    __syncthreads();
#undef KOFF
#undef SLOAD
#undef SWRITE
#undef SWAIT
#undef RESC
#undef WMASK
}
}

constexpr int NWAVES = 8, NTHR = 512;
struct Args { const float* in[29]; float* out; unsigned char* ws; int ph_lo, ph_hi; };
struct Frame {
    LAS unsigned char* lds; unsigned char* ws; unsigned* ctl;
    int tid, lane, wave, bid;
    static constexpr int G = 256;
};
constexpr int PTR_OFF = RING_BYTES + 4096 + 512;
constexpr int LROWS_OFF = PTR_OFF + 256;
static_assert(LROWS_OFF + 12 * 256 * 2 <= LDS_BYTES, "lds");
DI const float* in_ptr(const Frame& F, int i) { const unsigned long long v = ((const LAS unsigned long long*)(F.lds + PTR_OFF))[i];
    const unsigned lo = __builtin_amdgcn_readfirstlane((unsigned)v), hi = __builtin_amdgcn_readfirstlane((unsigned)(v >> 32)); return (const float*)(const GAS float*)(((unsigned long long)hi << 32) | lo); }
#define AIN(k) in_ptr(F, (k))
DI int modrow(int row) { return row < RL ? (row >> 11) : NB; }
DI const float* mod_vec(const Frame& F, int layer, int mr, int chunk) { return (const float*)(F.ws + WS_MOD) + ((size_t)(layer * 9 + mr) * 6 + chunk) * DM; }

DI bf16x8 tr_read_pair(unsigned a_lo, unsigned a_hi) { s16x4 lo, hi;
    asm volatile("ds_read_b64_tr_b16 %0, %2\n\tds_read_b64_tr_b16 %1, %3\n\ts_waitcnt lgkmcnt(0)" : "=&v"(lo), "=&v"(hi) : "v"(a_lo), "v"(a_hi) : "memory");
    return (bf16x8){lo[0], lo[1], lo[2], lo[3], hi[0], hi[1], hi[2], hi[3]}; }
DI bf16x8 cat4(s16x4 l, s16x4 h) { return (bf16x8){l[0], l[1], l[2], l[3], h[0], h[1], h[2], h[3]}; }
DI int rowmap(int kind, int n) {
    if (kind == 1) return n < 2560 ? n : (n < 2592 ? n + 2048 : n - 32);
    if (kind == 2) return ((n >> 4) << 5) + (n & 15);
    if (kind == 3) return ((n >> 4) << 5) + 16 + (n & 15);
    return n;
}
DI void transpose_item(const float* W, int K, int N, bf16_t* WT, int kind, LAS float* scr, int item, int lane) {
    const int nblk = N / 32, kb = item / nblk, nb = item % nblk, k0 = 64 * kb, n0 = 32 * nb;
#pragma unroll 8
    for (int i = 0; i < 32; ++i) { const int kk = 2 * i + (lane >> 5); scr[kk * 33 + (lane & 31)] = W[(size_t)(k0 + kk) * N + n0 + (lane & 31)]; }
    LDS_WAIT(); asm volatile("" ::: "memory");
    const int c = lane & 7;
#pragma unroll
    for (int j = 0; j < 4; ++j) { const int n = (lane >> 3) + 8 * j; const LAS float* s = scr + (8 * c) * 33 + n;
        u32x4 o; o.x = pk2(s[0 * 33], s[1 * 33]); o.y = pk2(s[2 * 33], s[3 * 33]); o.z = pk2(s[4 * 33], s[5 * 33]); o.w = pk2(s[6 * 33], s[7 * 33]);
        *(u32x4*)(WT + (size_t)rowmap(kind, n0 + n) * K + k0 + 8 * c) = o; }
    LDS_WAIT(); asm volatile("" ::: "memory");
}
DI bool conv_group(int& it, const float* src, size_t ss, int cnt, int K, int N, bf16_t* dst, size_t ds, int kind, LAS float* scr, int lane) {
    const int per = (K / 64) * (N / 32), tot = per * cnt;
    if (it >= tot) { it -= tot; return false; }
    const int m = it / per, r = it % per;
    transpose_item(src + (size_t)m * ss, K, N, dst + (size_t)m * ds, kind, scr, r, lane);
    return true;
}
struct ConvTile { const float* W; bf16_t* WT; int K, N, kind, k0, n0, f8; float scale; };
DI bool conv_tile_decode(const Frame& F, int t, ConvTile& c) {
    constexpr int PER_LAYER = 256 + 65 * 64 * 3 + 32 * 19;
    if (t >= 2 * PER_LAYER) return false;
    const int l = t / PER_LAYER; int r = t % PER_LAYER;
    bf16_t* WOUT = (bf16_t*)(F.ws + WS_WOUT); bf16_t* WGU = (bf16_t*)(F.ws + WS_WGU); bf16_t* WD = (bf16_t*)(F.ws + WS_WD);
    if (r < 256) { c.W = AIN(8) + (size_t)l * DM * DM; c.WT = WOUT + (size_t)l * DM * DM; c.K = DM; c.N = DM; c.kind = 0; c.k0 = (r >> 3) * 64; c.n0 = (r & 7) * 256; c.f8 = 0; c.scale = 1.f; return true; }
    r -= 256;
    if (r < 2 * 65 * 64) { const int up = r >= 65 * 64; if (up) r -= 65 * 64; const int e = r >> 6, q = r & 63;
        c.W = e < 64 ? AIN(up ? 24 : 23) + ((size_t)l * 64 + e) * DM * EH : AIN(up ? 27 : 26) + (size_t)l * DM * EH;
        c.f8 = MOE_FP8[l] ? 1 : 0; c.scale = SW_GU;
        c.WT = c.f8 ? (bf16_t*)((unsigned char*)(WGU + (size_t)l * 65 * 1024 * DM) + (size_t)e * 1024 * DM) : WGU + ((size_t)l * 65 + e) * 1024 * DM; c.K = DM; c.N = EH; c.kind = up ? 3 : 2; c.k0 = (q >> 1) * 64; c.n0 = (q & 1) * 256; return true; }
    r -= 2 * 65 * 64;
    if (r >= 65 * 64) { r -= 65 * 64;
        c.W = AIN(7) + (size_t)l * DM * INC; c.WT = (bf16_t*)(F.ws + WS_WIN) + (size_t)l * PC * DM; c.K = DM; c.N = INC; c.kind = 1; c.k0 = (r / 19) * 64; c.n0 = (r % 19) * 256; c.f8 = IN_FP8[l] ? 1 : 0; c.scale = SW_IN; return true; }
    { const int e = r >> 6, q = r & 63;
      c.W = e < 64 ? AIN(25) + ((size_t)l * 64 + e) * EH * DM : AIN(28) + (size_t)l * EH * DM;
      c.f8 = MOE2_FP8[l] ? 1 : 0; c.scale = SW_D;
      c.WT = c.f8 ? (bf16_t*)((unsigned char*)(WD + (size_t)l * 65 * DM * EH) + (size_t)e * DM * EH) : WD + ((size_t)l * 65 + e) * DM * EH; c.K = EH; c.N = DM; c.kind = 0; c.k0 = (q >> 3) * 64; c.n0 = (q & 7) * 256; return true; }
}
DI void conv_tile_load(const ConvTile& c, int tid, f32x4 (&r)[8]) {
#pragma unroll
    for (int i = 0; i < 8; ++i) r[i] = (c.n0 + 4 * (tid & 63) < c.N) ? *(const f32x4*)(c.W + (size_t)(c.k0 + (tid >> 6) + 8 * i) * c.N + c.n0 + 4 * (tid & 63)) : (f32x4){0.f, 0.f, 0.f, 0.f};
}
DI void p0_convert_fast(const Frame& F) {
    LAS unsigned char* img = F.lds;
    const int g = F.lane >> 4, q = (F.lane & 15) >> 2, p = F.lane & 3;
    ConvTile cur, nxt; f32x4 rc[8], rn[8];
    int t = F.bid; bool have = conv_tile_decode(F, t, cur);
    if (have) conv_tile_load(cur, F.tid, rc);
    while (have) {
        const bool hn = conv_tile_decode(F, t + F.G, nxt);
        if (hn) conv_tile_load(nxt, F.tid, rn);
#pragma unroll
        for (int i = 0; i < 8; ++i) { u32x2 w; w.x = pk2(rc[i].x, rc[i].y); w.y = pk2(rc[i].z, rc[i].w); *(LAS u32x2*)(img + ((F.tid >> 6) + 8 * i) * 528 + (F.tid & 63) * 8) = w; }
        __syncthreads();
        if (cur.f8) {
#pragma unroll
            for (int i = 0; i < 2; ++i) { const int nb = F.wave * 2 + i;
                const unsigned a0 = (unsigned)(uintptr_t)img + (unsigned)(16 * g + q) * 528u + (unsigned)(16 * nb + 4 * p) * 2u;
                const bf16x8 t01 = tr_read_pair(a0, a0 + 4u * 528u), t23 = tr_read_pair(a0 + 8u * 528u, a0 + 12u * 528u);
                const float sc = cur.scale; u32x4 w;
#define F8W(T_, O_) pg8::pk4_fp8(bf2f((unsigned short)T_[O_]) * sc, bf2f((unsigned short)T_[O_ + 1]) * sc, bf2f((unsigned short)T_[O_ + 2]) * sc, bf2f((unsigned short)T_[O_ + 3]) * sc)
                w.x = F8W(t01, 0); w.y = F8W(t01, 4); w.z = F8W(t23, 0); w.w = F8W(t23, 4);
#undef F8W
                const int n = cur.n0 + 16 * nb + (F.lane & 15);
                if (n < cur.N) *(u32x4*)((unsigned char*)cur.WT + (size_t)rowmap(cur.kind, n) * cur.K + cur.k0 + 16 * g) = w; }
        } else {
#pragma unroll
        for (int i = 0; i < 4; ++i) { const int combo = F.wave * 4 + i, nb = combo >> 1, kh = combo & 1;
            const unsigned a0 = (unsigned)(uintptr_t)img + (unsigned)(32 * kh + 8 * g + q) * 528u + (unsigned)(16 * nb + 4 * p) * 2u;
            const bf16x8 lohi = tr_read_pair(a0, a0 + 4u * 528u);
            const int n = cur.n0 + 16 * nb + (F.lane & 15);
            if (n < cur.N) *(bf16x8*)(cur.WT + (size_t)rowmap(cur.kind, n) * cur.K + cur.k0 + 32 * kh + 8 * g) = lohi; }
        }
        __syncthreads();
        cur = nxt; have = hn; t += F.G;
#pragma unroll
        for (int i = 0; i < 8; ++i) rc[i] = rn[i];
    }
}
DI void p0_convert(const Frame& F, const Args& a) {
    LAS float* scr = (LAS float*)(F.lds + F.wave * 16384);
    const int gw = F.bid * NWAVES + F.wave, NGW = F.G * NWAVES;
    bf16_t* WIN = (bf16_t*)(F.ws + WS_WIN); bf16_t* LRUW = (bf16_t*)(F.ws + WS_LRUW);
    constexpr int PER_LAYER = 2 * 8 * 8 + 224;
    for (int it0 = gw; it0 < 2 * PER_LAYER; it0 += NGW) {
        const int l = it0 / PER_LAYER; int it = it0 % PER_LAYER;
        { const int per = 8; if (it < 8 * per) { const int m = it / per, r = it % per, d = m >> 2, h = m & 3;
            transpose_item(AIN(11) + ((size_t)(l * 2 + d) * 4 + h) * 16384, 128, 128, LRUW + ((size_t)((l * 2 + d) * 2 + 0) * 4 + h) * 16384, 0, scr, r, F.lane); continue; } it -= 8 * per;
          if (it < 8 * per) { const int m = it / per, r = it % per, d = m >> 2, h = m & 3;
            transpose_item(AIN(13) + ((size_t)(l * 2 + d) * 4 + h) * 16384, 128, 128, LRUW + ((size_t)((l * 2 + d) * 2 + 1) * 4 + h) * 16384, 0, scr, r, F.lane); continue; } it -= 8 * per; }
        { u32x4 z = {0u, 0u, 0u, 0u}; const int rb = IN_FP8[l] ? DM : DM * 2;
          u32x4* p = (u32x4*)((unsigned char*)(WIN + (size_t)l * PC * DM) + (size_t)(INC + it) * rb) + F.lane;
          for (int j = 0; j < rb / 1024; ++j) p[64 * j] = z; }
    }
    __syncthreads();
}
DI void p0_mod(const Frame& F, const Args& a) {
    LAS float* st = (LAS float*)F.lds;
    LAS float* part = (LAS float*)(F.lds + 73728);
    if (F.bid == 200) { float* SP = (float*)(F.ws + WS_SP); for (int i = F.tid; i < 2048; i += NTHR) SP[i] = log1pf(expf(-AIN(15)[i])); }
    if (F.bid >= 208 && F.bid < 224) { bf16_t* RWS = (bf16_t*)(F.ws + WS_RWS); const float* rw = AIN(21);
        for (int i = (F.bid - 208) * NTHR + F.tid; i < 2 * DM * NEXP; i += 16 * NTHR) { const int l = i / (DM * NEXP), r = i % (DM * NEXP), k = r >> 6, e = r & 63; const float w = rw[i];
            const unsigned hi = f2bf(w); const float lo = w - bf2f((unsigned short)hi);
            const size_t fi = (size_t)l * NEXP * DM + (((((size_t)(k >> 8) * 8 + ((k >> 5) & 7)) * 4 + (e >> 4)) * 64 + (((k >> 3) & 3) * 16 + (e & 15))) * 8 + (k & 7));
            RWS[fi] = (bf16_t)hi; RWS[(size_t)2 * NEXP * DM + fi] = (bf16_t)f2bf(lo); } }
    if (F.bid == 224) { unsigned* rid = (unsigned*)(F.ws + WS_ROWID); for (int i = F.tid; i < RT; i += NTHR) rid[i] = (unsigned)i * (unsigned)DM; }
    if (F.bid >= 192) return;
    for (int i = F.tid; i < 9 * DM; i += NTHR) { const int r = i / DM, k = i % DM; const float c = r < 8 ? AIN(1)[r * DM + k] : AIN(3)[k]; st[k * 9 + r] = siluf_(c); }
    __syncthreads();
    const int l = F.bid / 96, cg = F.bid % 96;
    const float* W = AIN(4) + (size_t)l * DM * 12288 + cg * 128 + 2 * F.lane;
    float acc[9][2];
#pragma unroll
    for (int r = 0; r < 9; ++r) { acc[r][0] = 0.f; acc[r][1] = 0.f; }
    const int kb = F.wave * 256;
#pragma unroll 4
    for (int k = kb; k < kb + 256; ++k) { const f32x2 w = *(const f32x2*)(W + (size_t)k * 12288);
#pragma unroll
        for (int r = 0; r < 9; ++r) { const float s = st[k * 9 + r]; acc[r][0] += s * w.x; acc[r][1] += s * w.y; } }
#pragma unroll
    for (int r = 0; r < 9; ++r) { part[(F.wave * 9 + r) * 128 + 2 * F.lane] = acc[r][0]; part[(F.wave * 9 + r) * 128 + 2 * F.lane + 1] = acc[r][1]; }
    __syncthreads();
    float* MOD = (float*)(F.ws + WS_MOD);
    for (int i = F.tid; i < 9 * 128; i += NTHR) { const int r = i >> 7, c = i & 127; float s = AIN(5)[l * 12288 + cg * 128 + c];
#pragma unroll
        for (int w = 0; w < 8; ++w) s += part[(w * 9 + r) * 128 + c];
        MOD[(size_t)(l * 9 + r) * 12288 + cg * 128 + c] = s; }
    asm volatile("s_waitcnt vmcnt(0)" ::: "memory");
    __syncthreads();
    if (l == 0 && cg < 32 && F.tid == 0) { __builtin_amdgcn_fence(__ATOMIC_RELEASE, "agent"); asm volatile("s_waitcnt vmcnt(0)" ::: "memory"); (void)xb_add(F.ctl + CW_QUEUE + 64 * 8, 1u); }
}

DI float row_sumsq(const f32x4 (&v)[8]) { float s = 0.f;
#pragma unroll
    for (int j = 0; j < 8; ++j) s += (v[j].x * v[j].x + v[j].y * v[j].y) + (v[j].z * v[j].z + v[j].w * v[j].w);
    return wave_sum(s); }
DI void norm_mod_store(const f32x4 (&v)[8], float rstd, const float* g, const float* shift, const float* scale, bf16_t* hrow, int lane) {
#pragma unroll
    for (int j = 0; j < 8; ++j) { const int c = 256 * j + 4 * lane; const f32x4 gg = *(const f32x4*)(g + c), sh = *(const f32x4*)(shift + c), sc = *(const f32x4*)(scale + c);
        const f32x4 h = v[j] * rstd * gg * (sc + 1.0f) + sh;
        if (IN_FP8[0]) *(unsigned*)((unsigned char*)hrow + c) = pg8::pk4_fp8(h.x, h.y, h.z, h.w);
        else { u32x2 w; w.x = pk2(h.x, h.y); w.y = pk2(h.z, h.w); *(u32x2*)(hrow + c) = w; } }
}
DI void pre_rows(const Frame& F, const Args& a, int layer, const float* xl, const float* xc, int nrows) {
    const int gw = F.bid * NWAVES + F.wave, NGW = F.G * NWAVES; bf16_t* H = (bf16_t*)(F.ws + WS_H);
    const float* g0 = AIN(6) + (size_t)(layer * 4 + 0) * DM;
    f32x4 nv[8];
    if (gw < nrows) { const float* xr = gw < RL ? xl + (size_t)gw * DM : xc + (size_t)(gw - RL) * DM;
#pragma unroll
        for (int j = 0; j < 8; ++j) nv[j] = *(const f32x4*)(xr + 256 * j + 4 * F.lane); }
#pragma unroll 1
    for (int row = gw; row < nrows; row += NGW) {
        f32x4 v[8];
#pragma unroll
        for (int j = 0; j < 8; ++j) v[j] = nv[j];
        { const int nr = row + NGW; if (nr < nrows) { const float* xr = nr < RL ? xl + (size_t)nr * DM : xc + (size_t)(nr - RL) * DM;
#pragma unroll
            for (int j = 0; j < 8; ++j) nv[j] = *(const f32x4*)(xr + 256 * j + 4 * F.lane); } }
        const float rstd = rsqrtf(row_sumsq(v) * (1.0f / DM) + RMS_EPS); const int mr = modrow(row);
        norm_mod_store(v, rstd, g0, mod_vec(F, layer, mr, 0), mod_vec(F, layer, mr, 1), IN_FP8[0] ? (bf16_t*)((unsigned char*)H + (size_t)row * DM) : H + (size_t)row * DM, F.lane);
    }
}

template <bool F8, bool XIB> DI void postmix_phase(const Frame& F, const Args& a, int layer, const void* xl_src_, const void* xc_src_, bf16_t* xl_dst, bf16_t* xc_dst, int nrows) {
    LAS unsigned char* AH = F.lds;
    LAS unsigned char* AL = F.lds + 8 * 4112;
    LAS float* part = (LAS float*)(F.lds + 66048);
    LAS unsigned* hist = (LAS unsigned*)(F.lds + 66048 + 16384);
    const bf16_t* YO = (const bf16_t*)(F.ws + WS_ARENA + AR_YO); bf16_t* H = (bf16_t*)(F.ws + WS_H);
    int* TOKE = (int*)(F.ws + WS_META + MT_TOKE); int* TOKR = (int*)(F.ws + WS_META + MT_TOKR); float* TOKG = (float*)(F.ws + WS_META + MT_TOKG);
    const float* g1 = AIN(6) + (size_t)(layer * 4 + 1) * DM; const float* g2 = AIN(6) + (size_t)(layer * 4 + 2) * DM;
    const bf16_t* RWH = (const bf16_t*)(F.ws + WS_RWS) + (size_t)layer * NEXP * DM; const bf16_t* RWL = RWH + (size_t)2 * NEXP * DM; const float rbias = AIN(22)[layer * NEXP + F.lane];
    const int rpb = nrows / F.G;
    LAS float* VA1 = (LAS float*)(F.lds + 83968); LAS float* VA2 = VA1 + DM; LAS float* VB2 = VA2 + DM;
    if (F.tid < 64) hist[F.tid] = 0u;
    int cur_mr = -1;
    u32x2 yc[8], yn[8]; f32x4 xc[8], xn[8];
#define PM_LOAD(Y_, X_, it_) do { const int row_ = F.bid * rpb + (it_) * 8 + F.wave; \
        if constexpr (XIB) { const bf16_t* xs_ = row_ < RL ? (const bf16_t*)xl_src_ + (size_t)row_ * DM : (const bf16_t*)xc_src_ + (size_t)(row_ - RL) * DM; \
            _Pragma("unroll") for (int j = 0; j < 8; ++j) { Y_[j] = *(const u32x2*)(YO + (size_t)row_ * DM + 256 * j + 4 * F.lane); const u32x2 t_ = *(const u32x2*)(xs_ + 256 * j + 4 * F.lane); const unsigned tx_ = t_.x, ty_ = t_.y; X_[j].x = __builtin_bit_cast(float, tx_); X_[j].y = __builtin_bit_cast(float, ty_); } }        \
        else { const float* xs_ = row_ < RL ? (const float*)xl_src_ + (size_t)row_ * DM : (const float*)xc_src_ + (size_t)(row_ - RL) * DM; \
            _Pragma("unroll") for (int j = 0; j < 8; ++j) { Y_[j] = *(const u32x2*)(YO + (size_t)row_ * DM + 256 * j + 4 * F.lane); X_[j] = *(const f32x4*)(xs_ + 256 * j + 4 * F.lane); } } } while (0)
    PM_LOAD(yc, xc, 0);
    __syncthreads();
    for (int it = 0; it < rpb / 8; ++it) {
        const int row = F.bid * rpb + it * 8 + F.wave; const int mr = modrow(F.bid * rpb + it * 8);
        bf16_t* xd = row < RL ? xl_dst + (size_t)row * DM : xc_dst + (size_t)(row - RL) * DM;
        if (mr != cur_mr) { cur_mr = mr;
            const float* m2 = mod_vec(F, layer, mr, 2); const float* m3 = mod_vec(F, layer, mr, 3); const float* m4 = mod_vec(F, layer, mr, 4); const int c = 4 * F.tid;
            const f32x4 a1 = *(const f32x4*)(m2 + c) * *(const f32x4*)(g1 + c), a2 = *(const f32x4*)(g2 + c) * (*(const f32x4*)(m4 + c) + 1.0f), b2 = *(const f32x4*)(m3 + c);
            *(LAS f32x4*)(VA1 + c) = a1; *(LAS f32x4*)(VA2 + c) = a2; *(LAS f32x4*)(VB2 + c) = b2;
            __syncthreads(); }
        f32x4 v[8];
        { f32x4 y[8];
#pragma unroll
          for (int j = 0; j < 8; ++j) y[j] = (f32x4){bflo(yc[j].x), bfhi(yc[j].x), bflo(yc[j].y), bfhi(yc[j].y)};
          const float rstd = rsqrtf(row_sumsq(y) * (1.0f / DM) + RMS_EPS);
#pragma unroll
          for (int j = 0; j < 8; ++j) { const int c = 256 * j + 4 * F.lane; f32x4 xv = xc[j];
              if constexpr (XIB) { const float r0 = xc[j].x, r1 = xc[j].y; const unsigned w0 = __builtin_bit_cast(unsigned, r0), w1 = __builtin_bit_cast(unsigned, r1); xv = (f32x4){bflo(w0), bfhi(w0), bflo(w1), bfhi(w1)}; }
              v[j] = xv + *(const LAS f32x4*)(VA1 + c) * (y[j] * rstd); *(u32x2*)(xd + c) = (u32x2){pk2(v[j].x, v[j].y), pk2(v[j].z, v[j].w)}; } }
        { const float rstd = rsqrtf(row_sumsq(v) * (1.0f / DM) + RMS_EPS);
#pragma unroll
          for (int j = 0; j < 8; ++j) { const int c = 256 * j + 4 * F.lane;
              const f32x4 h = v[j] * rstd * *(const LAS f32x4*)(VA2 + c) + *(const LAS f32x4*)(VB2 + c);
              if constexpr (F8) { *(unsigned*)((unsigned char*)H + (size_t)row * DM + c) = pg8::pk4_fp8(h.x, h.y, h.z, h.w); } else { u32x2 w; w.x = pk2(h.x, h.y); w.y = pk2(h.z, h.w); *(u32x2*)(H + (size_t)row * DM + c) = w; }
              { const unsigned h0 = f2bf(h.x), h1 = f2bf(h.y), h2 = f2bf(h.z), h3 = f2bf(h.w); u32x2 wh, wl; wh.x = h0 | (h1 << 16); wh.y = h2 | (h3 << 16);
                wl.x = pk2(h.x - bf2f((unsigned short)h0), h.y - bf2f((unsigned short)h1)); wl.y = pk2(h.z - bf2f((unsigned short)h2), h.w - bf2f((unsigned short)h3));
                *(LAS u32x2*)(AH + F.wave * 4112 + c * 2) = wh; *(LAS u32x2*)(AL + F.wave * 4112 + c * 2) = wl; } } }
        if (it + 1 < rpb / 8) PM_LOAD(yn, xn, it + 1);
        __syncthreads();
        { const int fr = F.lane & 15, fq = F.lane >> 4; f32x4 acc[4];
#pragma unroll
          for (int et = 0; et < 4; ++et) acc[et] = (f32x4){0.f, 0.f, 0.f, 0.f};
          const bf16_t* wph = RWH + ((size_t)F.wave * 8 * 4 * 64 + F.lane) * 8; const bf16_t* wpl = RWL + ((size_t)F.wave * 8 * 4 * 64 + F.lane) * 8;
          bf16x8 wh[3][4], wl[3][4];
#define RT_LD(buf, s_) do { _Pragma("unroll") for (int et = 0; et < 4; ++et) { wh[buf][et] = *(const bf16x8*)(wph + ((s_) * 4 + et) * 512); wl[buf][et] = *(const bf16x8*)(wpl + ((s_) * 4 + et) * 512); } } while (0)
#define RT_MM(buf, s_) do { const bf16x8 bh = *(const LAS bf16x8*)(AH + (fr & 7) * 4112 + (F.wave * 256 + 32 * (s_) + fq * 8) * 2), bl = *(const LAS bf16x8*)(AL + (fr & 7) * 4112 + (F.wave * 256 + 32 * (s_) + fq * 8) * 2); \
              _Pragma("unroll") for (int et = 0; et < 4; ++et) { acc[et] = MFMA16(wh[buf][et], bh, acc[et]); acc[et] = MFMA16(wh[buf][et], bl, acc[et]); acc[et] = MFMA16(wl[buf][et], bh, acc[et]); } } while (0)
          RT_LD(0, 0); RT_LD(1, 1);
#pragma unroll 1
          for (int s2 = 0; s2 < 6; s2 += 3) { RT_LD(2, s2 + 2); RT_MM(0, s2); RT_LD(0, s2 + 3); RT_MM(1, s2 + 1); RT_LD(1, s2 + 4); RT_MM(2, s2 + 2); }
          RT_MM(0, 6); RT_MM(1, 7);
#undef RT_LD
#undef RT_MM
          if (fr < 8) {
#pragma unroll
              for (int et = 0; et < 4; ++et) *(LAS f32x4*)(part + (F.wave * 8 + fr) * 64 + et * 16 + 4 * fq) = acc[et]; } }
        __syncthreads();
        { int ln = F.lane; asm volatile("" : "+v"(ln));
          float logit = 0.f;
#pragma unroll
          for (int w = 0; w < 8; ++w) logit += part[(w * 8 + F.wave) * 64 + ln];
          const float s = 1.0f / (1.0f + expf(-logit)); const float bsd = s + rbias; const float NINF = -__builtin_inff();
          float m1 = bsd; m1 = fmaxf(m1, __shfl_xor(m1, 1)); m1 = fmaxf(m1, __shfl_xor(m1, 2)); m1 = fmaxf(m1, __shfl_xor(m1, 4));
          const unsigned long long bal = __ballot(bsd == m1); const int g = ln >> 3; const unsigned gm = (unsigned)(bal >> (8 * g)) & 0xffu; const int first = __ffs(gm) - 1;
          float b2 = ((ln & 7) == first) ? NINF : bsd; b2 = fmaxf(b2, __shfl_xor(b2, 1)); b2 = fmaxf(b2, __shfl_xor(b2, 2)); b2 = fmaxf(b2, __shfl_xor(b2, 4));
          const float gs = m1 + b2; int grank = 0;
#pragma unroll
          for (int gg = 0; gg < 8; ++gg) { const float og = rdlane(gs, gg * 8); grank += ((og > gs) || (og == gs && gg < g)) ? 1 : 0; }
          const bool elig = grank < 4; const float mk = elig ? bsd : NINF; int erank = 0;
#pragma unroll
          for (int ee = 0; ee < 64; ++ee) { const float ov = rdlane(mk, ee); erank += ((ov > mk) || (ov == mk && ee < ln)) ? 1 : 0; }
          const bool sel = elig && erank < 8; const float ssum = wave_sum(sel ? s : 0.f); const float gate = s / ssum * 2.5f;
          const unsigned long long sb = __ballot(sel); const int kidx = __popcll(sb & ((1ull << ln) - 1ull));
          if (sel) { const unsigned rk = __hip_atomic_fetch_add(hist + ln, 1u, __ATOMIC_RELAXED, __HIP_MEMORY_SCOPE_WORKGROUP);
              TOKE[row * 8 + kidx] = ln; TOKR[row * 8 + kidx] = (int)rk; TOKG[row * 8 + kidx] = gate; } }
        __syncthreads();
#pragma unroll
        for (int j = 0; j < 8; ++j) { yc[j] = yn[j]; xc[j] = xn[j]; }
    }
#undef PM_LOAD
    if (F.tid < 64) ((unsigned*)(F.ws + WS_META + MT_BLKCNT))[F.bid * 64 + F.tid] = hist[F.tid];
    __syncthreads();
}

DI void moe_tables(const Frame& F, int ntok) {
    LAS unsigned char* T = F.lds + TBL_OFF;
    LAS unsigned short* tile_e = (LAS unsigned short*)T; LAS unsigned* pstart = (LAS unsigned*)(T + 2048); LAS unsigned* cnt = (LAS unsigned*)(T + 2304); LAS unsigned* base = (LAS unsigned*)(T + 2560); LAS unsigned* misc = (LAS unsigned*)(T + 2816);
    LAS unsigned* tmp = (LAS unsigned*)F.lds;
    const unsigned* BC = (const unsigned*)(F.ws + WS_META + MT_BLKCNT);
    { const int e = F.tid & 63, p = F.tid >> 6; unsigned tot = 0, below = 0;
      for (int b = p * 32; b < p * 32 + 32; ++b) { const unsigned c = (b < F.G) ? BC[b * 64 + e] : 0u; tot += c; below += (b < F.bid) ? c : 0u; }
      tmp[p * 64 + e] = tot; tmp[512 + p * 64 + e] = below; }
    __syncthreads();
    if (F.tid < 64) { unsigned tot = 0, below = 0;
#pragma unroll
        for (int p = 0; p < 8; ++p) { tot += tmp[p * 64 + F.tid]; below += tmp[512 + p * 64 + F.tid]; }
        cnt[F.tid] = tot; base[F.tid] = below; }
    __syncthreads();
    if (F.tid < 64) { unsigned s = 0, tot = 0;
#pragma unroll 16
        for (int e = 0; e < 64; ++e) { const unsigned pc = (cnt[e] + 255u) & ~255u; s += (e < F.tid) ? pc : 0u; tot += pc; }
        pstart[F.tid] = s; if (F.tid == 0) misc[0] = tot >> 8; }
    __syncthreads();
    const int nrt = (int)misc[0], nst = ntok / 256;
    for (int t = F.tid; t < nrt + nst; t += NTHR) { int e = 64; if (t < nrt) { const unsigned s = (unsigned)t << 8; e = 0;
#pragma unroll 1
            for (int q = 32; q >= 1; q >>= 1) if (e + q < 64 && pstart[e + q] <= s) e += q;
            while (e < 63 && pstart[e + 1] <= s) ++e; }
        tile_e[t] = (unsigned short)e; }
    __syncthreads();
}
DI void slots_phase(const Frame& F, int layer, int ntok, unsigned rowbytes) {
    moe_tables(F, ntok);
    LAS unsigned char* T = F.lds + TBL_OFF;
    LAS unsigned* pstart = (LAS unsigned*)(T + 2048); LAS unsigned* cnt = (LAS unsigned*)(T + 2304); LAS unsigned* base = (LAS unsigned*)(T + 2560); LAS unsigned* misc = (LAS unsigned*)(T + 2816);
    const int* TOKE = (const int*)(F.ws + WS_META + MT_TOKE); const int* TOKR = (const int*)(F.ws + WS_META + MT_TOKR); const float* TOKG = (const float*)(F.ws + WS_META + MT_TOKG);
    int* TOKS = (int*)(F.ws + WS_META + MT_TOKS); unsigned* ROWOFF = (unsigned*)(F.ws + WS_META + MT_ROWOFF);
    const int rpb = ntok / F.G; const unsigned sslot0 = misc[0] << 8;
    for (int i = F.tid; i < rpb * 8; i += NTHR) { const int row = F.bid * rpb + (i >> 3), k = i & 7; const int e = TOKE[row * 8 + k];
        const unsigned slot = pstart[e] + base[e] + (unsigned)TOKR[row * 8 + k];
        TOKS[row * 8 + k] = (int)slot; ROWOFF[slot] = (unsigned)row * rowbytes; }
    for (int i = F.tid; i < rpb; i += NTHR) { const int row = F.bid * rpb + i; ROWOFF[sslot0 + row] = (unsigned)row * rowbytes; }
    if (F.bid < 64) { const unsigned e = F.bid, c = cnt[e], pe = (c + 255u) & ~255u;
        for (unsigned i = c + F.tid; i < pe; i += NTHR) { ROWOFF[pstart[e] + i] = 0u; } }
    (void)layer;
}

__device__ __attribute__((noinline)) void combine_phase_ol(unsigned char* ws_, int tid_, int wave_, int bid_, int layer, float* xout, int nrows, int next_pre_) {
    extern __shared__ __attribute__((aligned(16))) unsigned char lds_raw2[];
    Frame F; F.lds = (LAS unsigned char*)lds_raw2; F.ws = ws_; F.ctl = (unsigned*)(ws_ + WS_CTL); F.tid = tid_; F.lane = tid_ & 63; F.wave = wave_; F.bid = bid_; const bool next_pre = next_pre_ != 0;
    const unsigned char* MO = (const unsigned char*)(F.ws + WS_ARENA + AR_MO); const int* TOKS = (const int*)(F.ws + WS_META + MT_TOKS); const float* TOKG = (const float*)(F.ws + WS_META + MT_TOKG);
    const unsigned sslot0 = ((LAS unsigned*)(F.lds + TBL_OFF + 2816))[0] << 8;
    const float* g3 = AIN(6) + (size_t)(layer * 4 + 3) * DM; const float* g0n = AIN(6) + (size_t)((layer + 1 < NLAYER ? layer + 1 : layer) * 4 + 0) * DM; const int rpb = nrows / F.G;
    LAS float* VA3 = (LAS float*)F.lds; LAS float* VA0 = VA3 + DM; LAS float* VB0 = VA0 + DM;
    int cur_mr = -1;
    int sv = TOKS[(F.bid * rpb + F.wave) * 8 + (F.lane & 7)]; float gv = TOKG[(F.bid * rpb + F.wave) * 8 + (F.lane & 7)];
    __syncthreads();
    for (int i = 0; i < rpb / 8; ++i) { const int row = F.bid * rpb + i * 8 + F.wave; const int mr_ = modrow(F.bid * rpb + i * 8);
        if (mr_ != cur_mr) { cur_mr = mr_; __syncthreads(); int c = 4 * F.tid; asm volatile("" : "+v"(c));
            *(LAS f32x4*)(VA3 + c) = *(const f32x4*)(mod_vec(F, layer, mr_, 5) + c) * *(const f32x4*)(g3 + c);
            if (next_pre) { *(LAS f32x4*)(VA0 + c) = *(const f32x4*)(g0n + c) * (*(const f32x4*)(mod_vec(F, layer + 1, mr_, 1) + c) + 1.0f); *(LAS f32x4*)(VB0 + c) = *(const f32x4*)(mod_vec(F, layer + 1, mr_, 0) + c); }
            __syncthreads(); }
        unsigned slot[9]; float gk[9];
#pragma unroll
        for (int k = 0; k < 8; ++k) { slot[k] = (unsigned)__builtin_amdgcn_readlane(sv, k); gk[k] = rdlane(gv, k) * (1.0f / S_MO); }
        slot[8] = sslot0 + (unsigned)row; gk[8] = 1.0f / S_MO;
        if (i + 1 < rpb / 8) { sv = TOKS[(row + 8) * 8 + (F.lane & 7)]; gv = TOKG[(row + 8) * 8 + (F.lane & 7)]; }
        bf16_t* xr = row < RL ? (bf16_t*)(F.ws + WS_ARENA + AR_XLB) + (size_t)row * DM : (bf16_t*)(F.ws + WS_XC) + (size_t)(row - RL) * DM;
        float f[4][8];
#pragma unroll
        for (int j = 0; j < 4; ++j)
#pragma unroll
            for (int e = 0; e < 8; ++e) f[j][e] = 0.f;
#pragma unroll
        for (int k3 = 0; k3 < 9; k3 += 3) { u32x2 w[3][4];
#pragma unroll
            for (int q = 0; q < 3; ++q)
#pragma unroll
                for (int j = 0; j < 4; ++j) w[q][j] = *(const u32x2*)(MO + (size_t)slot[k3 + q] * DM + 512 * j + 8 * F.lane);
#pragma unroll
            for (int q = 0; q < 3; ++q)
#pragma unroll
                for (int j = 0; j < 4; ++j) { const f32x2 p0 = __builtin_amdgcn_cvt_pk_f32_fp8((int)w[q][j].x, false), p1 = __builtin_amdgcn_cvt_pk_f32_fp8((int)w[q][j].x, true), p2 = __builtin_amdgcn_cvt_pk_f32_fp8((int)w[q][j].y, false), p3 = __builtin_amdgcn_cvt_pk_f32_fp8((int)w[q][j].y, true);
                    const float g = gk[k3 + q]; f[j][0] += p0.x * g; f[j][1] += p0.y * g; f[j][2] += p1.x * g; f[j][3] += p1.y * g; f[j][4] += p2.x * g; f[j][5] += p2.y * g; f[j][6] += p3.x * g; f[j][7] += p3.y * g; } }
        float ss = 0.f;
#pragma unroll
        for (int j = 0; j < 4; ++j)
#pragma unroll
            for (int e = 0; e < 8; ++e) ss += f[j][e] * f[j][e];
        const float rstd = rsqrtf(wave_sum(ss) * (1.0f / DM) + RMS_EPS);
        float ss2 = 0.f;
#pragma unroll
        for (int j = 0; j < 4; ++j) { const int c8 = 512 * j + 8 * F.lane; const u32x4 xw = *(const u32x4*)(xr + c8);
            const float xv[8] = {bflo(xw.x), bfhi(xw.x), bflo(xw.y), bfhi(xw.y), bflo(xw.z), bfhi(xw.z), bflo(xw.w), bfhi(xw.w)};
#pragma unroll
            for (int h2 = 0; h2 < 2; ++h2) { const f32x4 a3 = *(const LAS f32x4*)(VA3 + c8 + 4 * h2);
#pragma unroll
                for (int e = 0; e < 4; ++e) { const float o = xv[4 * h2 + e] + a3[e] * (f[j][4 * h2 + e] * rstd); f[j][4 * h2 + e] = o; ss2 += o * o; } }
            if (next_pre) *(u32x4*)(xr + c8) = (u32x4){pk2(f[j][0], f[j][1]), pk2(f[j][2], f[j][3]), pk2(f[j][4], f[j][5]), pk2(f[j][6], f[j][7])};
            else { float* xo = xout + (size_t)row * DM + c8; *(f32x4*)xo = (f32x4){f[j][0], f[j][1], f[j][2], f[j][3]}; *(f32x4*)(xo + 4) = (f32x4){f[j][4], f[j][5], f[j][6], f[j][7]}; } }
        if (next_pre) { const float r2 = rsqrtf(wave_sum(ss2) * (1.0f / DM) + RMS_EPS); bf16_t* hrow = (bf16_t*)(F.ws + WS_H) + (size_t)row * DM;
#pragma unroll
            for (int j = 0; j < 4; ++j) { const int c = 512 * j + 8 * F.lane; float h[8];
#pragma unroll
                for (int h2 = 0; h2 < 2; ++h2) { const f32x4 a0 = *(const LAS f32x4*)(VA0 + c + 4 * h2), b0 = *(const LAS f32x4*)(VB0 + c + 4 * h2);
#pragma unroll
                    for (int e = 0; e < 4; ++e) h[4 * h2 + e] = f[j][4 * h2 + e] * r2 * a0[e] + b0[e]; }
                if (IN_FP8[1]) { u32x2 w8; w8.x = pg8::pk4_fp8(h[0], h[1], h[2], h[3]); w8.y = pg8::pk4_fp8(h[4], h[5], h[6], h[7]); *(u32x2*)((unsigned char*)(F.ws + WS_H) + (size_t)row * DM + c) = w8; }
                else { u32x4 wq; wq.x = pk2(h[0], h[1]); wq.y = pk2(h[2], h[3]); wq.z = pk2(h[4], h[5]); wq.w = pk2(h[6], h[7]); *(u32x4*)(hrow + c) = wq; } } }
    }
    __syncthreads();
}

DI void qkv_prep_rows(const Frame& F, const Args& a, int layer) {
    const int gw = F.bid * NWAVES + F.wave, NGW = F.G * NWAVES;
    const bf16_t* P = (const bf16_t*)(F.ws + WS_ARENA + AR_P);
    bf16_t* QC = (bf16_t*)(F.ws + WS_ARENA + AR_QC); bf16_t* KC = (bf16_t*)(F.ws + WS_ARENA + AR_KC); bf16_t* VC = (bf16_t*)(F.ws + WS_ARENA + AR_VC);
    bf16_t* QD = (bf16_t*)(F.ws + WS_ARENA + AR_QD); bf16_t* KD = (bf16_t*)(F.ws + WS_ARENA + AR_KD); bf16_t* VD = (bf16_t*)(F.ws + WS_ARENA + AR_VD);
    const int hh = F.lane >> 4, lp = F.lane & 15, ax = lp >> 3, second = (lp >> 2) & 1, d0 = 8 * lp;
    float invf[8], gq[8], gk[8];
#pragma unroll
    for (int j = 0; j < 8; ++j) { invf[j] = exp2f(-(float)((lp & 3) * 8 + j) * (13.287712379549449f / 32.0f)); gq[j] = AIN(19)[(layer * 2 + 0) * 128 + d0 + j]; gk[j] = AIN(19)[(layer * 2 + 1) * 128 + d0 + j]; }
    u32x4 nq_c, nk_c, nq_d, nk_d;
    { const bf16_t* Pr = P + (size_t)gw * PC; nq_c = *(const u32x4*)(Pr + C_CQ + 8 * F.lane); nk_c = *(const u32x4*)(Pr + C_CK + 8 * F.lane); nq_d = *(const u32x4*)(Pr + C_DQ + 8 * F.lane); nk_d = *(const u32x4*)(Pr + C_DK + 8 * F.lane); }
#pragma unroll 1
    for (int row = gw; row < RT; row += NGW) {
        const bool lat = row < RL; int b, t, kidx;
        if (lat) { b = row >> 11; t = row & 2047; kidx = CTXL + t; } else { const int rr = row - RL; b = rr >> 8; t = rr & 255; kidx = t; }
        const u32x4 wq_c = nq_c, wk_c = nk_c, wq_d = nq_d, wk_d = nk_d;
        if (row + NGW < RT) { const bf16_t* Pr = P + (size_t)(row + NGW) * PC; nq_c = *(const u32x4*)(Pr + C_CQ + 8 * F.lane); nk_c = *(const u32x4*)(Pr + C_CK + 8 * F.lane); nq_d = *(const u32x4*)(Pr + C_DQ + 8 * F.lane); nk_d = *(const u32x4*)(Pr + C_DK + 8 * F.lane); }
        float cs[8], sn[8];
        { const float pos = (float)(ax == 0 ? (t >> 6) : (t & 63));
#pragma unroll
          for (int j = 0; j < 8; ++j) { const float ang = pos * invf[j]; cs[j] = lat ? __cosf(ang) : 1.0f; sn[j] = lat ? __sinf(ang) : 0.0f; } }
#define QK_ONE(W_, NORM_, G_, OUT_) do { float x[8] = {bflo(W_.x), bfhi(W_.x), bflo(W_.y), bfhi(W_.y), bflo(W_.z), bfhi(W_.z), bflo(W_.w), bfhi(W_.w)}; \
        if (NORM_) { float ss = 0.f; _Pragma("unroll") for (int j = 0; j < 8; ++j) ss += x[j] * x[j]; DPP_ADD(ss, 0xB1); DPP_ADD(ss, 0x4E); DPP_ADD(ss, 0x141); DPP_ADD(ss, 0x140); \
            const float rs = rsqrtf(ss * (1.0f / 128.0f) + RMS_EPS); _Pragma("unroll") for (int j = 0; j < 8; ++j) x[j] = x[j] * rs * G_[j]; } \
        float o[8]; _Pragma("unroll") for (int j = 0; j < 8; ++j) { const float p = __shfl_xor(x[j], 4); o[j] = second ? (p * sn[j] + x[j] * cs[j]) : (x[j] * cs[j] - p * sn[j]); } \
        OUT_.x = pk2(o[0], o[1]); OUT_.y = pk2(o[2], o[3]); OUT_.z = pk2(o[4], o[5]); OUT_.w = pk2(o[6], o[7]); } while (0)
        u32x4 oq_c, ok_c, oq_d, ok_d;
        QK_ONE(wq_c, true, gq, oq_c); QK_ONE(wk_c, true, gk, ok_c); QK_ONE(wq_d, false, gq, oq_d); QK_ONE(wk_d, false, gk, ok_d);
#undef QK_ONE
        *(u32x4*)(QC + ((size_t)(b * 4 + hh) * KT + kidx) * 128 + d0) = oq_c; *(u32x4*)(QD + ((size_t)(b * 4 + hh) * KT + kidx) * 128 + d0) = oq_d;
        if (hh < 2) { *(u32x4*)(KC + ((size_t)(b * 2 + hh) * KT + kidx) * 128 + d0) = ok_c; *(u32x4*)(KD + ((size_t)(b * 2 + hh) * KT + kidx) * 128 + d0) = ok_d; }
        else { *(u32x4*)(VC + ((size_t)(b * 2 + hh - 2) * KT + kidx) * 128 + d0) = wk_c; *(u32x4*)(VD + ((size_t)(b * 2 + hh - 2) * KT + kidx) * 128 + d0) = wk_d; }
    }
}


DI float expm1_neg(float x) {
    const float p = x * (1.0f + x * (0.5f + x * (0.16666667f + x * (0.041666668f + x * (0.0083333338f + x * 0.0013888889f)))));
    return x > -0.25f ? p : __expf(x) - 1.0f;
}
DI void lru_gate_weights(const Frame& F, int layer, int hd) {
    const int h = hd >> 1, d = hd & 1; LAS unsigned char* wl = F.lds + 34816; const bf16_t* LRUW = (const bf16_t*)(F.ws + WS_LRUW);
#pragma unroll
    for (int i = 0; i < 8; ++i) { const int idx = F.tid + i * NTHR; const int g = idx >> 11, rem = idx & 2047, o = rem >> 4, ch = rem & 15;
        *(LAS u32x4*)(wl + g * 34816 + o * 272 + ch * 16) = *(const u32x4*)(LRUW + ((size_t)((layer * 2 + d) * 2 + g) * 4 + h) * 16384 + o * 128 + ch * 8); }
    if (F.tid < 128) { LAS float* vb = (LAS float*)(F.lds + 34816 + 2 * 34816); const int cc = (layer * 2 + d) * 512 + h * 128 + F.tid;
        vb[F.tid] = AIN(12)[cc]; vb[128 + F.tid] = AIN(14)[cc]; vb[256 + F.tid] = ((const float*)(F.ws + WS_SP))[cc]; }
}
DI void lru_gate_rows(const Frame& F, int unit, u32x2 (&raw)[11]) {
    const int tile = unit >> 3, h = (unit & 7) >> 1; int segrow0, seglen, t0;
    if (tile < 128) { const int b = tile >> 4; t0 = (tile & 15) * 128; segrow0 = b * SEQ; seglen = SEQ; } else { const int tt = tile - 128; const int b = tt >> 1; t0 = (tt & 1) * 128; segrow0 = RL + b * CTXL; seglen = CTXL; }
    const bf16_t* P = (const bf16_t*)(F.ws + WS_ARENA + AR_P); const int c4 = F.tid & 31, tr = F.tid >> 5; const int ch = h * 128 + 4 * c4;
#pragma unroll
    for (int i = 0; i < 11; ++i) { const int ti = t0 + tr * 8 - 2 + i; raw[i] = (u32x2){0u, 0u}; if (ti >= 0 && ti < seglen) raw[i] = *(const u32x2*)(P + (size_t)(segrow0 + ti) * PC + C_AX + ch); }
}
DI void lru_gate_unit(const Frame& F, const Args& a, int layer, int unit, u32x2 (&raw)[11], int next_unit) {
    const int tile = unit >> 3, h = (unit & 7) >> 1, d = unit & 1;
    int segrow0, seglen, t0;
    if (tile < 128) { const int b = tile >> 4; t0 = (tile & 15) * 128; segrow0 = b * SEQ; seglen = SEQ; } else { const int tt = tile - 128; const int b = tt >> 1; t0 = (tt & 1) * 128; segrow0 = RL + b * CTXL; seglen = CTXL; }
    const bf16_t* P = (const bf16_t*)(F.ws + WS_ARENA + AR_P);
    LAS unsigned char* ub = F.lds;
    LAS unsigned char* wl = F.lds + 34816;
    { const int c4 = F.tid & 31, tr = F.tid >> 5; const int ch = h * 128 + 4 * c4;
      f32x4 w[4];
#pragma unroll
      for (int j = 0; j < 4; ++j) w[j] = *(const f32x4*)(AIN(9) + (size_t)(layer * 4 + j) * 512 + ch);
      const f32x4 cb = *(const f32x4*)(AIN(10) + layer * 512 + ch);
      f32x4 x[11];
#pragma unroll
      for (int i = 0; i < 11; ++i) x[i] = (f32x4){bflo(raw[i].x), bfhi(raw[i].x), bflo(raw[i].y), bfhi(raw[i].y)};
#pragma unroll
      for (int tk = 0; tk < 8; ++tk) { f32x4 u = cb;
#pragma unroll
          for (int j = 0; j < 4; ++j) u += w[j] * x[tk + j];
          const int r = tr * 8 + tk; u32x2 pw; pw.x = pk2(u.x, u.y); pw.y = pk2(u.z, u.w); *(LAS u32x2*)(ub + r * 272 + 8 * c4) = pw; } }
    __syncthreads();
    if (next_unit < 1152) lru_gate_rows(F, next_unit, raw);
    const int fr = F.lane & 15, fq = F.lane >> 4, w16 = F.wave * 16;
    bf16x8 af[4];
#pragma unroll
    for (int ks = 0; ks < 4; ++ks) af[ks] = *(const LAS bf16x8*)(ub + (w16 + fr) * 272 + (ks * 32 + fq * 8) * 2);
    unsigned* LAB = (unsigned*)(F.ws + WS_ARENA + AR_LA);
#pragma unroll 4
    for (int nb = 0; nb < 8; ++nb) {
        f32x4 ar = {0.f, 0.f, 0.f, 0.f}, ai = {0.f, 0.f, 0.f, 0.f};
#pragma unroll
        for (int ks = 0; ks < 4; ++ks) { const bf16x8 wr = *(const LAS bf16x8*)(wl + (nb * 16 + fr) * 272 + (ks * 32 + fq * 8) * 2), wi = *(const LAS bf16x8*)(wl + 34816 + (nb * 16 + fr) * 272 + (ks * 32 + fq * 8) * 2);
            ar = MFMA16(wr, af[ks], ar); ai = MFMA16(wi, af[ks], ai); }
        const int c = nb * 16 + 4 * fq; const LAS float* vb = (const LAS float*)(F.lds + 34816 + 2 * 34816); const f32x4 vbr = *(const LAS f32x4*)(vb + c), vbi = *(const LAS f32x4*)(vb + 128 + c), vl = *(const LAS f32x4*)(vb + 256 + c);
        const u32x2 uw = *(const LAS u32x2*)(ub + (w16 + fr) * 272 + c * 2); const float uu[4] = {bflo(uw.x), bfhi(uw.x), bflo(uw.y), bfhi(uw.y)};
        f32x4 oa, ob;
#pragma unroll
        for (int j = 0; j < 4; ++j) { const float r = __builtin_amdgcn_rcpf(1.0f + __expf(-(ar[j] + vbr[j]))), ii = __builtin_amdgcn_rcpf(1.0f + __expf(-(ai[j] + vbi[j])));
            const float la = -8.0f * r * vl[j]; const float om = -expm1_neg(la);
            oa[j] = om; ob[j] = __builtin_amdgcn_sqrtf(om * (2.0f - om)) * (ii * uu[j]); }
        const size_t o = ((size_t)d * RT + segrow0 + t0 + w16 + fr) * 512 + h * 128 + c;
        *(u32x4*)(LAB + o) = (u32x4){pk2(oa[0], ob[0]), pk2(oa[1], ob[1]), pk2(oa[2], ob[2]), pk2(oa[3], ob[3])};
    }
    __syncthreads();
}

DI float log_sigmoidf_(float x) { const float e = __expf(-fabsf(x)); const float l1p = e < 1e-3f ? e * (1.0f - 0.5f * e) : __logf(1.0f + e); return fminf(x, 0.f) - l1p; }
DI void gla_a_unit(const Frame& F, const Args& a, int layer, int unit) {
    const int cg = unit >> 2, head = unit & 3; int b, row0, cc;
    if (cg < 256) { b = cg >> 5; const int ci = cg & 31; row0 = b * SEQ + ci * 64; cc = 4 + ci; } else { const int cx = cg - 256; b = cx >> 2; const int ci = cx & 3; row0 = RL + b * CTXL + ci * 64; cc = ci; }
    const bf16_t* P = (const bf16_t*)(F.ws + WS_ARENA + AR_P);
    LAS unsigned char* L = F.lds;
    LAS unsigned char* QR = L; LAS unsigned char* KR = L + 8192; LAS float* ZF = (LAS float*)(L + 16384); LAS float* ZB = (LAS float*)(L + 20480); LAS float* TOT = (LAS float*)(L + 24576);
    LAS unsigned char* QE = L + 28672; LAS unsigned char* KE = QE + 2 * 9216; LAS unsigned char* KD = KE + 2 * 9216; LAS unsigned char* VI = KD + 2 * 9216;
    { const int t = F.tid >> 3, c8 = (F.tid & 7) * 8; const bf16_t* pr = P + (size_t)(row0 + t) * PC;
      *(LAS u32x4*)(QR + t * 128 + c8 * 2) = *(const u32x4*)(pr + C_BQ + head * 64 + c8); *(LAS u32x4*)(KR + t * 128 + c8 * 2) = *(const u32x4*)(pr + C_BK + head * 64 + c8);
      const int c16 = (F.tid & 7) * 16; *(LAS u32x4*)(VI + t * 272 + c16 * 2) = *(const u32x4*)(pr + C_BV + head * 128 + c16); *(LAS u32x4*)(VI + t * 272 + c16 * 2 + 16) = *(const u32x4*)(pr + C_BV + head * 128 + c16 + 8);
      if (F.tid < 256) { const int tz = F.tid >> 2, q4 = (F.tid & 3) * 4; const bf16_t* pz = P + (size_t)(row0 + tz) * PC; const u32x2 zf = *(const u32x2*)(pz + C_ZF + q4), zb = *(const u32x2*)(pz + C_ZB + q4);
          *(LAS f32x4*)(ZF + tz * 16 + q4) = (f32x4){bflo(zf.x), bfhi(zf.x), bflo(zf.y), bfhi(zf.y)}; *(LAS f32x4*)(ZB + tz * 16 + q4) = (f32x4){bflo(zb.x), bfhi(zb.x), bflo(zb.y), bfhi(zb.y)}; } }
    __syncthreads();
    const int j = F.tid & 63, grp = F.tid >> 6;
    float cf[8], cb[8];
    { float wf[16], wb[16];
#pragma unroll
      for (int r = 0; r < 16; ++r) { wf[r] = AIN(16)[((size_t)(layer * 2 + 0) * 16 + r) * 256 + head * 64 + j]; wb[r] = AIN(16)[((size_t)(layer * 2 + 1) * 16 + r) * 256 + head * 64 + j]; }
      const float b2f = AIN(17)[(layer * 2 + 0) * 256 + head * 64 + j], b2b = AIN(17)[(layer * 2 + 1) * 256 + head * 64 + j];
#pragma unroll
      for (int tk = 0; tk < 8; ++tk) { const int t = grp * 8 + tk; float xf = b2f, xb = b2b;
#pragma unroll
          for (int r4 = 0; r4 < 4; ++r4) { const f32x4 zf = *(const LAS f32x4*)(ZF + t * 16 + 4 * r4), zb = *(const LAS f32x4*)(ZB + t * 16 + 4 * r4);
              xf += (zf.x * wf[4 * r4] + zf.y * wf[4 * r4 + 1]) + (zf.z * wf[4 * r4 + 2] + zf.w * wf[4 * r4 + 3]); xb += (zb.x * wb[4 * r4] + zb.y * wb[4 * r4 + 1]) + (zb.z * wb[4 * r4 + 2] + zb.w * wb[4 * r4 + 3]); }
          cf[tk] = log_sigmoidf_(xf) * (1.0f / 16.0f); cb[tk] = log_sigmoidf_(xb) * (1.0f / 16.0f); }
#pragma unroll
      for (int tk = 1; tk < 8; ++tk) cf[tk] += cf[tk - 1];
#pragma unroll
      for (int tk = 6; tk >= 0; --tk) cb[tk] += cb[tk + 1];
      TOT[(0 * 8 + grp) * 64 + j] = cf[7]; TOT[(1 * 8 + grp) * 64 + j] = cb[0]; }
    __syncthreads();
    { float pf = 0.f, sb = 0.f, lastf = 0.f, lastb = 0.f;
#pragma unroll
      for (int g = 0; g < 8; ++g) { const float tf = TOT[(0 * 8 + g) * 64 + j], tb = TOT[(1 * 8 + g) * 64 + j]; lastf += tf; lastb += tb; pf += (g < grp) ? tf : 0.f; sb += (g > grp) ? tb : 0.f; }
      bf16_t* GQE = (bf16_t*)(F.ws + WS_ARENA + AR_GQE);
#pragma unroll
      for (int tk = 0; tk < 8; ++tk) { const int t = grp * 8 + tk; const float cumf = pf + cf[tk], cumb = sb + cb[tk];
          const float q = bf2f(*(const LAS unsigned short*)(QR + t * 128 + j * 2)) * 0.125f, k = bf2f(*(const LAS unsigned short*)(KR + t * 128 + j * 2));
          const unsigned qef = f2bf(q * __expf(cumf)), qeb = f2bf(q * __expf(cumb));
          *(LAS unsigned short*)(QE + t * 144 + j * 2) = (unsigned short)qef; *(LAS unsigned short*)(QE + 9216 + t * 144 + j * 2) = (unsigned short)qeb;
          *(LAS unsigned short*)(KE + t * 144 + j * 2) = (unsigned short)f2bf(k * __expf(-cumf)); *(LAS unsigned short*)(KE + 9216 + t * 144 + j * 2) = (unsigned short)f2bf(k * __expf(-cumb));
          *(LAS unsigned short*)(KD + t * 144 + j * 2) = (unsigned short)f2bf(k * __expf(lastf - cumf)); *(LAS unsigned short*)(KD + 9216 + t * 144 + j * 2) = (unsigned short)f2bf(k * __expf(lastb - cumb));
          GQE[((size_t)0 * RT + row0 + t) * 256 + head * 64 + j] = (bf16_t)qef; GQE[((size_t)1 * RT + row0 + t) * 256 + head * 64 + j] = (bf16_t)qeb; }
      if (grp == 0) { float* GD = (float*)(F.ws + WS_GLAD); GD[((size_t)((b * 4 + head) * 2 + 0) * NCHUNK + cc) * 64 + j] = __expf(lastf); GD[((size_t)((b * 4 + head) * 2 + 1) * NCHUNK + cc) * 64 + j] = __expf(lastb); } }
    __syncthreads();
    const int fr = F.lane & 15, fq = F.lane >> 4, q_ = (F.lane & 15) >> 2, p_ = F.lane & 3;
    const unsigned vbase = (unsigned)(uintptr_t)VI;
    {
      const int tb = F.wave & 3, vh = F.wave >> 2;
      f32x4 oacc[4];
#pragma unroll
      for (int i = 0; i < 4; ++i) oacc[i] = (f32x4){0.f, 0.f, 0.f, 0.f};
#pragma unroll
      for (int d = 0; d < 2; ++d) {
          f32x4 st[4];
#pragma unroll
          for (int si = 0; si < 4; ++si) { st[si] = (f32x4){0.f, 0.f, 0.f, 0.f};
#pragma unroll
              for (int ks = 0; ks < 2; ++ks) { const bf16x8 ka = *(const LAS bf16x8*)(KE + d * 9216 + (16 * si + fr) * 144 + (ks * 32 + fq * 8) * 2), qb = *(const LAS bf16x8*)(QE + d * 9216 + (16 * tb + fr) * 144 + (ks * 32 + fq * 8) * 2);
                  st[si] = MFMA16(ka, qb, st[si]); }
              const int t_ = 16 * tb + fr;
#pragma unroll
              for (int jj = 0; jj < 4; ++jj) { const int s_ = 16 * si + 4 * fq + jj; const bool keep = d == 0 ? (s_ <= t_) : (s_ >= t_); st[si][jj] = keep ? st[si][jj] : 0.f; } }
#pragma unroll
          for (int kk = 0; kk < 2; ++kk) { u32x4 pw; pw.x = cvt_pk_bf16(st[2 * kk][0], st[2 * kk][1]); pw.y = cvt_pk_bf16(st[2 * kk][2], st[2 * kk][3]); pw.z = cvt_pk_bf16(st[2 * kk + 1][0], st[2 * kk + 1][1]); pw.w = cvt_pk_bf16(st[2 * kk + 1][2], st[2 * kk + 1][3]);
              const bf16x8 pa = __builtin_bit_cast(bf16x8, pw);
#pragma unroll
              for (int i = 0; i < 4; ++i) { const unsigned col = (unsigned)((vh * 4 + i) * 16 + 4 * p_) * 2u;
                  const bf16x8 vf = tr_read_pair(vbase + (unsigned)(32 * kk + 4 * fq + q_) * 272u + col, vbase + (unsigned)(32 * kk + 16 + 4 * fq + q_) * 272u + col);
                  oacc[i] = MFMA16(vf, pa, oacc[i]); } }
      }
      bf16_t* GOI = (bf16_t*)(F.ws + WS_ARENA + AR_GOI);
#pragma unroll
      for (int i = 0; i < 4; ++i) *(u32x2*)(GOI + (size_t)(row0 + 16 * tb + fr) * 512 + head * 128 + (vh * 4 + i) * 16 + 4 * fq) = (u32x2){pk2(oacc[i][0], oacc[i][1]), pk2(oacc[i][2], oacc[i][3])};
    }
    {
      bf16_t* GS = (bf16_t*)(F.ws + WS_ARENA + AR_GS);
#pragma unroll
      for (int d = 0; d < 2; ++d) {
          const unsigned kdb = (unsigned)(uintptr_t)(KD + d * 9216);
          bf16x8 va[2];
#pragma unroll
          for (int ks = 0; ks < 2; ++ks) { const unsigned a0 = vbase + (unsigned)(32 * ks + 8 * fq + q_) * 272u + (unsigned)(16 * F.wave + 4 * p_) * 2u; va[ks] = tr_read_pair(a0, a0 + 4u * 272u); }
#pragma unroll
          for (int jp = 0; jp < 4; jp += 2) { u32x2 w2[2];
#pragma unroll
              for (int jq = 0; jq < 2; ++jq) { const int jt = jp + jq; bf16x8 kb[2];
#pragma unroll
                  for (int ks = 0; ks < 2; ++ks) { const unsigned a0 = kdb + (unsigned)(32 * ks + 8 * fq + q_) * 144u + (unsigned)(16 * jt + 4 * p_) * 2u; kb[ks] = tr_read_pair(a0, a0 + 4u * 144u); }
                  f32x4 u = {0.f, 0.f, 0.f, 0.f};
#pragma unroll
                  for (int ks = 0; ks < 2; ++ks) u = MFMA16(kb[ks], va[ks], u);
                  w2[jq] = (u32x2){pk2(u[0], u[1]), pk2(u[2], u[3])}; }
              const auto rx = __builtin_amdgcn_permlane16_swap(w2[0].x, w2[1].x, false, false); const auto ry = __builtin_amdgcn_permlane16_swap(w2[0].y, w2[1].y, false, false);
              const int odd = fq & 1; bf16_t* dst = GS + ((size_t)((b * 4 + head) * 2 + d) * NCHUNK + cc) * 8192;
              *(u32x4*)(dst + (16 * F.wave + fr) * 64 + 16 * (jp + odd) + 4 * (fq - odd)) = (u32x4){rx[0], ry[0], rx[1], ry[1]}; }
      }
    }
    __syncthreads();
}

template <int STP> DI void lru_scan_dir(const unsigned* pab, unsigned* phc) {
    float h = 0.f, cp = 1.f; unsigned w0[32], w1[32];
#define LS_LOAD(W_) do { _Pragma("unroll") for (int i = 0; i < 32; ++i) W_[i] = pab[i * STP]; pab += 32 * STP; } while (0)
#define LS_STEP(W_) do { _Pragma("unroll") for (int i = 0; i < 32; ++i) { const float a_ = 1.0f - bflo(W_[i]); h = a_ * h + bfhi(W_[i]); cp *= a_; phc[i * STP] = pk2(h, cp); } phc += 32 * STP; } while (0)
    LS_LOAD(w0);
#pragma unroll 1
    for (int t = 0; t < 256; t += 64) { LS_LOAD(w1); LS_STEP(w0); if (t + 64 < 256) LS_LOAD(w0); LS_STEP(w1); }
#undef LS_LOAD
#undef LS_STEP
}
DI void lru_scan_unit(const Frame& F, int unit) {
    const int seg = unit % 9, bd = unit / 9, b = bd >> 1, d = bd & 1; const int c = F.wave * 64 + F.lane;
    const int r0 = seg == 0 ? RL + b * CTXL : b * SEQ + (seg - 1) * 256;
    const size_t base = ((size_t)d * RT + (d == 0 ? r0 : r0 + 255)) * 512 + c;
    const unsigned* pab = (const unsigned*)(F.ws + WS_ARENA + AR_LA) + base; unsigned* phc = (unsigned*)(F.ws + WS_ARENA + AR_LH) + base;
    if (d == 0) lru_scan_dir<512>(pab, phc); else lru_scan_dir<-512>(pab, phc);
}
DI void lru_final_unit(const Frame& F, int unit4) {
    const int unit = unit4 >> 2, qtr = unit4 & 3; const int b = unit / 9, seg = unit % 9; const int c = F.tid;
    const unsigned* LHC = (const unsigned*)(F.ws + WS_ARENA + AR_LH) + c;
    const bf16_t* P = (const bf16_t*)(F.ws + WS_ARENA + AR_P); bf16_t* Y = (bf16_t*)(F.ws + WS_Y);
    unsigned wf[8], wb[9];
#pragma unroll
    for (int s2 = 0; s2 < 8; ++s2) { const size_t r = (s2 == 0 ? RL + b * CTXL : b * SEQ + (s2 - 1) * 256) + 255; wf[s2] = LHC[r * 512]; }
    wb[0] = LHC[((size_t)RT + RL + b * CTXL) * 512];
#pragma unroll
    for (int s2 = 1; s2 <= 8; ++s2) wb[s2] = LHC[((size_t)RT + b * SEQ + (s2 - 1) * 256) * 512];
    float cf = 0.f, cb = 0.f;
#pragma unroll
    for (int s2 = 0; s2 < 8; ++s2) if (s2 < seg) cf = bfhi(wf[s2]) * cf + bflo(wf[s2]);
    if (seg > 0) { cb = bflo(wb[0]);
#pragma unroll
        for (int s2 = 8; s2 >= 1; --s2) if (s2 > seg) cb = bfhi(wb[s2]) * cb + bflo(wb[s2]); }
    const size_t r0 = (seg == 0 ? RL + b * CTXL : b * SEQ + (seg - 1) * 256) + qtr * 64;
    const unsigned* pf = LHC + r0 * 512; const unsigned* pb = LHC + ((size_t)RT + r0) * 512;
    const bf16_t* px = P + r0 * PC + C_AG + c; bf16_t* py = Y + r0 * DM + c;
    unsigned fa[8], ba[8], fb[8], bb[8]; unsigned short xa[8], xb[8];
#define LF_LOAD(F_, B_, X_) do { _Pragma("unroll") for (int i = 0; i < 8; ++i) { F_[i] = pf[i * 512]; B_[i] = pb[i * 512]; X_[i] = (unsigned short)px[(size_t)i * PC]; } pf += 8 * 512; pb += 8 * 512; px += (size_t)8 * PC; } while (0)
#define LF_STEP(F_, B_, X_) do { _Pragma("unroll") for (int i = 0; i < 8; ++i) { const float hf = bflo(F_[i]) + bfhi(F_[i]) * cf, hb = bflo(B_[i]) + bfhi(B_[i]) * cb; const float x = bf2f(X_[i]); \
        const float ge = x / (1.0f + __expf(-1.5957691216057308f * (x + 0.044715f * x * x * x)));        \
        py[(size_t)i * DM] = (bf16_t)f2bf((hf + hb) * ge); } py += (size_t)8 * DM; } while (0)
    LF_LOAD(fa, ba, xa);
#pragma unroll 1
    for (int t = 0; t < 64; t += 16) { LF_LOAD(fb, bb, xb); LF_STEP(fa, ba, xa); if (t + 16 < 64) LF_LOAD(fa, ba, xa); LF_STEP(fb, bb, xb); }
#undef LF_LOAD
#undef LF_STEP
}
DI int gla_cc(int d, int step) { return d == 0 ? step : (step < 4 ? 3 - step : 39 - step); }
DI void gla_b_unit(const Frame& F, int chain) {
    const int d = chain & 1; const bf16_t* GS = (const bf16_t*)(F.ws + WS_ARENA + AR_GS) + (size_t)chain * NCHUNK * 8192 + F.tid * 4; bf16_t* GSB = (bf16_t*)(F.ws + WS_ARENA + AR_GSB) + (size_t)chain * NCHUNK * 8192 + F.tid * 4; const float* GD = (const float*)(F.ws + WS_GLAD) + (size_t)chain * NCHUNK * 64 + (F.tid & 15) * 4;
    f32x4 S[4], Dv[6]; u32x2 U[6][4];
#pragma unroll
    for (int i = 0; i < 4; ++i) S[i] = (f32x4){0.f, 0.f, 0.f, 0.f};
#define GB_LOAD(slot_, step_) do { const int cc_ = gla_cc(d, (step_)); _Pragma("unroll") for (int i = 0; i < 4; ++i) U[slot_][i] = *(const u32x2*)(GS + (size_t)cc_ * 8192 + 2048 * i); Dv[slot_] = *(const f32x4*)(GD + cc_ * 64); } while (0)
#define GB_STEP(slot_, step_) do { const int cc_ = gla_cc(d, (step_)); _Pragma("unroll") for (int i = 0; i < 4; ++i) { *(u32x2*)(GSB + (size_t)cc_ * 8192 + 2048 * i) = (u32x2){pk2(S[i].x, S[i].y), pk2(S[i].z, S[i].w)}; S[i] = Dv[slot_] * S[i] + (f32x4){bflo(U[slot_][i].x), bfhi(U[slot_][i].x), bflo(U[slot_][i].y), bfhi(U[slot_][i].y)}; } } while (0)
    GB_LOAD(0, 0); GB_LOAD(1, 1); GB_LOAD(2, 2); GB_LOAD(3, 3); GB_LOAD(4, 4);
#pragma unroll 1
    for (int step = 0; step < NCHUNK; step += 6) {
        GB_LOAD(5, step + 5); GB_STEP(0, step);
        if (step + 6 < NCHUNK) GB_LOAD(0, step + 6); GB_STEP(1, step + 1);
        if (step + 7 < NCHUNK) GB_LOAD(1, step + 7); GB_STEP(2, step + 2);
        if (step + 8 < NCHUNK) GB_LOAD(2, step + 8); GB_STEP(3, step + 3);
        if (step + 9 < NCHUNK) GB_LOAD(3, step + 9); GB_STEP(4, step + 4);
        if (step + 10 < NCHUNK) GB_LOAD(4, step + 10); GB_STEP(5, step + 5);
    }
#undef GB_LOAD
#undef GB_STEP
}
DI void gla_c_unit(const Frame& F, const Args& a, int layer, int unit) {
    const int cg = unit >> 1, head = (unit & 1) * 2 + (F.wave >> 2), tb = F.wave & 3; int b, row0, cc;
    if (cg < 256) { b = cg >> 5; const int ci = cg & 31; row0 = b * SEQ + ci * 64; cc = 4 + ci; } else { const int cx = cg - 256; b = cx >> 2; const int ci = cx & 3; row0 = RL + b * CTXL + ci * 64; cc = ci; }
    const int fr = F.lane & 15, fq = F.lane >> 4;
    const bf16_t* GQE = (const bf16_t*)(F.ws + WS_ARENA + AR_GQE); const bf16_t* GSB = (const bf16_t*)(F.ws + WS_ARENA + AR_GSB); const bf16_t* GOI = (const bf16_t*)(F.ws + WS_ARENA + AR_GOI);
    const bf16_t* P = (const bf16_t*)(F.ws + WS_ARENA + AR_P); bf16_t* Y = (bf16_t*)(F.ws + WS_Y);
    f32x4 acc[8];
#pragma unroll
    for (int nt = 0; nt < 8; ++nt) acc[nt] = (f32x4){0.f, 0.f, 0.f, 0.f};
#pragma unroll
    for (int d = 0; d < 2; ++d) { const bf16_t* ST = GSB + ((size_t)((b * 4 + head) * 2 + d) * NCHUNK + cc) * 8192;
#pragma unroll
        for (int ks = 0; ks < 2; ++ks) { const bf16x8 af = *(const bf16x8*)(GQE + ((size_t)d * RT + row0 + 16 * tb + fr) * 256 + head * 64 + ks * 32 + fq * 8);
#pragma unroll
            for (int nt = 0; nt < 8; ++nt) acc[nt] = MFMA16(*(const bf16x8*)(ST + (nt * 16 + fr) * 64 + ks * 32 + fq * 8), af, acc[nt]); } }
    const size_t r = (size_t)(row0 + 16 * tb + fr);
    u32x2 gr[8], oi[8]; f32x4 gnv[8];
#pragma unroll
    for (int nt = 0; nt < 8; ++nt) { gnv[nt] = *(const f32x4*)(AIN(18) + layer * 128 + nt * 16 + 4 * fq); gr[nt] = *(const u32x2*)(P + r * PC + C_BG + head * 128 + nt * 16 + 4 * fq);
        oi[nt] = *(const u32x2*)(GOI + r * 512 + head * 128 + nt * 16 + 4 * fq); }
    float ssq = 0.f;
#pragma unroll
    for (int nt = 0; nt < 8; ++nt)
#pragma unroll
        for (int jj = 0; jj < 4; ++jj) { const unsigned ow = (jj < 2) ? oi[nt].x : oi[nt].y; acc[nt][jj] += (jj & 1) ? bfhi(ow) : bflo(ow); ssq += acc[nt][jj] * acc[nt][jj]; }
    ssq += __shfl_xor(ssq, 16); ssq += __shfl_xor(ssq, 32);
    const float rstd = rsqrtf(ssq * (1.0f / 128.0f) + RMS_EPS);
#pragma unroll
    for (int nt = 0; nt < 8; ++nt) { const float g[4] = {bflo(gr[nt].x), bfhi(gr[nt].x), bflo(gr[nt].y), bfhi(gr[nt].y)}; float y[4];
#pragma unroll
        for (int jj = 0; jj < 4; ++jj) y[jj] = acc[nt][jj] * rstd * gnv[nt][jj] * siluf_(g[jj]);
        *(u32x2*)(Y + r * DM + 512 + head * 128 + nt * 16 + 4 * fq) = (u32x2){pk2(y[0], y[1]), pk2(y[2], y[3])}; }
}
DI void scan_attn_phase(const Frame& F, const Args& a, int layer, bool need_ctx, int rep) {
    volatile LAS unsigned* qw = (volatile LAS unsigned*)(F.lds + MISC_OFF + 64);
    unsigned* head = F.ctl + CW_QUEUE + 64 * (layer + 2 * rep);
    const int n_units = 256 + 256 + (need_ctx ? 64 : 0);
    const bf16_t* QC = (const bf16_t*)(F.ws + WS_ARENA + AR_QC); const bf16_t* KC = (const bf16_t*)(F.ws + WS_ARENA + AR_KC); const bf16_t* VC = (const bf16_t*)(F.ws + WS_ARENA + AR_VC);
    const bf16_t* QD = (const bf16_t*)(F.ws + WS_ARENA + AR_QD); const bf16_t* KD = (const bf16_t*)(F.ws + WS_ARENA + AR_KD); const bf16_t* VD = (const bf16_t*)(F.ws + WS_ARENA + AR_VD);
    bf16_t* Y = (bf16_t*)(F.ws + WS_Y);
    for (int u = F.bid; u < 208; u += F.G) { if (u < 64) { if (rep == 0) gla_b_unit(F, u); } else lru_scan_unit(F, u - 64); }
    if (F.bid < 208 && rep == 0) { asm volatile("s_waitcnt vmcnt(0)" ::: "memory"); __syncthreads();
        if (F.tid == 0) { __builtin_amdgcn_fence(__ATOMIC_RELEASE, "agent"); asm volatile("s_waitcnt vmcnt(0)" ::: "memory"); (void)xb_add(F.ctl + CW_QUEUE + 64 * (4 + layer), 1u); } }
    for (;;) {
        __syncthreads();
        if (F.tid == 0) qw[0] = __hip_atomic_fetch_add(head, 1u, __ATOMIC_RELAXED, __HIP_MEMORY_SCOPE_AGENT);
        __syncthreads();
        int u = (int)qw[0]; if (u >= n_units) break;
        { int b, h, qoff, yrow, ycol, NT = 4, skip = 0, q0 = 0; bool win = false, sink = false, isD = false;
          if (u < 256) { b = u >> 5; h = (u >> 3) & 3; const int qb = u & 7; qoff = CTXL + 256 * qb; yrow = b * SEQ + 256 * qb; NT = KT / 64; }
          else if (u < 512) { u -= 256; b = u >> 5; h = (u >> 3) & 3; const int qb = u & 7; const int bs = qb == 0 ? 0 : 256 * qb - 128, be = qb == 7 ? SEQ : 256 * qb + 384;
              qoff = CTXL + 256 * qb; yrow = b * SEQ + 256 * qb; NT = 4 + (be - bs) / 64; skip = bs; q0 = 256 * qb; win = true; sink = true; isD = true; }
          else if (u < 544) { u -= 512; b = u >> 2; h = u & 3; qoff = 0; yrow = RL + b * CTXL; }
          else { u -= 544; b = u >> 2; h = u & 3; qoff = 0; yrow = RL + b * CTXL; sink = true; isD = true; }
          ycol = (isD ? 1536 : 1024) + h * 128;
          const bf16_t* Qp = (isD ? QD : QC) + ((size_t)(b * 4 + h) * KT + qoff) * 128; const bf16_t* Kp = (isD ? KD : KC) + (size_t)(b * 2 + (h >> 1)) * KT * 128; const bf16_t* Vp = (isD ? VD : VC) + (size_t)(b * 2 + (h >> 1)) * KT * 128;
          att::attn_body(Qp, Kp, Vp, Y + (size_t)yrow * DM + ycol, NT, skip, q0, AIN(20)[layer * 4 + h], win, sink, (char*)F.lds, F.tid); }
    }
}

#ifndef LAST_PHASE
#define LAST_PHASE 21
#endif
constexpr int PH_PER_LAYER = 10, N_PHASES = 2 + NLAYER * PH_PER_LAYER;

#define PHASE_BEGIN() do { int w_s = wave_s; asm volatile("" : "+s"(w_s)); unsigned z_ = 0u; asm volatile("" : "+s"(z_)); int t_ = w_s * 64 + (int)__builtin_amdgcn_mbcnt_hi(~0u, __builtin_amdgcn_mbcnt_lo(~0u, z_)); asm volatile("" : "+v"(t_)); F.tid = t_; F.lane = t_ & 63; F.wave = w_s; \
        unsigned long long zo_ = 0ull; asm volatile("" : "+s"(zo_)); F.ws = args.ws + zo_; F.ctl = (unsigned*)(F.ws + WS_CTL);       int b_ = blockIdx.x; asm volatile("" : "+s"(b_)); F.bid = b_; } while (0)
#ifndef PH_MASK
#define PH_MASK 0xFFF
#endif
#define PHON(t) (((PH_MASK) >> (t)) & 1)
#ifndef DUP_MASK
#define DUP_MASK 0
#endif
#define NREP(t) (1 + (((DUP_MASK) >> (t)) & 1))
#define IN(k) ((k) <= LAST_PHASE)
#define SEAM(k) do { if ((k) < LAST_PHASE) { XcdBarrier b2_; b2_.bar = F.ctl + CW_BAR; b2_.x = (unsigned)__builtin_amdgcn_readfirstlane((int)xb_xcc_id()); b2_.st = (volatile LAS unsigned*)(F.lds + MISC_OFF) + 8; xcd_barrier(b2_, F.tid); } } while (0)
#define XL (args.out)
#define XLB ((bf16_t*)(F.ws + WS_ARENA + AR_XLB))
#define XCB ((bf16_t*)(F.ws + WS_XC))
#define H ((bf16_t*)(F.ws + WS_H))
#define Y ((bf16_t*)(F.ws + WS_Y))
#define P ((bf16_t*)(F.ws + WS_ARENA + AR_P))
template <int layer> DI void run_layer(Frame& F, const Args& args, const int wave_s) {
    constexpr bool F8 = MOE_FP8[layer]; constexpr bool G2F8 = MOE2_FP8[layer];
        const int pb = 2 + layer * PH_PER_LAYER; const bool need_ctx = layer < NLAYER - 1; const int ntok = need_ctx ? RT : RL;
        if (PHON(2) && IN(pb + 0)) { PHASE_BEGIN(); for (int rep = 0; rep < NREP(2); ++rep) {
            pg8::DenseSched S; S.T.init(RT / 256, PC / 256, F.G, F.bid);
            pg8::EpiBf16 E{P, PC, IN_FP8[layer] ? 1.0f / SW_IN : 1.0f};
            if constexpr (IN_FP8[layer]) pg8::gemm_phase<DM, 1, 2, SP2_FP8>(F.tid, F.lds, H, (const bf16_t*)(F.ws + WS_WIN) + (size_t)layer * PC * DM, nullptr, S, E);
            else pg8::gemm_phase<DM, 2, 0, SP2_BF16>(F.tid, F.lds, H, (const bf16_t*)(F.ws + WS_WIN) + (size_t)layer * PC * DM, nullptr, S, E);
            } SEAM(pb + 0);
        }
        if (PHON(3) && IN(pb + 1)) { PHASE_BEGIN(); for (int rep = 0; rep < NREP(3); ++rep) {
            for (int r2 = 0; r2 < NREP(12); ++r2) qkv_prep_rows(F, args, layer);
            __syncthreads();
            for (int r2 = 0; r2 < NREP(13); ++r2) { lru_gate_weights(F, layer, F.bid & 7); u32x2 graw[11]; lru_gate_rows(F, F.bid, graw); for (int u = F.bid; u < 1152; u += F.G) lru_gate_unit(F, args, layer, u, graw, u + F.G); }
            for (int r2 = 0; r2 < NREP(14); ++r2) for (int u = (F.bid + 128) & 255; u < 1152; u += F.G) gla_a_unit(F, args, layer, u);
            } SEAM(pb + 1);
        }
        if (PHON(4) && IN(pb + 2)) { PHASE_BEGIN(); scan_attn_phase(F, args, layer, need_ctx, 0); if (NREP(4) == 2) { __syncthreads(); scan_attn_phase(F, args, layer, need_ctx, 1); } }
        if (PHON(5) && IN(pb + 3)) { PHASE_BEGIN();
            { const int ngc = need_ctx ? 576 : 512, nlf = need_ctx ? 288 : 256;
              volatile LAS unsigned* qw = (volatile LAS unsigned*)(F.lds + MISC_OFF + 64); unsigned* head = F.ctl + CW_QUEUE + 64 * (6 + layer);
              __syncthreads();
              if (F.tid == 0) { unsigned* cnt = F.ctl + CW_QUEUE + 64 * (4 + layer); unsigned* bar = F.ctl + CW_BAR; XB_SPIN(xb_ld(cnt) < 208u, bar);
                  __builtin_amdgcn_fence(__ATOMIC_ACQUIRE, "agent"); asm volatile("s_waitcnt vmcnt(0)" ::: "memory"); }
              for (;;) {
                  __syncthreads();
                  if (F.tid == 0) qw[0] = __hip_atomic_fetch_add(head, 1u, __ATOMIC_RELAXED, __HIP_MEMORY_SCOPE_AGENT);
                  __syncthreads();
                  const int u = (int)qw[0]; if (u >= ngc + nlf) break;
                  if (u < ngc) gla_c_unit(F, args, layer, u);
                  else { const int v = u - ngc; lru_final_unit(F, need_ctx ? v : (((v >> 5) * 9 + 1 + ((v >> 2) & 7)) * 4 + (v & 3))); } } }
            SEAM(pb + 3);
        }
        if (PHON(6) && IN(pb + 4)) { PHASE_BEGIN(); for (int rep = 0; rep < NREP(6); ++rep) {
            pg8::DenseSched S; S.T.init(ntok / 256, DM / 256, F.G, F.bid);
            pg8::EpiBf16 E{(bf16_t*)(F.ws + WS_ARENA + AR_YO), DM, 1.0f};
            pg8::gemm_phase<DM, 2, 0, SP2_BF16>(F.tid, F.lds, Y, (const bf16_t*)(F.ws + WS_WOUT) + (size_t)layer * DM * DM, nullptr, S, E);
            } SEAM(pb + 4);
        }
        if (PHON(7) && IN(pb + 5)) { PHASE_BEGIN(); postmix_phase<F8, layer != 0>(F, args, layer, layer == 0 ? (const void*)AIN(0) : (const void*)XLB, layer == 0 ? (const void*)AIN(2) : (const void*)XCB, XLB, XCB, ntok); if (layer == 0 && NREP(7) == 2) postmix_phase<F8, false>(F, args, layer, AIN(0), AIN(2), XLB, XCB, ntok); SEAM(pb + 5); }
        if (PHON(8) && IN(pb + 6)) { PHASE_BEGIN(); for (int rep = 0; rep < NREP(8); ++rep) { slots_phase(F, layer, ntok, F8 ? DM : DM * 2); } SEAM(pb + 6); }
        if (PHON(9) && IN(pb + 7)) { PHASE_BEGIN(); for (int rep = 0; rep < NREP(9); ++rep) {
            const LAS unsigned short* tile_e = (const LAS unsigned short*)(F.lds + TBL_OFF); const int nrt = (int)((LAS unsigned*)(F.lds + TBL_OFF + 2816))[0];
            pg8::MoeSched S; S.T.init(nrt + ntok / 256, 4, F.G, F.bid); S.tile_e = tile_e;
            pg8::EpiSwiGlu<G2F8> E{(void*)(F.ws + WS_ARENA + AR_ACT), F8 ? 1.0f / SW_GU : 1.0f, G2F8 ? S_ACT : 1.0f};
            LAS unsigned short* lrows = (LAS unsigned short*)(F.lds + LROWS_OFF);
            { const unsigned* ROWOFF = (const unsigned*)(F.ws + WS_META + MT_ROWOFF); pg8::Unit uu;
              for (int i = 0; i < 12 && S.next(i, uu); ++i) if (F.tid < 256) lrows[i * 256 + F.tid] = (unsigned short)(ROWOFF[uu.pm * 256 + F.tid] / (unsigned)(F8 ? DM : DM * 2));
              __syncthreads(); }
            pg8::gemm_phase<DM, F8 ? 1 : 2, 1, SP2_FP8>(F.tid, F.lds, H, (const bf16_t*)(F.ws + WS_WGU + (size_t)layer * 65 * 1024 * DM * 2), lrows, S, E);
            } SEAM(pb + 7);
        }
        if (PHON(10) && IN(pb + 8)) { PHASE_BEGIN(); for (int rep = 0; rep < NREP(10); ++rep) {
            const LAS unsigned short* tile_e = (const LAS unsigned short*)(F.lds + TBL_OFF); const int nrt = (int)((LAS unsigned*)(F.lds + TBL_OFF + 2816))[0];
            pg8::MoeSched S; S.T.init(nrt + ntok / 256, 8, F.G, F.bid); S.tile_e = tile_e;
            pg8::EpiFp8 E{(unsigned char*)(F.ws + WS_ARENA + AR_MO), DM, G2F8 ? S_MO / (S_ACT * SW_D) : S_MO};
            if constexpr (G2F8) pg8::gemm_phase<EH, 1, 2, SP2_FP8>(F.tid, F.lds, (const bf16_t*)(F.ws + WS_ARENA + AR_ACT), (const bf16_t*)(F.ws + WS_WD + (size_t)layer * 65 * DM * EH * 2), nullptr, S, E);
            else pg8::gemm_phase<EH, 2, 0, SP2_BF16>(F.tid, F.lds, (const bf16_t*)(F.ws + WS_ARENA + AR_ACT), (const bf16_t*)(F.ws + WS_WD + (size_t)layer * 65 * DM * EH * 2), nullptr, S, E);
            } SEAM(pb + 8);
        }
        if (PHON(11) && IN(pb + 9)) { PHASE_BEGIN();
            combine_phase_ol(F.ws, F.tid, F.wave, F.bid, layer, XL, ntok, need_ctx ? 1 : 0);
            SEAM(pb + 9);
        }
    }

__global__ void __launch_bounds__(NTHR, 2) fwd_kernel(Args args) {
    extern __shared__ __attribute__((aligned(16))) unsigned char lds_raw[];
    Frame F;
    F.lds = (LAS unsigned char*)lds_raw; F.ws = args.ws; F.ctl = (unsigned*)(F.ws + WS_CTL);
    F.tid = threadIdx.x; F.lane = F.tid & 63; F.wave = __builtin_amdgcn_readfirstlane(F.tid >> 6); F.bid = blockIdx.x;
    volatile LAS unsigned* MISC = (volatile LAS unsigned*)(F.lds + MISC_OFF);
    const int wave_s = F.wave;
    if (F.tid < 64) MISC[F.tid] = 0u;
    if (F.tid == 0) { LAS unsigned long long* tb = (LAS unsigned long long*)(F.lds + PTR_OFF);
#pragma unroll
        for (int i = 0; i < 29; ++i) tb[i] = (unsigned long long)args.in[i]; }
    __syncthreads();
    (void)xcd_barrier_post(F.ctl + CW_BAR, MISC + 8);
    if (PHON(0) && IN(0)) { PHASE_BEGIN(); p0_mod(F, args); for (int rep = 0; rep < NREP(0); ++rep) { p0_convert(F, args); p0_convert_fast(F); } }
    if (PHON(1) && IN(1)) { PHASE_BEGIN();
        __syncthreads();
        if (F.tid == 0) { unsigned* cnt = F.ctl + CW_QUEUE + 64 * 8; unsigned* bar = F.ctl + CW_BAR; XB_SPIN(xb_ld(cnt) < 32u, bar); __builtin_amdgcn_fence(__ATOMIC_ACQUIRE, "agent"); asm volatile("s_waitcnt vmcnt(0)" ::: "memory"); }
        __syncthreads();
        for (int rep = 0; rep < NREP(1); ++rep) pre_rows(F, args, 0, AIN(0), AIN(2), RT); SEAM(1); }
    run_layer<0>(F, args, wave_s);
    run_layer<1>(F, args, wave_s);
}
#undef IN
#undef SEAM
#undef XL
#undef XLB
#undef XCB
#undef H
#undef Y
#undef P

extern "C" void kernel_launch(void* const* d_in, const int* in_sizes, int n_in, void* d_out, int out_size, void* d_ws, size_t ws_size, hipStream_t stream) {
    static int grid = 0;
    if (grid == 0) {
        if (n_in != 29 || out_size != RL * DM || ws_size < WS_END) { fprintf(stderr, "kernel_launch: unexpected shapes / workspace (n_in %d out %d ws %zu need %zu)\n", n_in, out_size, ws_size, (size_t)WS_END); grid = -1; return; }
        int dev = 0, cus = 0, per_cu = 0;
        if (hipGetDevice(&dev) != hipSuccess || hipDeviceGetAttribute(&cus, hipDeviceAttributeMultiprocessorCount, dev) != hipSuccess) { grid = -1; return; }
        if (hipFuncSetAttribute((const void*)fwd_kernel, hipFuncAttributeMaxDynamicSharedMemorySize, LDS_BYTES) != hipSuccess) { fprintf(stderr, "kernel_launch: hipFuncSetAttribute failed\n"); grid = -1; return; }
        if (hipOccupancyMaxActiveBlocksPerMultiprocessor(&per_cu, (const void*)fwd_kernel, NTHR, LDS_BYTES) != hipSuccess || per_cu < 1) { fprintf(stderr, "kernel_launch: occupancy query reports %d\n", per_cu); }
        (void)hipGetLastError();
        if (cus < 256) { fprintf(stderr, "kernel_launch: this kernel needs 256 CUs (one resident workgroup each), device has %d\n", cus); grid = -1; return; }
        grid = 256;
    }
    if (grid < 0) return;
    (void)hipMemsetAsync((char*)d_ws + WS_CTL, 0, 1 * MiB, stream);
    Args a{};
    for (int i = 0; i < 29; ++i) a.in[i] = (const float*)d_in[i];
    a.out = (float*)d_out; a.ws = (unsigned char*)d_ws;
    a.ph_lo = 0; a.ph_hi = N_PHASES;
    hipLaunchKernelGGL(fwd_kernel, dim3(grid), dim3(NTHR), LDS_BYTES, stream, a);
    const hipError_t le = hipPeekAtLastError();
    if (le != hipSuccess) fprintf(stderr, "kernel_launch: launch failed: %s\n", hipGetErrorName(le));
}
```
